# Optimizing an MI355X kernel written in HIP

```python
import math
import jax, jax.numpy as jnp
from jax import lax
import numpy as np

D_MODEL = 2048
BATCH = 8
SEQ = 4096
DEPTH = 4

CTX_LEN = 256
GRID_W = 64
MIX_WIDTH = D_MODEL
POOL_WIDTH = 3 * MIX_WIDTH // 4
SSM_WIDTH = MIX_WIDTH - POOL_WIDTH
POOL_WINDOWS = (2, 4, 8, 16)
N_POOL_GROUPS = len(POOL_WINDOWS)
POOL_GROUP = POOL_WIDTH // N_POOL_GROUPS
SSM_GROUP = 16
N_SSM_GROUPS = SSM_WIDTH // SSM_GROUP
SSM_STATE = 64
D_FF = 5632
CONV_K = 3
DT_MIN, DT_MAX = 1e-3, 1e-1
EPS = 1e-6

kernel_name = "hybrid_pool_s5_prefix_dit_block"


def rms_norm(x, gain):
    xf = x.astype(jnp.float32)
    y = xf * lax.rsqrt(jnp.mean(xf * xf, axis=-1, keepdims=True) + EPS)
    return (y * gain.astype(jnp.float32)).astype(x.dtype)


def modulate(h, shift, scale):
    return h * (1 + scale[:, None, :]) + shift[:, None, :]


def multiscale_pool(u, w_pool, pool_scale):
    bsz, n, _ = u.shape
    uf = u.astype(jnp.float32)
    cs = jnp.concatenate([jnp.zeros((bsz, 1, POOL_WIDTH), jnp.float32), jnp.cumsum(uf, axis=1)], axis=1)
    t = jnp.arange(n)
    parts = []
    for g, w in enumerate(POOL_WINDOWS):
        lo = jnp.maximum(t - w // 2, 0)
        hi = jnp.minimum(t + w // 2, n)
        sl = slice(g * POOL_GROUP, (g + 1) * POOL_GROUP)
        csg = cs[..., sl]
        cnt = (hi - lo).astype(jnp.float32)[None, :, None]
        mean = (jnp.take(csg, hi, axis=1) - jnp.take(csg, lo, axis=1)) / cnt
        parts.append(mean - uf[..., sl])
    p = jnp.stack(parts, axis=2)
    y = jnp.einsum('blgc,gcd->blgd', p, w_pool.astype(jnp.float32))
    return (y.reshape(bsz, n, POOL_WIDTH) * pool_scale.astype(jnp.float32)).astype(u.dtype)


def s5_discretise(a_re, a_im, log_dt, b_re, b_im):
    a_re = a_re.astype(jnp.float32)
    a_im = a_im.astype(jnp.float32)
    dt = jnp.exp(log_dt.astype(jnp.float32))[:, None]
    mag = jnp.exp(a_re * dt)
    lam_re = mag * jnp.cos(a_im * dt)
    lam_im = mag * jnp.sin(a_im * dt)
    denom = a_re * a_re + a_im * a_im
    nr, ni = lam_re - 1.0, lam_im
    f_re = (nr * a_re + ni * a_im) / denom
    f_im = (ni * a_re - nr * a_im) / denom
    b_re = b_re.astype(jnp.float32)
    b_im = b_im.astype(jnp.float32)
    bb_re = f_re[..., None] * b_re - f_im[..., None] * b_im
    bb_im = f_re[..., None] * b_im + f_im[..., None] * b_re
    return lam_re, lam_im, bb_re, bb_im


def _complex_linear_recurrence_op(left, right):
    a1r, a1i, b1r, b1i = left
    a2r, a2i, b2r, b2i = right
    return (a2r * a1r - a2i * a1i,
            a2r * a1i + a2i * a1r,
            a2r * b1r - a2i * b1i + b2r,
            a2r * b1i + a2i * b1r + b2i)


def s5_scan(u_g, lam_re, lam_im, bb_re, bb_im, h0, reverse):
    b_re = jnp.einsum('blgh,gph->blgp', u_g, bb_re)
    b_im = jnp.einsum('blgh,gph->blgp', u_g, bb_im)
    if h0 is not None:
        pos = -1 if reverse else 0
        h0_re, h0_im = h0
        b_re = b_re.at[:, pos].add(lam_re * h0_re - lam_im * h0_im)
        b_im = b_im.at[:, pos].add(lam_re * h0_im + lam_im * h0_re)
    a_re = jnp.broadcast_to(lam_re, b_re.shape)
    a_im = jnp.broadcast_to(lam_im, b_im.shape)
    _, _, h_re, h_im = lax.associative_scan(
        _complex_linear_recurrence_op, (a_re, a_im, b_re, b_im), axis=1, reverse=reverse)
    return h_re, h_im


def s5_readout(h, c_re, c_im):
    h_re, h_im = h
    return (jnp.einsum('blgp,ghp->blgh', h_re, c_re.astype(jnp.float32))
            - jnp.einsum('blgp,ghp->blgh', h_im, c_im.astype(jnp.float32)))


def to_ssm_groups(u_ssm):
    bsz, n, _ = u_ssm.shape
    return u_ssm.astype(jnp.float32).reshape(bsz, n, N_SSM_GROUPS, SSM_GROUP)


def s5_head_output(u_ssm, y, ssm_d, w_glu):
    bsz, n, _ = u_ssm.shape
    yf = y.reshape(bsz, n, SSM_WIDTH) + ssm_d.astype(jnp.float32) * u_ssm.astype(jnp.float32)
    yf = jax.nn.gelu(yf)
    return (yf * jax.nn.sigmoid(yf @ w_glu.astype(jnp.float32))).astype(u_ssm.dtype)


def mix_project(u, ssm_y, w_pool, pool_scale, ssm_d, w_glu, w_out):
    pool_out = multiscale_pool(u[..., :POOL_WIDTH], w_pool, pool_scale)
    ssm_out = s5_head_output(u[..., POOL_WIDTH:], ssm_y, ssm_d, w_glu)
    return jnp.concatenate([pool_out, ssm_out], axis=-1) @ w_out


def conv_glu_ffn(h, w_up, w_conv, w_down, rows):
    bsz, n, _ = h.shape
    z = h @ w_up
    if rows is None:
        grid = z[:, None]
        k = w_conv[1:2]
    else:
        grid = z.reshape(bsz, rows, GRID_W, 2 * D_FF)
        k = w_conv
    grid = lax.conv_general_dilated(grid, k[:, :, None, :], (1, 1), 'SAME',
                                    dimension_numbers=('NHWC', 'HWIO', 'NHWC'),
                                    feature_group_count=2 * D_FF)
    val, gate = jnp.split(grid.reshape(bsz, n, 2 * D_FF), 2, axis=-1)
    return (val * jax.nn.silu(gate)) @ w_down


def setup_inputs(seed: int = 0) -> dict:
    key = jax.random.key(seed)
    ks = jax.random.split(key, 26)
    f32 = jnp.float32
    nrm = lambda k, shape, s: jax.random.normal(k, shape, f32) * s
    G, P, H = N_SSM_GROUPS, SSM_STATE, SSM_GROUP
    a_im_base = jnp.pi * jnp.arange(P, dtype=f32)
    return {
        "x": nrm(ks[0], (BATCH, SEQ, D_MODEL), 1.0),
        "c": nrm(ks[1], (BATCH, D_MODEL), 1.0),
        "ctx": nrm(ks[2], (BATCH, CTX_LEN, D_MODEL), 1.0),
        "c_ctx": nrm(ks[3], (D_MODEL,), 1.0),
        "w_ada": nrm(ks[4], (DEPTH, D_MODEL, 6 * D_MODEL), 0.5 * D_MODEL ** -0.5),
        "b_ada": nrm(ks[5], (DEPTH, 6 * D_MODEL), 0.02),
        "w_in": nrm(ks[6], (DEPTH, D_MODEL, MIX_WIDTH), D_MODEL ** -0.5),
        "w_pool": nrm(ks[7], (DEPTH, N_POOL_GROUPS, POOL_GROUP, POOL_GROUP), POOL_GROUP ** -0.5),
        "pool_scale": 1.0 + nrm(ks[8], (DEPTH, POOL_WIDTH), 0.02),
        "ssm_a_re": -0.5 + nrm(ks[9], (DEPTH, 2, G, P), 0.01),
        "ssm_a_im": a_im_base + nrm(ks[10], (DEPTH, 2, G, P), 0.01),
        "ssm_log_dt": jax.random.uniform(ks[11], (DEPTH, 2, G), f32, math.log(DT_MIN), math.log(DT_MAX)),
        "ssm_b_re": nrm(ks[12], (DEPTH, 2, G, P, H), (2 * H) ** -0.5),
        "ssm_b_im": nrm(ks[13], (DEPTH, 2, G, P, H), (2 * H) ** -0.5),
        "ssm_c_re": nrm(ks[14], (DEPTH, 2, G, H, P), P ** -0.5),
        "ssm_c_im": nrm(ks[15], (DEPTH, 2, G, H, P), P ** -0.5),
        "ssm_d": nrm(ks[16], (DEPTH, SSM_WIDTH), 1.0),
        "w_glu": nrm(ks[17], (DEPTH, SSM_WIDTH, SSM_WIDTH), SSM_WIDTH ** -0.5),
        "w_out": nrm(ks[18], (DEPTH, MIX_WIDTH, D_MODEL), MIX_WIDTH ** -0.5),
        "g_pre_mix": 1.0 + nrm(ks[19], (DEPTH, D_MODEL), 0.02),
        "g_post_mix": 1.0 + nrm(ks[20], (DEPTH, D_MODEL), 0.02),
        "g_pre_ffn": 1.0 + nrm(ks[21], (DEPTH, D_MODEL), 0.02),
        "g_post_ffn": 1.0 + nrm(ks[22], (DEPTH, D_MODEL), 0.02),
        "w_up": nrm(ks[23], (DEPTH, D_MODEL, 2 * D_FF), D_MODEL ** -0.5),
        "w_conv": nrm(ks[24], (DEPTH, CONV_K, CONV_K, 2 * D_FF), 1.0 / CONV_K),
        "w_down": nrm(ks[25], (DEPTH, D_FF, D_MODEL), D_FF ** -0.5),
    }


def reference(x, c, ctx, c_ctx, w_ada, b_ada, w_in, w_pool, pool_scale, ssm_a_re, ssm_a_im,
              ssm_log_dt, ssm_b_re, ssm_b_im, ssm_c_re, ssm_c_im, ssm_d, w_glu, w_out,
              g_pre_mix, g_post_mix, g_pre_ffn, g_post_ffn, w_up, w_conv, w_down):
    n_lat = x.shape[1]
    rows = n_lat // GRID_W
    s_c = jax.nn.silu(c)
    s_ctx = jax.nn.silu(c_ctx)[None, :]
    for l in range(DEPTH):
        last = l == DEPTH - 1
        mx = jnp.split(s_c @ w_ada[l] + b_ada[l], 6, axis=-1)
        mc = jnp.split(s_ctx @ w_ada[l] + b_ada[l], 6, axis=-1)
        disc = [s5_discretise(ssm_a_re[l, d], ssm_a_im[l, d], ssm_log_dt[l, d],
                              ssm_b_re[l, d], ssm_b_im[l, d]) for d in range(2)]

        h_ctx = modulate(rms_norm(ctx, g_pre_mix[l]), mc[0], mc[1])
        h_lat = modulate(rms_norm(x, g_pre_mix[l]), mx[0], mx[1])
        u_lat = h_lat @ w_in[l]
        if last:
            u_ctx_ssm = h_ctx @ w_in[l][:, POOL_WIDTH:]
        else:
            u_ctx = h_ctx @ w_in[l]
            u_ctx_ssm = u_ctx[..., POOL_WIDTH:]
        ctx_g = to_ssm_groups(u_ctx_ssm)
        lat_g = to_ssm_groups(u_lat[..., POOL_WIDTH:])
        lat_dirs, ctx_dirs = [], []
        for d in range(2):
            rev = d == 1
            lam_re, lam_im, bb_re, bb_im = disc[d]
            hc = s5_scan(ctx_g, lam_re, lam_im, bb_re, bb_im, None, rev)
            fin = 0 if rev else -1
            h0 = (hc[0][:, fin], hc[1][:, fin])
            hl = s5_scan(lat_g, lam_re, lam_im, bb_re, bb_im, h0, rev)
            lat_dirs.append(s5_readout(hl, ssm_c_re[l, d], ssm_c_im[l, d]))
            if not last:
                ctx_dirs.append(s5_readout(hc, ssm_c_re[l, d], ssm_c_im[l, d]))
        mix_lat = mix_project(u_lat, lat_dirs[0] + lat_dirs[1], w_pool[l], pool_scale[l],
                              ssm_d[l], w_glu[l], w_out[l])
        x = x + mx[2][:, None, :] * rms_norm(mix_lat, g_post_mix[l])

        f_lat = conv_glu_ffn(modulate(rms_norm(x, g_pre_ffn[l]), mx[3], mx[4]),
                             w_up[l], w_conv[l], w_down[l], rows)
        x = x + mx[5][:, None, :] * rms_norm(f_lat, g_post_ffn[l])

        if not last:
            mix_ctx = mix_project(u_ctx, ctx_dirs[0] + ctx_dirs[1], w_pool[l], pool_scale[l],
                                  ssm_d[l], w_glu[l], w_out[l])
            ctx = ctx + mc[2][:, None, :] * rms_norm(mix_ctx, g_post_mix[l])
            f_ctx = conv_glu_ffn(modulate(rms_norm(ctx, g_pre_ffn[l]), mc[3], mc[4]),
                                 w_up[l], w_conv[l], w_down[l], None)
            ctx = ctx + mc[5][:, None, :] * rms_norm(f_ctx, g_post_ffn[l])
    return x
```

```cpp
#include <hip/hip_runtime.h>
#include <cstdio>
#include <cstdint>

#ifndef MK_DUP
#define MK_DUP 0
#endif
#ifndef MK_MULTI_LAUNCH
#define MK_MULTI_LAUNCH 0
#endif

namespace pg8 {
#define PG8_LAS __attribute__((address_space(3)))
typedef unsigned short bf16_t;
typedef short bf16x8 __attribute__((ext_vector_type(8)));
typedef float f32x4 __attribute__((ext_vector_type(4)));
typedef unsigned u32x4 __attribute__((ext_vector_type(4)));
constexpr int BM = 256, BK = 64, HALF = 128, HTB = HALF * BK * 2, STAGE_BYTES = 8 * HTB, NXCD = 8, WGM = 8;

__host__ __device__ __forceinline__ int lds_byte(int r, int c) { const int st = (r >> 4) * 2 + (c >> 5), rr = r & 15, cc = c & 31, ob = rr * 64 + cc * 2; return st * 1024 + (ob ^ (((ob >> 9) & 1) << 5)); }
__host__ __device__ __forceinline__ void stage_rc(int b, int& R, int& C) { const int st = b / 1024, sb = b % 1024, swz = sb ^ (((sb >> 9) & 1) << 5); R = (st >> 1) * 16 + swz / 64; C = (st & 1) * 32 + (swz % 64) / 2; }
__host__ __device__ __forceinline__ int perm32(int rho) { const int n = rho >> 4, i = rho & 15; return 8 * (i >> 2) + 4 * n + (i & 3); }

struct Unit { int pm, pn; };
struct Gemm { const bf16_t* A; const bf16_t* Bt; int M, N, K; };

struct StaticOrder {
    int nM, nN, nwg, G, c;
    __host__ __device__ void init(int M, int N, int G_, int c_) { nM = M / BM; nN = N / BM; nwg = nM * nN; G = G_; c = c_; }
    __host__ __device__ bool next(int i, Unit& u) const {
        const long L = (long)i * G + c; if (L >= nwg) return false;
        int wgid = (int)L; { const int q = nwg / NXCD, r = nwg % NXCD, xcd = wgid % NXCD, off = wgid / NXCD; wgid = (xcd < r ? xcd * (q + 1) : r * (q + 1) + (xcd - r) * q) + off; }
        const int nig = WGM * nN, gid = wgid / nig, fm = gid * WGM, gsz = (nM - fm) < WGM ? (nM - fm) : WGM;
        u.pm = fm + ((wgid % nig) % gsz); u.pn = (wgid % nig) / gsz; return true;
    }
    __device__ __forceinline__ void a_ready(const Unit&) const {}
    __device__ __forceinline__ void done(const Unit&) const {}
};

__device__ __forceinline__ unsigned cvt_pk_bf16(float lo, float hi) { unsigned r; asm volatile("v_cvt_pk_bf16_f32 %0, %1, %2" : "=v"(r) : "v"(lo), "v"(hi)); return r; }

struct EpiBf16 {
    static constexpr bool PERM = true, AFTER_DRAIN = false;
    bf16_t* O; int ldc;
    __device__ __forceinline__ void operator()(const f32x4 (&acc)[2][2][4][2], const Unit& u, int wr, int wc, int fr, int fq) const {
        const int row0 = u.pm * BM + wr * 64 + fr; const int col0 = u.pn * BM + wc * 32 + 8 * fq;
#pragma unroll
        for (int ai = 0; ai < 2; ++ai)
#pragma unroll
            for (int m = 0; m < 4; ++m) { bf16_t* rowp = O + (size_t)(row0 + ai * HALF + m * 16) * ldc + col0;
#pragma unroll
                for (int bj = 0; bj < 2; ++bj) { const f32x4 v0 = acc[ai][bj][m][0], v1 = acc[ai][bj][m][1];
                    u32x4 w; w.x = cvt_pk_bf16(v0[0], v0[1]); w.y = cvt_pk_bf16(v0[2], v0[3]); w.z = cvt_pk_bf16(v1[0], v1[1]); w.w = cvt_pk_bf16(v1[2], v1[3]);
                    *(u32x4*)(rowp + bj * HALF) = w; } }
    }
};

template <class Epi, class Sched, bool ALIGN_EPI = false, bool SP2 = false>
__device__ __forceinline__ void gemm_phase(PG8_LAS unsigned char* lds, const Gemm g, const Sched& S, const Epi& E) {
    int tid_ = threadIdx.x; asm volatile("" : "+v"(tid_));
    const int tid = tid_, wid = __builtin_amdgcn_readfirstlane(tid >> 6), lane = tid & 63, wr = wid >> 2, wc = wid & 3, fr = lane & 15, fq = lane >> 4;
    const int K = g.K, nt = K / BK;
    unsigned voffA[2], voffB[2];
#pragma unroll
    for (int i = 0; i < 2; ++i) { int R, C; stage_rc(tid * 16 + i * 8192, R, C); const int Rb = Epi::PERM ? ((R & ~31) + perm32(R & 31)) : R;
        voffA[i] = (unsigned)(R * K + C) * 2u; voffB[i] = (unsigned)(Rb * K + C) * 2u; }
    const size_t kstep = (size_t)(BK * 2);
    const size_t hstep = (size_t)HALF * K * 2;
    const size_t tstep = 2 * hstep;
    const unsigned ldsw = (unsigned)wid * 1024u;
    const int aoff = lds_byte(wr * 64 + fr, fq * 8), boff = lds_byte(wc * 32 + fr, fq * 8);
#define PG8_SA(b, h) (((b) * 2 + (h)) * HTB)
#define PG8_SB(b, h) ((4 + (b) * 2 + (h)) * HTB)
#define PG8_STAGE(bufoff, gbase, voff) do { _Pragma("unroll") for (int _i = 0; _i < 2; ++_i) \
        __builtin_amdgcn_global_load_lds((const unsigned*)((const char*)(gbase) + (voff)[_i]), (PG8_LAS unsigned*)(lds + (bufoff) + ldsw + _i * 8192), 16, 0, 0); } while (0)
#define PG8_LDA(dst, b, h) do { _Pragma("unroll") for (int m = 0; m < 4; ++m) _Pragma("unroll") for (int k = 0; k < 2; ++k) dst[m][k] = *(const PG8_LAS bf16x8*)(lds + PG8_SA(b, h) + aoff + m * 2048 + k * 1024); } while (0)
#define PG8_LDB(dst, b, h) do { _Pragma("unroll") for (int n = 0; n < 2; ++n) _Pragma("unroll") for (int k = 0; k < 2; ++k) dst[n][k] = *(const PG8_LAS bf16x8*)(lds + PG8_SB(b, h) + boff + n * 2048 + k * 1024); } while (0)
#define PG8_MMA(ai, bj, At, Bt) do { __builtin_amdgcn_s_setprio(1); _Pragma("unroll") for (int m = 0; m < 4; ++m) _Pragma("unroll") for (int n = 0; n < 2; ++n) _Pragma("unroll") for (int k = 0; k < 2; ++k) \
        acc[ai][bj][m][n] = __builtin_amdgcn_mfma_f32_16x16x32_bf16(Bt[n][k], At[m][k], acc[ai][bj][m][n], 0, 0, 0); __builtin_amdgcn_s_setprio(0); } while (0)
#define PG8_WAIT_V(n) asm volatile("s_waitcnt vmcnt(" #n ")" ::: "memory")
#define PG8_WAIT_L(n) asm volatile("s_waitcnt lgkmcnt(" #n ")" ::: "memory")
#define PG8_BAR __builtin_amdgcn_s_barrier()
#define PG8_SCHED __builtin_amdgcn_sched_barrier(0)
    Unit cur, nxt; int ui = 0;
    if (!S.next(0, cur)) return;
    f32x4 acc[2][2][4][2];
#pragma unroll
    for (int a = 0; a < 2; ++a)
#pragma unroll
        for (int b = 0; b < 2; ++b)
#pragma unroll
            for (int m = 0; m < 4; ++m)
#pragma unroll
                for (int n = 0; n < 2; ++n) acc[a][b][m][n] = (f32x4){0.f, 0.f, 0.f, 0.f};
    bf16x8 At[4][2], B0[2][2], B1[2][2];
    const char* cA = (const char*)g.A + (size_t)cur.pm * tstep; const char* cB = (const char*)g.Bt + (size_t)cur.pn * tstep;
    S.a_ready(cur);
    if constexpr (SP2) {
        PG8_STAGE(PG8_SB(0, 0), cB, voffB); PG8_STAGE(PG8_SB(0, 1), cB + hstep, voffB); PG8_STAGE(PG8_SA(0, 0), cA, voffA); PG8_STAGE(PG8_SA(0, 1), cA + hstep, voffA);
        if (wr == 1) PG8_BAR;
        PG8_WAIT_V(2); PG8_BAR;
        PG8_STAGE(PG8_SB(1, 0), cB + kstep, voffB); PG8_STAGE(PG8_SA(1, 0), cA + kstep, voffA); PG8_STAGE(PG8_SB(1, 1), cB + hstep + kstep, voffB);
        PG8_WAIT_V(6); PG8_BAR;
    } else {
        PG8_STAGE(PG8_SB(0, 0), cB, voffB); PG8_STAGE(PG8_SA(0, 0), cA, voffA); PG8_STAGE(PG8_SB(0, 1), cB + hstep, voffB); PG8_STAGE(PG8_SA(0, 1), cA + hstep, voffA);
        if (wr == 1) PG8_BAR;
        PG8_WAIT_V(4); PG8_BAR;
        PG8_STAGE(PG8_SB(1, 0), cB + kstep, voffB); PG8_STAGE(PG8_SA(1, 0), cA + kstep, voffA); PG8_STAGE(PG8_SB(1, 1), cB + hstep + kstep, voffB);
        PG8_WAIT_V(6); PG8_BAR;
    }
    for (;;) {
        const bool has_next = S.next(ui + 1, nxt);
        const char* nA = has_next ? (const char*)g.A + (size_t)nxt.pm * tstep : cA; const char* nB = has_next ? (const char*)g.Bt + (size_t)nxt.pn * tstep : cB;
        for (int t = 0; t < nt; t += 2) {
            const bool last = (t == nt - 2);
            const char* a1 = cA + (size_t)(t + 1) * kstep;
            const char* a2 = last ? nA : cA + (size_t)(t + 2) * kstep; const char* b2 = last ? nB : cB + (size_t)(t + 2) * kstep;
            const char* a3 = a2 + kstep; const char* b3 = b2 + kstep;
            if (last && has_next) S.a_ready(nxt);
            if constexpr (SP2) {
            PG8_LDB(B0, 0, 0); PG8_LDB(B1, 0, 1); PG8_SCHED; PG8_LDA(At, 0, 0); PG8_STAGE(PG8_SA(1, 1), a1 + hstep, voffA);
            PG8_WAIT_V(8); PG8_WAIT_L(0); PG8_BAR; PG8_MMA(0, 0, At, B0); PG8_MMA(0, 1, At, B1); PG8_BAR; PG8_SCHED;
            PG8_LDA(At, 0, 1); PG8_STAGE(PG8_SB(0, 0), b2, voffB); PG8_STAGE(PG8_SB(0, 1), b2 + hstep, voffB); PG8_STAGE(PG8_SA(0, 0), a2, voffA);
            PG8_WAIT_V(8); PG8_WAIT_L(0); PG8_BAR; PG8_MMA(1, 0, At, B0); PG8_MMA(1, 1, At, B1); PG8_BAR; PG8_SCHED;
            PG8_LDB(B0, 1, 0); PG8_LDB(B1, 1, 1); PG8_SCHED; PG8_LDA(At, 1, 0); PG8_STAGE(PG8_SA(0, 1), a2 + hstep, voffA);
            PG8_WAIT_V(8); PG8_WAIT_L(0); PG8_BAR; PG8_MMA(0, 0, At, B0); PG8_MMA(0, 1, At, B1); PG8_BAR; PG8_SCHED;
            PG8_LDA(At, 1, 1); PG8_STAGE(PG8_SB(1, 0), b3, voffB); PG8_STAGE(PG8_SB(1, 1), b3 + hstep, voffB); PG8_STAGE(PG8_SA(1, 0), a3, voffA);
            PG8_WAIT_V(8); PG8_WAIT_L(0); PG8_BAR; PG8_MMA(1, 0, At, B0); PG8_MMA(1, 1, At, B1); PG8_BAR; PG8_SCHED;
            } else {
            PG8_LDB(B0, 0, 0); PG8_SCHED; PG8_LDA(At, 0, 0); PG8_STAGE(PG8_SA(1, 1), a1 + hstep, voffA);
            PG8_WAIT_L(8); PG8_BAR; PG8_WAIT_L(0); PG8_MMA(0, 0, At, B0); PG8_BAR; PG8_SCHED;
            PG8_LDB(B1, 0, 1); PG8_STAGE(PG8_SB(0, 0), b2, voffB);
            PG8_BAR; PG8_WAIT_L(0); PG8_MMA(0, 1, At, B1); PG8_BAR;
            PG8_LDA(At, 0, 1); PG8_STAGE(PG8_SA(0, 0), a2, voffA);
            PG8_BAR; PG8_WAIT_L(0); PG8_MMA(1, 0, At, B0); PG8_BAR; PG8_SCHED;
            PG8_STAGE(PG8_SB(0, 1), b2 + hstep, voffB);
            PG8_WAIT_V(6); PG8_BAR; PG8_MMA(1, 1, At, B1); PG8_BAR;
            PG8_LDB(B0, 1, 0); PG8_SCHED; PG8_LDA(At, 1, 0); PG8_STAGE(PG8_SA(0, 1), a2 + hstep, voffA);
            PG8_WAIT_L(8); PG8_BAR; PG8_WAIT_L(0); PG8_MMA(0, 0, At, B0); PG8_BAR; PG8_SCHED;
            PG8_LDB(B1, 1, 1); PG8_STAGE(PG8_SB(1, 0), b3, voffB);
            PG8_BAR; PG8_WAIT_L(0); PG8_MMA(0, 1, At, B1); PG8_BAR;
            PG8_LDA(At, 1, 1); PG8_STAGE(PG8_SA(1, 0), a3, voffA);
            PG8_BAR; PG8_WAIT_L(0); PG8_MMA(1, 0, At, B0); PG8_BAR; PG8_SCHED;
            PG8_STAGE(PG8_SB(1, 1), b3 + hstep, voffB);
            PG8_WAIT_V(6); PG8_BAR; PG8_MMA(1, 1, At, B1); PG8_BAR;
            }
        }
        if constexpr (ALIGN_EPI) { if (wr == 0) PG8_BAR; }
        if constexpr (!Epi::AFTER_DRAIN) { E(acc, cur, wr, wc, fr, fq); S.done(cur); }
        if (!has_next) break;
#pragma unroll
        for (int a = 0; a < 2; ++a)
#pragma unroll
            for (int b = 0; b < 2; ++b)
#pragma unroll
                for (int m = 0; m < 4; ++m)
#pragma unroll
                    for (int n = 0; n < 2; ++n) acc[a][b][m][n] = (f32x4){0.f, 0.f, 0.f, 0.f};
        cur = nxt; cA = nA; cB = nB; ++ui;
        if constexpr (ALIGN_EPI) { if (wr == 1) PG8_BAR; }
    }
    PG8_WAIT_V(0);
    if constexpr (!ALIGN_EPI) { if (wr == 0) PG8_BAR; }
    PG8_BAR;
#undef PG8_SA
#undef PG8_SB
#undef PG8_STAGE
#undef PG8_LDA
#undef PG8_LDB
#undef PG8_MMA
#undef PG8_WAIT_V
#undef PG8_WAIT_L
#undef PG8_BAR
#undef PG8_SCHED
}
}

constexpr int DM = 2048, NBATCH = 8, SEQ = 4096, DEPTH = 4, CTXL = 256, GRIDW = 64;
constexpr int MLAT = NBATCH * SEQ, MCTX = NBATCH * CTXL, MALL = MLAT + MCTX;
constexpr int POOLW = 1536, SSMW = 512, NGRP = 32, SGRP = 16, NSTATE = 64, PGRP = 384;
constexpr int DFF = 5632, DFF2 = 11264;
constexpr float EPSN = 1e-6f;
constexpr int NWAVES = 8, NTHREADS = 512;

constexpr size_t MiB = 1u << 20;
constexpr size_t WS_CTL = 0, CTL_BYTES = 1 * MiB;
constexpr size_t WS_MOD = 1 * MiB;
constexpr size_t WS_LAM = 3 * MiB;
constexpr size_t WS_BB = 4 * MiB;
constexpr size_t WS_CM = 6 * MiB;
constexpr size_t WS_WT = 8 * MiB;
constexpr size_t WT_IN = 0, WT_COMB = (size_t)DM * DM, WT_UP = 2 * (size_t)DM * DM, WT_DOWN = WT_UP + (size_t)DFF2 * DM, WT_GLU = WT_DOWN + (size_t)DM * DFF, WT_LAYER = WT_GLU + (size_t)SSMW * SSMW;
constexpr size_t WS_XB = WS_WT + 4 * WT_LAYER * 2;
constexpr size_t WS_BUFA = WS_XB + (size_t)MALL * DM * 2;
constexpr size_t BUF_BYTES = (size_t)MALL * DM * 2;
constexpr size_t WS_BUFB = WS_BUFA + BUF_BYTES, WS_BUFC = WS_BUFB + BUF_BYTES, WS_Z = WS_BUFC + BUF_BYTES;
constexpr int HALF1_ROW0 = 4 * SEQ;
constexpr size_t Z_FULL = (size_t)MALL * DFF2 * 2, Z_HALF = (size_t)(MALL - HALF1_ROW0) * DFF2 * 2;
constexpr size_t A_HALF = (size_t)(MALL - HALF1_ROW0) * DFF * 2;
constexpr size_t WS_NEED_FULL = WS_Z + Z_FULL, WS_NEED_HALF = WS_Z + Z_HALF;
static_assert(A_HALF + (size_t)(MALL - HALF1_ROW0) * DM * 2 <= 2 * BUF_BYTES, "half-mode a + f fit in bufB|bufC");
static_assert((size_t)MALL * DFF * 2 <= 3 * BUF_BYTES, "full-mode a fits in bufA|bufB|bufC");
static_assert(WS_XB % 256 == 0 && WS_BUFA % 256 == 0 && WS_Z % 256 == 0, "alignment");
constexpr int CW_QUEUE = 64;
constexpr int CW_BAR = 4096;

constexpr int SCRATCH_BYTES = 139264;
constexpr int MISC_OFF = SCRATCH_BYTES;
constexpr int LDS_BYTES = 147456;

#define LAS __attribute__((address_space(3)))
typedef unsigned short bf16;
typedef short bf16x8 __attribute__((ext_vector_type(8)));
typedef float f32x4 __attribute__((ext_vector_type(4)));
typedef float f32x16 __attribute__((ext_vector_type(16)));
typedef unsigned u32x4 __attribute__((ext_vector_type(4)));
typedef unsigned u32x2 __attribute__((ext_vector_type(2)));

__device__ __forceinline__ float bf2f(unsigned short b) { return __uint_as_float(((unsigned)b) << 16); }
__device__ __forceinline__ float bflo(unsigned w) { return __uint_as_float(w << 16); }
__device__ __forceinline__ float bfhi(unsigned w) { return __uint_as_float(w & 0xffff0000u); }
__device__ __forceinline__ unsigned pk2(float lo, float hi) { return pg8::cvt_pk_bf16(lo, hi); }
__device__ __forceinline__ float wave_sum(float v) {
#pragma unroll
    for (int o = 1; o < 64; o <<= 1) v += __shfl_xor(v, o);
    return v;
}
__device__ __forceinline__ void st16_wt(void* p, u32x4 v) { asm volatile("global_store_dwordx4 %0, %1, off sc1\n\ts_nop 1" :: "v"(p), "v"(v) : "memory"); }
__device__ __forceinline__ void st8_wt(void* p, u32x2 v) { asm volatile("global_store_dwordx2 %0, %1, off sc1\n\ts_nop 1" :: "v"(p), "v"(v) : "memory"); }
__device__ __forceinline__ float sigmoidf_(float t) { return __builtin_amdgcn_rcpf(1.0f + __builtin_amdgcn_exp2f(-1.4426950408889634f * t)); }

#define XB_TMO      128
#define XB_XCNT(j)  (256  + 64 * (j))
#define XB_XSUB(j)  (1280 + 64 * (j))
#define XB_XGEN(j)  (2304 + 64 * (j))
#define XB_TOP      3328
#define XB_TOPGEN   3392
#define XCD_BAR_WORDS 3456
#define XB_SPIN_CAP (1u << 20)

__device__ __forceinline__ unsigned xb_ld(unsigned* p)              { return __hip_atomic_load(p, __ATOMIC_RELAXED, __HIP_MEMORY_SCOPE_AGENT); }
__device__ __forceinline__ unsigned xb_add(unsigned* p, unsigned v) { return __hip_atomic_fetch_add(p, v, __ATOMIC_RELAXED, __HIP_MEMORY_SCOPE_AGENT); }
__device__ __forceinline__ unsigned xb_xcc_id() { return (unsigned)__builtin_amdgcn_s_getreg((3 << 11) | 20) & 0xFu; }
#define XB_SPIN(cond, bar) do { unsigned _sp = 0; while (cond) { __builtin_amdgcn_s_sleep(1); \
    if ((++_sp & 255u) == 0u) { if (xb_ld(&(bar)[XB_TMO])) break; if (_sp > XB_SPIN_CAP) { atomicAdd(&(bar)[XB_TMO], 1u); break; } } } } while (0)

struct XcdBarrier { unsigned* bar; unsigned x; volatile LAS unsigned* st; };

__device__ __forceinline__ XcdBarrier xcd_barrier_post(unsigned* bar, volatile LAS unsigned* st) {
    XcdBarrier b; b.bar = bar; b.x = xb_xcc_id(); b.st = st;
    if (threadIdx.x == 0) (void)xb_add(&bar[XB_XCNT(b.x)], 1u);
    return b;
}
__device__ __forceinline__ void xcd_barrier_complete(unsigned* bar, unsigned x, unsigned& nloc, unsigned& nx) {
    const unsigned G = gridDim.x * gridDim.y * gridDim.z;
    unsigned sum, cnt, mine, sp = 0u;
    for (;;) {
        sum = 0u; cnt = 0u; mine = 0u;
#pragma unroll
        for (unsigned j = 0; j < 16; ++j) { const unsigned c = xb_ld(&bar[XB_XCNT(j)]); sum += c; cnt += (c > 0u) ? 1u : 0u; mine = (j == x) ? c : mine; }
        if (sum == G) break;
        __builtin_amdgcn_s_sleep(1);
        if ((++sp & 255u) == 0u) { if (xb_ld(&bar[XB_TMO])) break; if (sp > XB_SPIN_CAP) { atomicAdd(&bar[XB_TMO], 1u); break; } }
    }
    nloc = mine > 0u ? mine : 1u; nx = cnt > 0u ? cnt : 1u;
}
__device__ __forceinline__ void xcd_barrier(const XcdBarrier& b) {
    asm volatile("s_waitcnt vmcnt(0)" ::: "memory");
    __syncthreads();
    if (threadIdx.x == 0) {
        unsigned* bar = b.bar;
        __builtin_amdgcn_s_waitcnt(0);
        unsigned nloc = b.st[0], nx = b.st[1];
        if (nloc == 0u) { xcd_barrier_complete(bar, b.x, nloc, nx); b.st[0] = nloc; b.st[1] = nx; }
        const unsigned old = xb_add(&bar[XB_XSUB(b.x)], 1u);
        const unsigned gen = old / nloc;
        if (old + 1u == (gen + 1u) * nloc) {
            __builtin_amdgcn_fence(__ATOMIC_RELEASE, "agent");
            asm volatile("s_waitcnt vmcnt(0)" ::: "memory");
            const unsigned og = xb_add(&bar[XB_TOP], 1u);
            const unsigned tg = og / nx;
            if (og + 1u == (tg + 1u) * nx) xb_add(&bar[XB_TOPGEN], 1u);
            else XB_SPIN(xb_ld(&bar[XB_TOPGEN]) == tg, bar);
            __builtin_amdgcn_fence(__ATOMIC_ACQUIRE, "agent");
            xb_add(&bar[XB_XGEN(b.x)], 1u);
            asm volatile("s_waitcnt vmcnt(0)" ::: "memory");
        } else {
            XB_SPIN(xb_ld(&bar[XB_XGEN(b.x)]) == gen, bar);
            __builtin_amdgcn_fence(__ATOMIC_ACQUIRE, "agent");
            asm volatile("s_waitcnt vmcnt(0)" ::: "memory");
        }
    }
    __syncthreads();
}

struct Args {
    const float* in[26];
    float* out;
    unsigned char* ws;
    int seg_lo, seg_hi;
    int nhalf, dup;
};
typedef const Args __attribute__((address_space(4)))* ArgsP;
__device__ __forceinline__ ArgsP launder(ArgsP p) { asm volatile("" : "+s"(p)); return p; }
enum { IN_X = 0, IN_C, IN_CTX, IN_CCTX, IN_WADA, IN_BADA, IN_WIN, IN_WPOOL, IN_PSCALE, IN_ARE, IN_AIM, IN_LOGDT, IN_BRE, IN_BIM, IN_CRE, IN_CIM, IN_SSMD, IN_WGLU, IN_WOUT,
       IN_GPREMIX, IN_GPOSTMIX, IN_GPREFFN, IN_GPOSTFFN, IN_WUP, IN_WCONV, IN_WDOWN };

__device__ __forceinline__ void p0_mod_item(ArgsP a, LAS unsigned char* lds, int item, int tid) {
    const int l = item / 48, n0 = (item % 48) * 256;
    LAS float* sS = (LAS float*)lds;
    const float* c = a->in[IN_C]; const float* cc = a->in[IN_CCTX];
    for (int idx = tid; idx < 9 * DM; idx += NTHREADS) { const int j = idx >> 11, k = idx & (DM - 1); const float v = (j < 8) ? c[j * DM + k] : cc[k]; sS[idx] = v * sigmoidf_(v); }
    __syncthreads();
    const int q = tid & 63, ks = tid >> 6;
    f32x4 acc[9];
#pragma unroll
    for (int j = 0; j < 9; ++j) acc[j] = (f32x4){0.f, 0.f, 0.f, 0.f};
    const float* wp = a->in[IN_WADA] + ((size_t)l * DM + (size_t)ks * 256) * (6 * DM) + n0 + 4 * q;
#pragma unroll 2
    for (int kk = 0; kk < 256; kk += 4) {
        const f32x4 w0 = *(const f32x4*)(wp + (size_t)(kk + 0) * (6 * DM)), w1 = *(const f32x4*)(wp + (size_t)(kk + 1) * (6 * DM));
        const f32x4 w2 = *(const f32x4*)(wp + (size_t)(kk + 2) * (6 * DM)), w3 = *(const f32x4*)(wp + (size_t)(kk + 3) * (6 * DM));
#pragma unroll
        for (int j = 0; j < 9; ++j) { const f32x4 sv = *(const LAS f32x4*)(sS + j * DM + ks * 256 + kk);
            acc[j] += sv.x * w0 + sv.y * w1 + sv.z * w2 + sv.w * w3; }
    }
    __syncthreads();
    LAS float* red = (LAS float*)lds;
#pragma unroll
    for (int j = 0; j < 9; ++j) *(LAS f32x4*)(red + (ks * 9 + j) * 256 + 4 * q) = acc[j];
    __syncthreads();
    float* MOD = (float*)(a->ws + WS_MOD);
    const float* bada = a->in[IN_BADA];
    for (int o = tid; o < 9 * 256; o += NTHREADS) { const int j = o >> 8, col = o & 255; float s = bada[l * 6 * DM + n0 + col];
#pragma unroll
        for (int k2 = 0; k2 < 8; ++k2) s += red[(k2 * 9 + j) * 256 + col];
        MOD[((size_t)l * 9 + j) * (6 * DM) + n0 + col] = s; }
    __syncthreads();
}
__device__ __forceinline__ void p0_s5_item(ArgsP a, int e, int tid) {
    if (tid >= 64) return;
    const int p = tid, ldg = e;
    const int gp = ldg * 64 + p;
    const float a_re = a->in[IN_ARE][gp], a_im = a->in[IN_AIM][gp], dt = expf(a->in[IN_LOGDT][ldg]);
    const float mag = expf(a_re * dt), lam_re = mag * cosf(a_im * dt), lam_im = mag * sinf(a_im * dt);
    const float denom = a_re * a_re + a_im * a_im, nr = lam_re - 1.0f, ni = lam_im;
    const float f_re = (nr * a_re + ni * a_im) / denom, f_im = (ni * a_re - nr * a_im) / denom;
    float* LAM = (float*)(a->ws + WS_LAM); bf16* BB = (bf16*)(a->ws + WS_BB); bf16* CM = (bf16*)(a->ws + WS_CM);
    LAM[gp * 2 + 0] = lam_re; LAM[gp * 2 + 1] = lam_im;
    const float* bre = a->in[IN_BRE] + (size_t)gp * 16; const float* bim = a->in[IN_BIM] + (size_t)gp * 16;
#pragma unroll
    for (int h = 0; h < 16; h += 2) {
        const float r0 = f_re * bre[h] - f_im * bim[h], i0 = f_re * bim[h] + f_im * bre[h];
        const float r1 = f_re * bre[h + 1] - f_im * bim[h + 1], i1 = f_re * bim[h + 1] + f_im * bre[h + 1];
        *(unsigned*)(BB + ((size_t)ldg * 128 + p) * 16 + h) = pk2(r0, r1);
        *(unsigned*)(BB + ((size_t)ldg * 128 + 64 + p) * 16 + h) = pk2(i0, i1);
    }
    const float* cre = a->in[IN_CRE] + (size_t)ldg * 16 * 64; const float* cim = a->in[IN_CIM] + (size_t)ldg * 16 * 64;
#pragma unroll
    for (int h = 0; h < 16; ++h) *(unsigned*)(CM + ((size_t)ldg * 16 + h) * 128 + 2 * p) = pk2(cre[h * 64 + p], -cim[h * 64 + p]);
}
__device__ __forceinline__ void p0_fold_tile(ArgsP a, int l, int wt, int lane) {
    const int nb = wt / 48, cbk = wt % 48, g = cbk / 12, c0 = (cbk % 12) * 32, n0 = nb * 32;
    const float* wout = a->in[IN_WOUT] + (size_t)l * DM * DM + (size_t)(g * PGRP) * DM + n0 + (lane & 31);
    const float* wpool = a->in[IN_WPOOL] + ((size_t)(l * 4 + g) * PGRP + c0 + (lane & 31)) * PGRP;
    const float* ps = a->in[IN_PSCALE] + l * POOLW + g * PGRP;
    f32x16 acc;
#pragma unroll
    for (int r = 0; r < 16; ++r) acc[r] = 0.f;
    const int h8 = 8 * (lane >> 5);
    for (int d0 = 0; d0 < PGRP; d0 += 16) {
        float av[8];
#pragma unroll
        for (int j = 0; j < 8; ++j) av[j] = wout[(size_t)(d0 + h8 + j) * DM] * ps[d0 + h8 + j];
        const f32x4 b0 = *(const f32x4*)(wpool + d0 + h8), b1 = *(const f32x4*)(wpool + d0 + h8 + 4);
        u32x4 aw, bw;
        aw.x = pk2(av[0], av[1]); aw.y = pk2(av[2], av[3]); aw.z = pk2(av[4], av[5]); aw.w = pk2(av[6], av[7]);
        bw.x = pk2(b0.x, b0.y); bw.y = pk2(b0.z, b0.w); bw.z = pk2(b1.x, b1.y); bw.w = pk2(b1.z, b1.w);
        acc = __builtin_amdgcn_mfma_f32_32x32x16_bf16(__builtin_bit_cast(bf16x8, aw), __builtin_bit_cast(bf16x8, bw), acc, 0, 0, 0);
    }
    asm volatile("s_nop 15\n\ts_nop 15\n\ts_nop 15\n\ts_nop 15" : "+v"(acc));
    bf16* WT = (bf16*)(a->ws + WS_WT) + (size_t)l * WT_LAYER + WT_COMB;
#pragma unroll
    for (int r = 0; r < 16; ++r) { const int n = n0 + (r & 3) + 8 * (r >> 2) + 4 * (lane >> 5);
        WT[(size_t)n * DM + g * PGRP + c0 + (lane & 31)] = (bf16)(pk2(acc[r], 0.f) & 0xffffu); }
}
__device__ __forceinline__ void p0_transpose_tile(const float* W, int N, bf16* WT, int ldt, int kdst, LAS float* scr, int kb, int nb, int lane) {
    const int k0 = 64 * kb, n0 = 32 * nb;
#pragma unroll 8
    for (int i = 0; i < 32; ++i) { const int kk = 2 * i + (lane >> 5); scr[kk * 33 + (lane & 31)] = __builtin_nontemporal_load(W + (size_t)(k0 + kk) * N + n0 + (lane & 31)); }
    asm volatile("s_waitcnt lgkmcnt(0)" ::: "memory");
    const int c = lane & 7;
#pragma unroll
    for (int j = 0; j < 4; ++j) { const int n = (lane >> 3) + 8 * j; const LAS float* s = scr + (8 * c) * 33 + n;
        u32x4 o; o.x = pk2(s[0 * 33], s[1 * 33]); o.y = pk2(s[2 * 33], s[3 * 33]); o.z = pk2(s[4 * 33], s[5 * 33]); o.w = pk2(s[6 * 33], s[7 * 33]);
        *(u32x4*)(WT + (size_t)(n0 + n) * ldt + kdst + k0 + 8 * c) = o; }
    asm volatile("s_waitcnt lgkmcnt(0)" ::: "memory");
}
constexpr int Q_MOD = 192, Q_S5 = 256, Q_FOLD = 4 * 384;
constexpr int TI_IN = 32 * 8, TI_OUTS = 8 * 8, TI_UP = 32 * 44, TI_DOWN = 88 * 8, TI_GLU = 8 * 2, TI_LAYER = TI_IN + TI_OUTS + TI_UP + TI_DOWN + TI_GLU;
constexpr int Q_TOTAL = Q_MOD + Q_S5 + Q_FOLD + 4 * TI_LAYER;
__device__ __forceinline__ void p0_transpose_item(ArgsP a, LAS unsigned char* lds, int it, int wave, int lane) {
    const int l = it / TI_LAYER; int r = it % TI_LAYER;
    LAS float* scr = (LAS float*)(lds + wave * 16384);
    bf16* WTL = (bf16*)(a->ws + WS_WT) + (size_t)l * WT_LAYER;
    if (r < TI_IN) { p0_transpose_tile(a->in[IN_WIN] + (size_t)l * DM * DM, DM, WTL + WT_IN, DM, 0, scr, r / 8, (r % 8) * 8 + wave, lane); return; } r -= TI_IN;
    if (r < TI_OUTS) { p0_transpose_tile(a->in[IN_WOUT] + (size_t)l * DM * DM + (size_t)POOLW * DM, DM, WTL + WT_COMB, DM, POOLW, scr, r / 8, (r % 8) * 8 + wave, lane); return; } r -= TI_OUTS;
    if (r < TI_UP) { p0_transpose_tile(a->in[IN_WUP] + (size_t)l * DM * DFF2, DFF2, WTL + WT_UP, DM, 0, scr, r / 44, (r % 44) * 8 + wave, lane); return; } r -= TI_UP;
    if (r < TI_DOWN) { p0_transpose_tile(a->in[IN_WDOWN] + (size_t)l * DFF * DM, DM, WTL + WT_DOWN, DFF, 0, scr, r / 8, (r % 8) * 8 + wave, lane); return; } r -= TI_DOWN;
    p0_transpose_tile(a->in[IN_WGLU] + (size_t)l * SSMW * SSMW, SSMW, WTL + WT_GLU, SSMW, 0, scr, r / 2, (r % 2) * 8 + wave, lane);
}
__device__ __forceinline__ void phase_prologue(ArgsP a, LAS unsigned char* lds, int tid, int wave, int lane) {
    unsigned* qhead = (unsigned*)(a->ws + WS_CTL) + CW_QUEUE;
    volatile LAS unsigned* slot = (volatile LAS unsigned*)(lds + MISC_OFF + 64);
    for (;;) {
        if (tid == 0) slot[0] = __hip_atomic_fetch_add(qhead, 1u, __ATOMIC_RELAXED, __HIP_MEMORY_SCOPE_AGENT);
        __syncthreads();
        const int it = (int)slot[0];
        __syncthreads();
        if (it >= Q_TOTAL) break;
        if (it < Q_MOD) { p0_mod_item(a, lds, it, tid); continue; }
        if (it < Q_MOD + Q_S5) { p0_s5_item(a, it - Q_MOD, tid); continue; }
        if (it < Q_MOD + Q_S5 + Q_FOLD) { const int f = it - Q_MOD - Q_S5; p0_fold_tile(a, f / 384, (f % 384) * 8 + wave, lane); continue; }
        p0_transpose_item(a, lds, it - Q_MOD - Q_S5 - Q_FOLD, wave, lane);
    }
}

struct NormP {
    const bf16* y; int y_row0;
    const float* xin_lat; const float* xin_ctx;
    bf16* xb;
    float* out_f32;
    bf16* h;
    const float* gate; const float* g_post;
    const float* g_pre; const float* shift; const float* scale;
};
__device__ __forceinline__ void phase_norm(const NormP& P, int r0, int r1, int gw, int ngw, int lane) {
    const int nrows = r1 - r0, per = (nrows + ngw - 1) / ngw;
    int m = r0 + gw * per; const int mend = (m + per < r1) ? m + per : r1;
    int curj = -1;
    f32x4 A1[8], A2[8], SH[8];
#pragma unroll
    for (int i = 0; i < 8; ++i) { A1[i] = (f32x4){0.f, 0.f, 0.f, 0.f}; A2[i] = A1[i]; SH[i] = A1[i]; }
    for (; m < mend; ++m) {
        const int j = (m < MLAT) ? (m >> 12) : 8;
        if (j != curj) { curj = j;
#pragma unroll
            for (int jj = 0; jj < 4; ++jj)
#pragma unroll
                for (int hh = 0; hh < 2; ++hh) { const int e = 512 * jj + 8 * lane + 4 * hh;
                    if (P.y) A1[jj * 2 + hh] = *(const f32x4*)(P.gate + (size_t)j * 6 * DM + e) * *(const f32x4*)(P.g_post + e);
                    if (P.h) { A2[jj * 2 + hh] = *(const f32x4*)(P.g_pre + e) * (*(const f32x4*)(P.scale + (size_t)j * 6 * DM + e) + 1.0f); SH[jj * 2 + hh] = *(const f32x4*)(P.shift + (size_t)j * 6 * DM + e); } }
        }
        f32x4 xv[8];
        if (P.xin_lat) {
            const float* xs = (m < MLAT) ? P.xin_lat + (size_t)m * DM : P.xin_ctx + (size_t)(m - MLAT) * DM;
#pragma unroll
            for (int jj = 0; jj < 4; ++jj) { xv[2 * jj] = __builtin_nontemporal_load((const f32x4*)(xs + 512 * jj + 8 * lane)); xv[2 * jj + 1] = __builtin_nontemporal_load((const f32x4*)(xs + 512 * jj + 8 * lane + 4)); }
        } else {
            const bf16* xs = P.xb + (size_t)m * DM;
#pragma unroll
            for (int jj = 0; jj < 4; ++jj) { const u32x4 w = __builtin_nontemporal_load((const u32x4*)(xs + 512 * jj + 8 * lane));
                xv[2 * jj] = (f32x4){bflo(w.x), bfhi(w.x), bflo(w.y), bfhi(w.y)}; xv[2 * jj + 1] = (f32x4){bflo(w.z), bfhi(w.z), bflo(w.w), bfhi(w.w)}; }
        }
        if (P.y) {
            const bf16* yr = P.y + (size_t)(m - P.y_row0) * DM;
            f32x4 yv[8]; float ss = 0.f;
#pragma unroll
            for (int jj = 0; jj < 4; ++jj) { const u32x4 w = __builtin_nontemporal_load((const u32x4*)(yr + 512 * jj + 8 * lane));
                yv[2 * jj] = (f32x4){bflo(w.x), bfhi(w.x), bflo(w.y), bfhi(w.y)}; yv[2 * jj + 1] = (f32x4){bflo(w.z), bfhi(w.z), bflo(w.w), bfhi(w.w)}; }
#pragma unroll
            for (int i = 0; i < 8; ++i) ss += (yv[i].x * yv[i].x + yv[i].y * yv[i].y) + (yv[i].z * yv[i].z + yv[i].w * yv[i].w);
            const float rstd = 1.0f / sqrtf(wave_sum(ss) * (1.0f / DM) + EPSN);
#pragma unroll
            for (int i = 0; i < 8; ++i) xv[i] += A1[i] * (yv[i] * rstd);
        }
        if (P.out_f32) {
            float* xd = P.out_f32 + (size_t)m * DM;
#pragma unroll
            for (int jj = 0; jj < 4; ++jj) { *(f32x4*)(xd + 512 * jj + 8 * lane) = xv[2 * jj]; *(f32x4*)(xd + 512 * jj + 8 * lane + 4) = xv[2 * jj + 1]; }
        } else {
            bf16* xd = P.xb + (size_t)m * DM;
#pragma unroll
            for (int jj = 0; jj < 4; ++jj) { u32x4 w; w.x = pk2(xv[2 * jj].x, xv[2 * jj].y); w.y = pk2(xv[2 * jj].z, xv[2 * jj].w); w.z = pk2(xv[2 * jj + 1].x, xv[2 * jj + 1].y); w.w = pk2(xv[2 * jj + 1].z, xv[2 * jj + 1].w);
                st16_wt(xd + 512 * jj + 8 * lane, w); }
        }
        if (P.h) {
            float ss = 0.f;
#pragma unroll
            for (int i = 0; i < 8; ++i) ss += (xv[i].x * xv[i].x + xv[i].y * xv[i].y) + (xv[i].z * xv[i].z + xv[i].w * xv[i].w);
            const float rstd = 1.0f / sqrtf(wave_sum(ss) * (1.0f / DM) + EPSN);
            bf16* hr = P.h + (size_t)m * DM;
#pragma unroll
            for (int jj = 0; jj < 4; ++jj) { const f32x4 o0 = xv[2 * jj] * rstd * A2[2 * jj] + SH[2 * jj], o1 = xv[2 * jj + 1] * rstd * A2[2 * jj + 1] + SH[2 * jj + 1];
                u32x4 w; w.x = pk2(o0.x, o0.y); w.y = pk2(o0.z, o0.w); w.z = pk2(o1.x, o1.y); w.w = pk2(o1.z, o1.w);
                st16_wt(hr + 512 * jj + 8 * lane, w); }
        }
    }
}

#define POOL_ACC(sgn, VV) do { const u32x4 q_ = (VV); s[0] sgn bflo(q_.x); s[1] sgn bfhi(q_.x); s[2] sgn bflo(q_.y); s[3] sgn bfhi(q_.y); s[4] sgn bflo(q_.z); s[5] sgn bfhi(q_.z); s[6] sgn bflo(q_.w); s[7] sgn bfhi(q_.w); } while (0)
template <int H> __device__ __forceinline__ void pool_batch(const bf16* u, bf16* PA, int m0, int ch0) {
    constexpr int NR = 7 + 2 * H;
    int base, t0, n;
    if (m0 < MLAT) { base = m0 & ~(SEQ - 1); t0 = m0 & (SEQ - 1); n = SEQ; } else { const int mm = m0 - MLAT; base = MLAT + (mm & ~(CTXL - 1)); t0 = mm & (CTXL - 1); n = CTXL; }
    u32x4 v[NR];
#pragma unroll
    for (int k = 0; k < NR; ++k) { const int tt = t0 - H + k; v[k] = (u32x4){0u, 0u, 0u, 0u}; if (tt >= 0 && tt < n) v[k] = *(const u32x4*)(u + (size_t)(base + tt) * DM + ch0); }
    float s[8];
#pragma unroll
    for (int e = 0; e < 8; ++e) s[e] = 0.f;
#pragma unroll
    for (int k = 0; k < 2 * H; ++k) POOL_ACC(+=, v[k]);
#pragma unroll
    for (int i = 0; i < 8; ++i) {
        if (i > 0) { POOL_ACC(+=, v[i + 2 * H - 1]); POOL_ACC(-=, v[i - 1]); }
        const int t = t0 + i, lo = (t - H > 0) ? t - H : 0, hi = (t + H < n) ? t + H : n;
        const float inv = 1.0f / (float)(hi - lo);
        const u32x4 c = v[H + i];
        u32x4 o; o.x = pk2(s[0] * inv - bflo(c.x), s[1] * inv - bfhi(c.x)); o.y = pk2(s[2] * inv - bflo(c.y), s[3] * inv - bfhi(c.y));
        o.z = pk2(s[4] * inv - bflo(c.z), s[5] * inv - bfhi(c.z)); o.w = pk2(s[6] * inv - bflo(c.w), s[7] * inv - bfhi(c.w));
        st16_wt(PA + (size_t)(m0 + i) * DM + ch0, o);
    }
}
__device__ __forceinline__ void pool_rows(const bf16* u, bf16* PA, int row0, int nbatch, int pw  , int lane) {
    if (lane >= 48) return;
    for (int it = pw; it < nbatch * 4; it += 4) {
        const int batch = it >> 2, grp = (it + batch) & 3, m0 = row0 + 8 * batch, ch0 = grp * PGRP + 8 * lane;
        if (grp == 0) pool_batch<1>(u, PA, m0, ch0); else if (grp == 1) pool_batch<2>(u, PA, m0, ch0); else if (grp == 2) pool_batch<4>(u, PA, m0, ch0); else pool_batch<8>(u, PA, m0, ch0);
    }
}
__device__ __forceinline__ int chain_row(int q, int dir, int b) {
    if (q < CTXL) { const int tt = dir ? (CTXL - 1 - q) : q; return MLAT + b * CTXL + tt; }
    const int qq = q - CTXL; const int tt = dir ? (SEQ - 1 - qq) : qq; return b * SEQ + tt;
}
constexpr int STASH_KCB = 528, STASH_BUFB = 16 * STASH_KCB;
__device__ __forceinline__ void ssm_chain(LAS unsigned char* stash, const bf16* u, bf16* Y, const float* LAM, const bf16* BB, const bf16* CM, int l, int b, int g, int dir, int lane) {
    const int ldg = (l * 2 + dir) * NGRP + g;
    const float lr = LAM[(ldg * 64 + lane) * 2], li = LAM[(ldg * 64 + lane) * 2 + 1];
    bf16x8 Bf[4], Cf[4];
#pragma unroll
    for (int cb = 0; cb < 4; ++cb) Bf[cb] = *(const bf16x8*)(BB + ((size_t)ldg * 128 + cb * 32 + (lane & 31)) * 16 + 8 * (lane >> 5));
#pragma unroll
    for (int ks = 0; ks < 4; ++ks) Cf[ks] = *(const bf16x8*)(CM + ((size_t)ldg * 16 + (lane & 15)) * 128 + 32 * ks + 8 * (lane >> 4));
    float hr = 0.f, hi = 0.f;
    const int ucol = POOLW + SGRP * g + 8 * (lane >> 5);
    const int sgn = dir ? -1 : 1;
    const int uoff = sgn * (lane & 31) * DM + ucol;
    const int yo0 = sgn * (lane & 15) * SSMW + SGRP * g + 4 * (lane >> 4), yo1 = yo0 + sgn * 16 * SSMW;
    const unsigned wad = (unsigned)(size_t)(stash + (lane >> 2) * STASH_KCB + (lane & 3) * 4);
    bf16x8 cur[8], nxt[8];
#pragma unroll
    for (int c = 0; c < 8; ++c) cur[c] = *(const bf16x8*)(u + (ptrdiff_t)chain_row(32 * c, dir, b) * DM + uoff);
    for (int sc = 0; sc < 17; ++sc) {
        if (sc + 1 < 17) {
#pragma unroll
            for (int c = 0; c < 8; ++c) nxt[c] = *(const bf16x8*)(u + (ptrdiff_t)chain_row(256 * (sc + 1) + 32 * c, dir, b) * DM + uoff);
        }
#pragma unroll
        for (int c = 0; c < 8; ++c) {
            const int q0 = 256 * sc + 32 * c;
            const LAS unsigned char* stp = stash + ((c & 1) ^ 1) * STASH_BUFB;
            bf16x8 a0[4], a1[4];
#pragma unroll
            for (int ks = 0; ks < 4; ++ks) {
                a0[ks] = *(const LAS bf16x8*)(stp + (4 * ks + (lane >> 4)) * STASH_KCB + (lane & 15) * 16);
                a1[ks] = *(const LAS bf16x8*)(stp + (4 * ks + (lane >> 4)) * STASH_KCB + (16 + (lane & 15)) * 16);
            }
            f32x16 z16;
#pragma unroll
            for (int r = 0; r < 16; ++r) z16[r] = 0.f;
            f32x16 D0 = __builtin_amdgcn_mfma_f32_32x32x16_bf16(cur[c], Bf[0], z16, 0, 0, 0);
            f32x16 D1 = __builtin_amdgcn_mfma_f32_32x32x16_bf16(cur[c], Bf[1], z16, 0, 0, 0);
            f32x16 D2 = __builtin_amdgcn_mfma_f32_32x32x16_bf16(cur[c], Bf[2], z16, 0, 0, 0);
            f32x16 D3 = __builtin_amdgcn_mfma_f32_32x32x16_bf16(cur[c], Bf[3], z16, 0, 0, 0);
            f32x4 acc0 = (f32x4){0.f, 0.f, 0.f, 0.f}, acc1 = acc0;
            asm volatile("" : "+v"(D0), "+v"(D1), "+v"(D2), "+v"(D3), "+v"(acc0), "+v"(acc1) :: "memory");
#pragma unroll
            for (int ks = 0; ks < 4; ++ks) {
                acc0 = __builtin_amdgcn_mfma_f32_16x16x32_bf16(Cf[ks], a0[ks], acc0, 0, 0, 0);
                acc1 = __builtin_amdgcn_mfma_f32_16x16x32_bf16(Cf[ks], a1[ks], acc1, 0, 0, 0);
            }
            asm volatile("s_waitcnt lgkmcnt(0)\n\ts_nop 15\n\ts_nop 15" : "+v"(acc0), "+v"(acc1) :: "memory");
            if (q0 > 0) {
                bf16* yb = Y + (ptrdiff_t)chain_row(q0 - 32, dir, b) * SSMW;
                u32x2 w0, w1; w0.x = pk2(acc0[0], acc0[1]); w0.y = pk2(acc0[2], acc0[3]); w1.x = pk2(acc1[0], acc1[1]); w1.y = pk2(acc1[2], acc1[3]);
                *(u32x2*)(yb + yo0) = w0;
                *(u32x2*)(yb + yo1) = w1;
            }
            asm volatile("s_nop 3" : "+v"(D0), "+v"(D1), "+v"(D2), "+v"(D3));
            float bre[32], bim[32];
#pragma unroll
            for (int r = 0; r < 16; ++r) { const int p0 = (r & 3) + 8 * (r >> 2);
                auto rr = __builtin_amdgcn_permlane32_swap(__float_as_uint(D0[r]), __float_as_uint(D1[r]), false, false);
                bre[p0] = __uint_as_float(rr[0]); bre[p0 + 4] = __uint_as_float(rr[1]);
                auto ri = __builtin_amdgcn_permlane32_swap(__float_as_uint(D2[r]), __float_as_uint(D3[r]), false, false);
                bim[p0] = __uint_as_float(ri[0]); bim[p0 + 4] = __uint_as_float(ri[1]); }
#pragma unroll
            for (int pos = 0; pos < 32; pos += 2) {
                const float nr = fmaf(-li, hi, fmaf(lr, hr, bre[pos]));
                const float ni = fmaf(li, hr, fmaf(lr, hi, bim[pos]));
                const unsigned p0 = pk2(nr, ni);
                hr = fmaf(-li, ni, fmaf(lr, nr, bre[pos + 1]));
                hi = fmaf(li, nr, fmaf(lr, ni, bim[pos + 1]));
                const unsigned p1 = pk2(hr, hi);
                asm volatile("ds_write2_b32 %0, %1, %2 offset0:%3 offset1:%4" :: "v"(wad + (unsigned)((c & 1) * STASH_BUFB)), "v"(p0), "v"(p1), "n"(4 * pos), "n"(4 * pos + 4) : "memory");
            }
        }
#pragma unroll
        for (int c = 0; c < 8; ++c) cur[c] = nxt[c];
    }
    {
        const LAS unsigned char* stp = stash + 1 * STASH_BUFB;
        asm volatile("s_waitcnt lgkmcnt(0)" ::: "memory");
        f32x4 acc0 = (f32x4){0.f, 0.f, 0.f, 0.f}, acc1 = acc0;
#pragma unroll
        for (int ks = 0; ks < 4; ++ks) {
            const bf16x8 a0 = *(const LAS bf16x8*)(stp + (4 * ks + (lane >> 4)) * STASH_KCB + (lane & 15) * 16);
            const bf16x8 a1 = *(const LAS bf16x8*)(stp + (4 * ks + (lane >> 4)) * STASH_KCB + (16 + (lane & 15)) * 16);
            acc0 = __builtin_amdgcn_mfma_f32_16x16x32_bf16(Cf[ks], a0, acc0, 0, 0, 0);
            acc1 = __builtin_amdgcn_mfma_f32_16x16x32_bf16(Cf[ks], a1, acc1, 0, 0, 0);
        }
        asm volatile("s_waitcnt lgkmcnt(0)\n\ts_nop 15\n\ts_nop 15" : "+v"(acc0), "+v"(acc1) :: "memory");
        bf16* yb = Y + (ptrdiff_t)chain_row(256 * 16 + 32 * 7, dir, b) * SSMW;
        u32x2 w0, w1; w0.x = pk2(acc0[0], acc0[1]); w0.y = pk2(acc0[2], acc0[3]); w1.x = pk2(acc1[0], acc1[1]); w1.y = pk2(acc1[2], acc1[3]);
        *(u32x2*)(yb + yo0) = w0;
        *(u32x2*)(yb + yo1) = w1;
    }
}
__device__ __forceinline__ void phase_mix_a(ArgsP a, LAS unsigned char* lds, int l, int mrows, int wave, int lane, int tid) {
    const bf16* u = (const bf16*)(a->ws + WS_BUFB);
    if (wave < 2) {
        const int bx = blockIdx.x, xcd = bx & 7, jj = bx >> 3;
        for (int it = jj; it < 32; it += (int)(gridDim.x >> 3)) {
            const int g = 4 * xcd + (it & 3), b = it >> 2;
            bf16* Y = (bf16*)(a->ws + WS_BUFA) + (size_t)wave * MALL * SSMW;
            ssm_chain(lds + wave * 32768, u, Y, (const float*)(a->ws + WS_LAM), (const bf16*)(a->ws + WS_BB), (const bf16*)(a->ws + WS_CM), l, b, g, wave, lane);
        }
    } else if (wave != 4 && wave != 5) {
        const int per = mrows / 256;
        for (int wgi = blockIdx.x; wgi < 256; wgi += gridDim.x) pool_rows(u, (bf16*)(a->ws + WS_BUFC), wgi * per, per / 8, (wave < 4) ? wave - 2 : wave - 4, lane);
    }
}

__device__ __forceinline__ float gelu_tanh(float x) { const float z = 0.7978845608028654f * (x + 0.044715f * x * x * x); return x * sigmoidf_(2.0f * z); }
__device__ __forceinline__ int glu_lds_off(int row, int chunk) { return row * 1024 + ((chunk ^ (row & 15)) << 4); }
__device__ __forceinline__ void phase_mix_b(ArgsP a, LAS unsigned char* lds, int l, int mrows, int tid, int wave, int lane) {
    const bf16* Y0 = (const bf16*)(a->ws + WS_BUFA); const bf16* Y1 = Y0 + (size_t)MALL * SSMW;
    const bf16* u = (const bf16*)(a->ws + WS_BUFB);
    const float* Dv = a->in[IN_SSMD] + l * SSMW;
    const bf16* Wg = (const bf16*)(a->ws + WS_WT) + (size_t)l * WT_LAYER + WT_GLU;
    bf16* PA = (bf16*)(a->ws + WS_BUFC);
    const int RPW = mrows / 256;
    for (int wgi = blockIdx.x; wgi < 256; wgi += gridDim.x) {
        const int row0 = wgi * RPW;
        {
            const int c = lane, k0 = 8 * c;
            const f32x4 d0 = *(const f32x4*)(Dv + k0), d1 = *(const f32x4*)(Dv + k0 + 4);
#pragma unroll 4
            for (int i = 0; i < RPW / 8; ++i) {
                const int r = wave + 8 * i; const size_t mr = (size_t)(row0 + r);
                const u32x4 y0w = __builtin_nontemporal_load((const u32x4*)(Y0 + mr * SSMW + k0)), y1w = __builtin_nontemporal_load((const u32x4*)(Y1 + mr * SSMW + k0));
                const f32x4 y00 = (f32x4){bflo(y0w.x), bfhi(y0w.x), bflo(y0w.y), bfhi(y0w.y)}, y01 = (f32x4){bflo(y0w.z), bfhi(y0w.z), bflo(y0w.w), bfhi(y0w.w)};
                const f32x4 y10 = (f32x4){bflo(y1w.x), bfhi(y1w.x), bflo(y1w.y), bfhi(y1w.y)}, y11 = (f32x4){bflo(y1w.z), bfhi(y1w.z), bflo(y1w.w), bfhi(y1w.w)};
                const u32x4 uw = *(const u32x4*)(u + mr * DM + POOLW + k0);
                const f32x4 u0 = (f32x4){bflo(uw.x), bfhi(uw.x), bflo(uw.y), bfhi(uw.y)}, u1 = (f32x4){bflo(uw.z), bfhi(uw.z), bflo(uw.w), bfhi(uw.w)};
                const f32x4 v0 = y00 + y10 + d0 * u0, v1 = y01 + y11 + d1 * u1;
                u32x4 w; w.x = pk2(gelu_tanh(v0.x), gelu_tanh(v0.y)); w.y = pk2(gelu_tanh(v0.z), gelu_tanh(v0.w)); w.z = pk2(gelu_tanh(v1.x), gelu_tanh(v1.y)); w.w = pk2(gelu_tanh(v1.z), gelu_tanh(v1.w));
                *(LAS u32x4*)(lds + glu_lds_off(r, c)) = w;
            }
        }
        __syncthreads();
#pragma unroll 1
        for (int mh = 0; mh < 2; ++mh) {
            const int fr = lane & 15, kq = lane >> 4, nbase = 64 * wave, mb0 = 5 * mh;
            f32x4 acc[5][4];
#pragma unroll
            for (int mb = 0; mb < 5; ++mb)
#pragma unroll
                for (int nb = 0; nb < 4; ++nb) acc[mb][nb] = (f32x4){0.f, 0.f, 0.f, 0.f};
            const bf16* wrow = Wg + (size_t)(nbase + fr) * SSMW + 8 * kq;
            bf16x8 Wc[4], Wn[4];
#pragma unroll
            for (int nb = 0; nb < 4; ++nb) Wc[nb] = *(const bf16x8*)(wrow + (size_t)(16 * nb) * SSMW);
#pragma unroll 1
            for (int ks = 0; ks < 16; ++ks) {
                if (ks + 1 < 16) {
#pragma unroll
                    for (int nb = 0; nb < 4; ++nb) Wn[nb] = *(const bf16x8*)(wrow + (size_t)(16 * nb) * SSMW + 32 * (ks + 1));
                }
#pragma unroll
                for (int mb = 0; mb < 5; ++mb) {
                    int rr = 16 * (mb0 + mb) + fr; rr = rr < RPW ? rr : RPW - 1;
                    const bf16x8 af = *(const LAS bf16x8*)(lds + glu_lds_off(rr, 4 * ks + kq));
#pragma unroll
                    for (int nb = 0; nb < 4; ++nb) acc[mb][nb] = __builtin_amdgcn_mfma_f32_16x16x32_bf16(Wc[nb], af, acc[mb][nb], 0, 0, 0);
                }
#pragma unroll
                for (int nb = 0; nb < 4; ++nb) Wc[nb] = Wn[nb];
            }
#pragma unroll
            for (int mb = 0; mb < 5; ++mb) {
                const int tok = 16 * (mb0 + mb) + fr;
                if (tok < RPW) {
#pragma unroll
                    for (int nb = 0; nb < 4; ++nb) {
                        const int n = nbase + 16 * nb + 4 * kq;
                        const u32x2 yw = *(const LAS u32x2*)(lds + glu_lds_off(tok, n >> 3) + (n & 7) * 2);
                        const f32x4 g = acc[mb][nb];
                        u32x2 o; o.x = pk2(bflo(yw.x) * sigmoidf_(g.x), bfhi(yw.x) * sigmoidf_(g.y)); o.y = pk2(bflo(yw.y) * sigmoidf_(g.z), bfhi(yw.y) * sigmoidf_(g.w));
                        *(u32x2*)(PA + (size_t)(row0 + tok) * DM + POOLW + n) = o;
                    }
                }
            }
        }
        __syncthreads();
    }
}

struct ConvF { f32x4 v[3], g[3]; };
constexpr int CV_ROWB = 1024, CV_COLB = 10 * CV_ROWB, CV_PAIRB = 2 * CV_COLB, CV_DEPTH = 6;
__device__ __forceinline__ void conv_wg_item(LAS unsigned char* lds, const bf16* z  , bf16* aout  , const float* wc, int mloc0, int mglob0, int cg, int wave, int lane) {
    const bool ctx = mglob0 >= MLAT;
    const int gr0 = (mglob0 >> 6) & 63;
    const int f0c = cg * 256, f0 = f0c + 4 * lane;
    f32x4 wv[3][3], wg[3][3];
#pragma unroll
    for (int i = 0; i < 3; ++i)
#pragma unroll
        for (int j = 0; j < 3; ++j) { wv[i][j] = *(const f32x4*)(wc + (size_t)(i * 3 + j) * DFF2 + f0); wg[i][j] = *(const f32x4*)(wc + (size_t)(i * 3 + j) * DFF2 + DFF + f0); }
    asm volatile("s_waitcnt vmcnt(0)" : "+v"(wv[0][0]), "+v"(wv[0][1]), "+v"(wv[0][2]), "+v"(wv[1][0]), "+v"(wv[1][1]), "+v"(wv[1][2]), "+v"(wv[2][0]), "+v"(wv[2][1]), "+v"(wv[2][2]),
                 "+v"(wg[0][0]), "+v"(wg[0][1]), "+v"(wg[0][2]), "+v"(wg[1][0]), "+v"(wg[1][1]), "+v"(wg[1][2]), "+v"(wg[2][0]), "+v"(wg[2][1]), "+v"(wg[2][2]) :: "memory");
    const int mrun = mglob0 + 64 * wave;
    bool up, down, left, right;
    if (!ctx) { const int gr = (mrun >> 6) & 63; up = gr > 0; down = gr < 63; left = false; right = false; }
    else { const int seg = ((mrun - MLAT) >> 6) & 3; up = false; down = false; left = seg > 0; right = seg < 3; }
    bf16* ao = aout + (size_t)(mloc0 + 64 * wave) * DFF + f0;
    const int lane_off = (lane < 32) ? (f0c + 8 * lane) : (DFF + f0c + 8 * (lane - 32));
#define CV_DMA(hr, k, p, kc) do { int jj_ = (hr) - 1; bool rv_; \
        if (!ctx) { rv_ = (jj_ >= 0 && jj_ < 8) || (jj_ < 0 && gr0 > 0) || (jj_ == 8 && gr0 + 8 < 64); } else { rv_ = (jj_ >= 0 && jj_ < 8); } \
        if (!rv_) jj_ = jj_ < 0 ? 0 : 7; \
        int kk_ = (k); bool cv_ = (kk_ >= 0 && kk_ < GRIDW); \
        if (!cv_ && ctx && rv_) { const int sg_ = ((mglob0 + 64 * jj_ - MLAT) >> 6) & 3; cv_ = (kk_ < 0) ? (sg_ > 0) : (sg_ < 3); } \
        if (!cv_) kk_ = kk_ < 0 ? 0 : GRIDW - 1; \
        const bf16* src_ = z + (size_t)(mloc0 + 64 * jj_ + kk_) * DFF2 + lane_off; \
        __builtin_amdgcn_global_load_lds((const unsigned*)src_, (LAS unsigned*)(lds + ((p) % CV_DEPTH) * CV_PAIRB + (kc) * CV_COLB + (hr) * CV_ROWB), 16, 0, 2); } while (0)
#define CV_DMA_PAIR(p) do { const int pp_ = (p) > 32 ? 32 : (p);   \
        CV_DMA(wave, 2 * pp_ - 1, p, 0); CV_DMA(wave, 2 * pp_, p, 1); \
        if (wave < 2) { CV_DMA(8 + wave, 2 * pp_ - 1, p, 0); CV_DMA(8 + wave, 2 * pp_, p, 1); } } while (0)
#define CV_F4(w2) ((f32x4){bflo((w2).x), bfhi((w2).x), bflo((w2).y), bfhi((w2).y)})
    const f32x4 zero4 = (f32x4){0.f, 0.f, 0.f, 0.f};
#define CV_CVT(slot, p, kc, k) do { const bool cok_ = ((k) >= 0 && (k) < GRIDW) || ((k) < 0 && left) || ((k) >= GRIDW && right); \
        LAS const unsigned char* b_ = lds + ((p) % CV_DEPTH) * CV_PAIRB + (kc) * CV_COLB + wave * CV_ROWB + 8 * lane; \
        _Pragma("unroll") for (int i_ = 0; i_ < 3; ++i_) { const bool ok_ = cok_ && (i_ == 1 || (i_ == 0 && up) || (i_ == 2 && down)); \
            if (ok_) { const u32x2 a_ = *(LAS const u32x2*)(b_ + i_ * CV_ROWB), g_ = *(LAS const u32x2*)(b_ + i_ * CV_ROWB + 512); F[slot].v[i_] = CV_F4(a_); F[slot].g[i_] = CV_F4(g_); } \
            else { F[slot].v[i_] = zero4; F[slot].g[i_] = zero4; } } } while (0)
#define CV_OUT(c, sm, s0, sp) do { f32x4 ov = wv[0][0] * F[sm].v[0], og = wg[0][0] * F[sm].g[0]; \
        ov += wv[1][0] * F[sm].v[1]; og += wg[1][0] * F[sm].g[1]; ov += wv[2][0] * F[sm].v[2]; og += wg[2][0] * F[sm].g[2]; \
        _Pragma("unroll") for (int i_ = 0; i_ < 3; ++i_) { ov += wv[i_][1] * F[s0].v[i_]; og += wg[i_][1] * F[s0].g[i_]; ov += wv[i_][2] * F[sp].v[i_]; og += wg[i_][2] * F[sp].g[i_]; } \
        const f32x4 o_ = ov * og * (f32x4){sigmoidf_(og.x), sigmoidf_(og.y), sigmoidf_(og.z), sigmoidf_(og.w)}; \
        u32x2 w_; w_.x = pk2(o_.x, o_.y); w_.y = pk2(o_.z, o_.w); st8_wt(ao + (size_t)(c) * DFF, w_); } while (0)
#define CV_ARRIVE(p, EXACT) do { if (EXACT) { if (wave < 2) asm volatile("s_waitcnt vmcnt(26)" ::: "memory"); else asm volatile("s_waitcnt vmcnt(18)" ::: "memory"); } \
        else { if (wave < 2) asm volatile("s_waitcnt vmcnt(16)" ::: "memory"); else asm volatile("s_waitcnt vmcnt(8)" ::: "memory"); } \
        asm volatile("s_waitcnt lgkmcnt(0)" ::: "memory"); __builtin_amdgcn_s_barrier(); asm volatile("" ::: "memory"); CV_DMA_PAIR((p) + 5); } while (0)
    ConvF F[4];
    CV_DMA_PAIR(0); CV_DMA_PAIR(1); CV_DMA_PAIR(2); CV_DMA_PAIR(3); CV_DMA_PAIR(4);
    CV_ARRIVE(0, false); CV_CVT(0, 0, 0, -1); CV_CVT(1, 0, 1, 0);
#pragma unroll 1
    for (int q = 0; q < 16; ++q) {
        const int po = 2 * q + 1, pe = 2 * q + 2;
        const bool ex = q >= 3;
        CV_ARRIVE(po, ex); CV_CVT(2, po, 0, 2 * po - 1); CV_CVT(3, po, 1, 2 * po);
        CV_OUT(2 * po - 2, 0, 1, 2); CV_OUT(2 * po - 1, 1, 2, 3);
        CV_ARRIVE(pe, ex); CV_CVT(0, pe, 0, 2 * pe - 1); CV_CVT(1, pe, 1, 2 * pe);
        CV_OUT(2 * pe - 2, 2, 3, 0); CV_OUT(2 * pe - 1, 3, 0, 1);
    }
    asm volatile("s_waitcnt vmcnt(0) lgkmcnt(0)" ::: "memory"); __builtin_amdgcn_s_barrier(); asm volatile("" ::: "memory");
#undef CV_DMA
#undef CV_DMA_PAIR
#undef CV_F4
#undef CV_CVT
#undef CV_OUT
#undef CV_ARRIVE
}
__device__ __forceinline__ void phase_conv(ArgsP a, LAS unsigned char* lds, int l, int r0, int r1, const bf16* z, bf16* aout, int wave, int lane) {
    const float* wc = a->in[IN_WCONV] + (size_t)l * 9 * DFF2;
    const int nitems = ((r1 - r0) / (GRIDW * 8)) * 22;
    for (int it = blockIdx.x; it < nitems; it += gridDim.x) {
        const int rb = it / 22, cg = it % 22;
        conv_wg_item(lds, z, aout, wc, rb * 8 * GRIDW, r0 + rb * 8 * GRIDW, cg, wave, lane);
    }
}

constexpr int PH_PER_LAYER = 13;
constexpr int PH_TOTAL = 2 + DEPTH * PH_PER_LAYER;
constexpr int NORM_WGS = 64;

__global__ void __launch_bounds__(NTHREADS, 2) mk_fwd(Args args) {
    extern __shared__ __attribute__((aligned(16))) unsigned char lds_raw[];
    LAS unsigned char* lds = (LAS unsigned char*)lds_raw;
    const ArgsP kp = (ArgsP)__builtin_amdgcn_kernarg_segment_ptr();
    (void)args;
    volatile LAS unsigned* MISC = (volatile LAS unsigned*)(lds + MISC_OFF);
    if (threadIdx.x < 64) MISC[threadIdx.x] = 0u;
    __syncthreads();
    const int lo = kp->seg_lo, hi = kp->seg_hi;
    XcdBarrier bar; bar.bar = (unsigned*)(kp->ws + WS_CTL) + CW_BAR; bar.x = 0; bar.st = MISC + 8;
    if (hi - lo > 1) bar = xcd_barrier_post((unsigned*)(kp->ws + WS_CTL) + CW_BAR, MISC + 8);
#ifndef PHEN
#define PHEN 0xffff
#endif
#define IN(k) (lo <= (k) && (k) < hi)
#define SEAM(k) do { if ((k) + 1 < hi) xcd_barrier(bar); } while (0)
#define REP(bit) for (int rep_ = 0, nrep_ = ((kp->dup & (bit)) ? 2 : 1); rep_ < nrep_; ++rep_)
#define TIDV int tid_ = threadIdx.x; asm volatile("" : "+v"(tid_)); const int tid = tid_, lane = tid & 63, wave = __builtin_amdgcn_readfirstlane(tid >> 6); const int G = gridDim.x, gw = blockIdx.x * NWAVES + wave, ngw = G * NWAVES; (void)lane; (void)gw; (void)ngw; (void)G

    if ((PHEN & 1) && IN(0)) { TIDV; phase_prologue(launder(kp), lds, tid, wave, lane); SEAM(0); }
    if ((PHEN & 2) && IN(1)) {
        TIDV; const ArgsP a = launder(kp); float* MOD = (float*)(a->ws + WS_MOD);
        NormP P; P.y = nullptr; P.y_row0 = 0; P.xin_lat = a->in[IN_X]; P.xin_ctx = a->in[IN_CTX]; P.xb = (bf16*)(a->ws + WS_XB); P.out_f32 = nullptr; P.h = (bf16*)(a->ws + WS_BUFA);
        P.gate = nullptr; P.g_post = nullptr; P.g_pre = a->in[IN_GPREMIX]; P.shift = MOD + 0 * DM; P.scale = MOD + 1 * DM;
        phase_norm(P, 0, MALL, gw, ngw, lane);
        SEAM(1);
    }
    for (int l = 0; l < DEPTH; ++l) {
        const int pb = 2 + l * PH_PER_LAYER;
        if (pb + PH_PER_LAYER <= lo || pb >= hi) continue;
        const int mrows = (l == DEPTH - 1) ? MLAT : MALL;
        if ((PHEN & 4) && IN(pb + 0)) {
            const ArgsP a = launder(kp); const pg8::bf16_t* WTL = (const pg8::bf16_t*)(a->ws + WS_WT) + (size_t)l * WT_LAYER;
            pg8::Gemm g{(const bf16*)(a->ws + WS_BUFA), WTL + WT_IN, MALL, DM, DM}; pg8::StaticOrder S; S.init(MALL, DM, (int)gridDim.x, (int)blockIdx.x);
            pg8::EpiBf16 E{(bf16*)(a->ws + WS_BUFB), DM};
            REP(4) pg8::gemm_phase<pg8::EpiBf16, pg8::StaticOrder, true, true>(lds, g, S, E);
            SEAM(pb + 0);
        }
        if ((PHEN & 8) && IN(pb + 1)) { TIDV; REP(8) phase_mix_a(launder(kp), lds, l, mrows, wave, lane, tid); SEAM(pb + 1); }
        if ((PHEN & 16) && IN(pb + 2)) { TIDV; REP(16) phase_mix_b(launder(kp), lds, l, mrows, tid, wave, lane); SEAM(pb + 2); }
        if ((PHEN & 32) && IN(pb + 3)) {
            const ArgsP a = launder(kp); const pg8::bf16_t* WTL = (const pg8::bf16_t*)(a->ws + WS_WT) + (size_t)l * WT_LAYER;
            pg8::Gemm g{(const bf16*)(a->ws + WS_BUFC), WTL + WT_COMB, mrows, DM, DM}; pg8::StaticOrder S; S.init(mrows, DM, (int)gridDim.x, (int)blockIdx.x);
            pg8::EpiBf16 E{(bf16*)(a->ws + WS_BUFB), DM};
            REP(4) pg8::gemm_phase<pg8::EpiBf16, pg8::StaticOrder, true, true>(lds, g, S, E);
            SEAM(pb + 3);
        }
        if ((PHEN & 64) && IN(pb + 4)) {
            TIDV; const ArgsP a = launder(kp); const float* MODL = (const float*)(a->ws + WS_MOD) + (size_t)l * 9 * 6 * DM;
            NormP P; P.y = (const bf16*)(a->ws + WS_BUFB); P.y_row0 = 0; P.xin_lat = nullptr; P.xin_ctx = nullptr; P.xb = (bf16*)(a->ws + WS_XB); P.out_f32 = nullptr; P.h = (bf16*)(a->ws + WS_BUFA);
            P.gate = MODL + 2 * DM; P.g_post = a->in[IN_GPOSTMIX] + l * DM; P.g_pre = a->in[IN_GPREFFN] + l * DM; P.shift = MODL + 3 * DM; P.scale = MODL + 4 * DM;
            phase_norm(P, 0, mrows, gw, ngw, lane);
            SEAM(pb + 4);
        }
        for (int hf = 0; hf < 2; ++hf) {
            const int nhalf = kp->nhalf;
            if (hf >= nhalf) break;
            const int r0 = (nhalf == 1) ? 0 : (hf == 0 ? 0 : HALF1_ROW0), r1 = (nhalf == 1) ? mrows : (hf == 0 ? HALF1_ROW0 : mrows);
            const int ph = pb + 5 + 4 * hf;
            const size_t a_off = (nhalf == 1) ? WS_BUFA : WS_BUFB, f_off = (nhalf == 1) ? WS_Z : (hf == 0 ? WS_BUFB + A_HALF : WS_Z);
            const bool pair_norm0 = (nhalf == 2 && l < DEPTH - 1);
            if ((PHEN & 128) && IN(ph + 0)) {
                const ArgsP a = launder(kp); const pg8::bf16_t* WTL = (const pg8::bf16_t*)(a->ws + WS_WT) + (size_t)l * WT_LAYER;
                pg8::Gemm g{(const bf16*)(a->ws + WS_BUFA) + (size_t)r0 * DM, WTL + WT_UP, r1 - r0, DFF2, DM}; pg8::StaticOrder S; S.init(r1 - r0, DFF2, (int)gridDim.x, (int)blockIdx.x);
                pg8::EpiBf16 E{(bf16*)(a->ws + WS_Z), DFF2};
                REP(4) pg8::gemm_phase<pg8::EpiBf16, pg8::StaticOrder, true, true>(lds, g, S, E);
                SEAM(ph + 0);
            }
            if ((PHEN & 256) && IN(ph + 1)) { TIDV; const ArgsP a = launder(kp); REP(256) phase_conv(a, lds, l, r0, r1, (const bf16*)(a->ws + WS_Z), (bf16*)(a->ws + a_off), wave, lane); SEAM(ph + 1); }
            if ((PHEN & 512) && IN(ph + 2)) {
                const bool paired = pair_norm0 && hf == 1;
                const int gG = paired ? (int)gridDim.x - NORM_WGS : (int)gridDim.x;
                if ((int)blockIdx.x < gG) {
                    const ArgsP a = launder(kp); const pg8::bf16_t* WTL = (const pg8::bf16_t*)(a->ws + WS_WT) + (size_t)l * WT_LAYER;
                    pg8::Gemm g{(const bf16*)(a->ws + a_off), WTL + WT_DOWN, r1 - r0, DM, DFF}; pg8::StaticOrder S; S.init(r1 - r0, DM, gG, (int)blockIdx.x);
                    pg8::EpiBf16 E{(bf16*)(a->ws + f_off), DM};
                    REP(4) pg8::gemm_phase<pg8::EpiBf16, pg8::StaticOrder, true, true>(lds, g, S, E);
                } else {
                    TIDV; const ArgsP a = launder(kp);
                    const float* MODL = (const float*)(a->ws + WS_MOD) + (size_t)l * 9 * 6 * DM; const float* MODN = MODL + 9 * 6 * DM;
                    NormP P; P.y = (const bf16*)(a->ws + WS_BUFB + A_HALF); P.y_row0 = 0; P.xin_lat = nullptr; P.xin_ctx = nullptr; P.xb = (bf16*)(a->ws + WS_XB); P.out_f32 = nullptr;
                    P.h = (bf16*)(a->ws + WS_BUFA);
                    P.gate = MODL + 5 * DM; P.g_post = a->in[IN_GPOSTFFN] + l * DM;
                    P.g_pre = a->in[IN_GPREMIX] + (l + 1) * DM; P.shift = MODN + 0 * DM; P.scale = MODN + 1 * DM;
                    phase_norm(P, 0, HALF1_ROW0, ((int)blockIdx.x - gG) * NWAVES + wave, NORM_WGS * NWAVES, lane);
                }
                SEAM(ph + 2);
            }
            if ((PHEN & 1024) && IN(ph + 3) && !(pair_norm0 && hf == 0)) {
                TIDV; const ArgsP a = launder(kp); const bool lastl = (l == DEPTH - 1);
                const float* MODL = (const float*)(a->ws + WS_MOD) + (size_t)l * 9 * 6 * DM; const float* MODN = MODL + (lastl ? 0 : 9 * 6 * DM);
                NormP P; P.y = (const bf16*)(a->ws + f_off); P.y_row0 = r0; P.xin_lat = nullptr; P.xin_ctx = nullptr; P.xb = (bf16*)(a->ws + WS_XB); P.out_f32 = lastl ? a->out : nullptr;
                P.h = lastl ? nullptr : (bf16*)(a->ws + WS_BUFA);
                P.gate = MODL + 5 * DM; P.g_post = a->in[IN_GPOSTFFN] + l * DM;
                P.g_pre = a->in[IN_GPREMIX] + (lastl ? l : l + 1) * DM; P.shift = MODN + 0 * DM; P.scale = MODN + 1 * DM;
                phase_norm(P, r0, r1, gw, ngw, lane);
                SEAM(ph + 3);
            }
        }
    }
#undef IN
#undef SEAM
#undef TIDV
}

extern "C" void kernel_launch(void* const* d_in, const int* in_sizes, int n_in, void* d_out, int out_size, void* d_ws, size_t ws_size, hipStream_t stream) {
    static int grid = 0;
    if (grid == 0) {
        if (n_in != 26 || out_size != MLAT * DM || ws_size < WS_NEED_HALF) { fprintf(stderr, "kernel_launch: unexpected problem shape / workspace (n_in %d, out %d, ws %zu, need %zu)\n", n_in, out_size, ws_size, (size_t)WS_NEED_HALF); grid = -1; return; }
        int dev = 0, cus = 0, per_cu = 0;
        if (hipGetDevice(&dev) != hipSuccess || hipDeviceGetAttribute(&cus, hipDeviceAttributeMultiprocessorCount, dev) != hipSuccess) { grid = -1; return; }
        if (hipFuncSetAttribute((const void*)mk_fwd, hipFuncAttributeMaxDynamicSharedMemorySize, LDS_BYTES) != hipSuccess) { fprintf(stderr, "kernel_launch: hipFuncSetAttribute failed\n"); grid = -1; return; }
        if (hipOccupancyMaxActiveBlocksPerMultiprocessor(&per_cu, (const void*)mk_fwd, NTHREADS, LDS_BYTES) != hipSuccess || per_cu < 1)
            fprintf(stderr, "kernel_launch: note: occupancy query reports %d workgroups per CU\n", per_cu);
        (void)hipGetLastError();
        grid = cus;
        if (grid != 256) fprintf(stderr, "kernel_launch: note: %d CUs (built for 256)\n", grid);
    }
    if (grid < 0) return;
    if (hipMemsetAsync((char*)d_ws + WS_CTL, 0, CTL_BYTES, stream) != hipSuccess) { fprintf(stderr, "kernel_launch: memset failed\n"); return; }
    Args a{};
    for (int i = 0; i < 26; ++i) a.in[i] = (const float*)d_in[i];
    a.out = (float*)d_out; a.ws = (unsigned char*)d_ws;
    a.nhalf = 2;
    a.dup = MK_DUP;
#if MK_MULTI_LAUNCH
    for (int ph = 0; ph < PH_TOTAL; ++ph) {
        if (ph >= 2) { const int k = (ph - 2) % PH_PER_LAYER, ll = (ph - 2) / PH_PER_LAYER; if (a.nhalf == 1 && k >= 9) continue; if (a.nhalf == 2 && k == 8 && ll < DEPTH - 1) continue; }
        a.seg_lo = ph; a.seg_hi = ph + 1;
        hipLaunchKernelGGL(mk_fwd, dim3(grid), dim3(NTHREADS), LDS_BYTES, stream, a);
    }
#else
    a.seg_lo = 0; a.seg_hi = PH_TOTAL;
    hipLaunchKernelGGL(mk_fwd, dim3(grid), dim3(NTHREADS), LDS_BYTES, stream, a);
#endif
    const hipError_t le = hipPeekAtLastError();
    if (le != hipSuccess) fprintf(stderr, "kernel_launch: launch failed: %s\n", hipGetErrorName(le));
}
```

```cpp
#include <hip/hip_runtime.h>
#include <cstdio>
#include <cstdint>

#ifndef MK_DUP
#define MK_DUP 0
#endif
#ifndef MK_MULTI_LAUNCH
#define MK_MULTI_LAUNCH 0
#endif

namespace pg8 {
#define PG8_LAS __attribute__((address_space(3)))
typedef unsigned short bf16_t;
typedef short bf16x8 __attribute__((ext_vector_type(8)));
typedef float f32x4 __attribute__((ext_vector_type(4)));
typedef unsigned u32x4 __attribute__((ext_vector_type(4)));
constexpr int BM = 256, BK = 64, HALF = 128, HTB = HALF * BK * 2, STAGE_BYTES = 8 * HTB, NXCD = 8, WGM = 8;

__host__ __device__ __forceinline__ int lds_byte(int r, int c) { const int st = (r >> 4) * 2 + (c >> 5), rr = r & 15, cc = c & 31, ob = rr * 64 + cc * 2; return st * 1024 + (ob ^ (((ob >> 9) & 1) << 5)); }
__host__ __device__ __forceinline__ void stage_rc(int b, int& R, int& C) { const int st = b / 1024, sb = b % 1024, swz = sb ^ (((sb >> 9) & 1) << 5); R = (st >> 1) * 16 + swz / 64; C = (st & 1) * 32 + (swz % 64) / 2; }
__host__ __device__ __forceinline__ int perm32(int rho) { const int n = rho >> 4, i = rho & 15; return 8 * (i >> 2) + 4 * n + (i & 3); }

struct Unit { int pm, pn; };
struct Gemm { const bf16_t* A; const bf16_t* Bt; int M, N, K; };

struct StaticOrder {
    int nM, nN, nwg, G, c;
    __host__ __device__ void init(int M, int N, int G_, int c_) { nM = M / BM; nN = N / BM; nwg = nM * nN; G = G_; c = c_; }
    __host__ __device__ bool next(int i, Unit& u) const {
        const long L = (long)i * G + c; if (L >= nwg) return false;
        int wgid = (int)L; { const int q = nwg / NXCD, r = nwg % NXCD, xcd = wgid % NXCD, off = wgid / NXCD; wgid = (xcd < r ? xcd * (q + 1) : r * (q + 1) + (xcd - r) * q) + off; }
        const int nig = WGM * nN, gid = wgid / nig, fm = gid * WGM, gsz = (nM - fm) < WGM ? (nM - fm) : WGM;
        u.pm = fm + ((wgid % nig) % gsz); u.pn = (wgid % nig) / gsz; return true;
    }
    __device__ __forceinline__ void a_ready(const Unit&) const {}
    __device__ __forceinline__ void done(const Unit&) const {}
};

__device__ __forceinline__ unsigned cvt_pk_bf16(float lo, float hi) { unsigned r; asm volatile("v_cvt_pk_bf16_f32 %0, %1, %2" : "=v"(r) : "v"(lo), "v"(hi)); return r; }

struct EpiBf16 {
    static constexpr bool PERM = true, AFTER_DRAIN = false;
    bf16_t* O; int ldc;
    __device__ __forceinline__ void operator()(const f32x4 (&acc)[2][2][4][2], const Unit& u, int wr, int wc, int fr, int fq) const {
        const int row0 = u.pm * BM + wr * 64 + fr; const int col0 = u.pn * BM + wc * 32 + 8 * fq;
#pragma unroll
        for (int ai = 0; ai < 2; ++ai)
#pragma unroll
            for (int m = 0; m < 4; ++m) { bf16_t* rowp = O + (size_t)(row0 + ai * HALF + m * 16) * ldc + col0;
#pragma unroll
                for (int bj = 0; bj < 2; ++bj) { const f32x4 v0 = acc[ai][bj][m][0], v1 = acc[ai][bj][m][1];
                    u32x4 w; w.x = cvt_pk_bf16(v0[0], v0[1]); w.y = cvt_pk_bf16(v0[2], v0[3]); w.z = cvt_pk_bf16(v1[0], v1[1]); w.w = cvt_pk_bf16(v1[2], v1[3]);
                    *(u32x4*)(rowp + bj * HALF) = w; } }
    }
};

template <class Epi, class Sched, bool ALIGN_EPI = false, bool SP2 = false>
__device__ __forceinline__ void gemm_phase(PG8_LAS unsigned char* lds, const Gemm g, const Sched& S, const Epi& E) {
    int tid_ = threadIdx.x; asm volatile("" : "+v"(tid_));
    const int tid = tid_, wid = __builtin_amdgcn_readfirstlane(tid >> 6), lane = tid & 63, wr = wid >> 2, wc = wid & 3, fr = lane & 15, fq = lane >> 4;
    const int K = g.K, nt = K / BK;
    unsigned voffA[2], voffB[2];
#pragma unroll
    for (int i = 0; i < 2; ++i) { int R, C; stage_rc(tid * 16 + i * 8192, R, C); const int Rb = Epi::PERM ? ((R & ~31) + perm32(R & 31)) : R;
        voffA[i] = (unsigned)(R * K + C) * 2u; voffB[i] = (unsigned)(Rb * K + C) * 2u; }
    const size_t kstep = (size_t)(BK * 2);
    const size_t hstep = (size_t)HALF * K * 2;
    const size_t tstep = 2 * hstep;
    const unsigned ldsw = (unsigned)wid * 1024u;
    const int aoff = lds_byte(wr * 64 + fr, fq * 8), boff = lds_byte(wc * 32 + fr, fq * 8);
#define PG8_SA(b, h) (((b) * 2 + (h)) * HTB)
#define PG8_SB(b, h) ((4 + (b) * 2 + (h)) * HTB)
#define PG8_STAGE(bufoff, gbase, voff) do { _Pragma("unroll") for (int _i = 0; _i < 2; ++_i) \
        __builtin_amdgcn_global_load_lds((const unsigned*)((const char*)(gbase) + (voff)[_i]), (PG8_LAS unsigned*)(lds + (bufoff) + ldsw + _i * 8192), 16, 0, 0); } while (0)
#define PG8_LDA(dst, b, h) do { _Pragma("unroll") for (int m = 0; m < 4; ++m) _Pragma("unroll") for (int k = 0; k < 2; ++k) dst[m][k] = *(const PG8_LAS bf16x8*)(lds + PG8_SA(b, h) + aoff + m * 2048 + k * 1024); } while (0)
#define PG8_LDB(dst, b, h) do { _Pragma("unroll") for (int n = 0; n < 2; ++n) _Pragma("unroll") for (int k = 0; k < 2; ++k) dst[n][k] = *(const PG8_LAS bf16x8*)(lds + PG8_SB(b, h) + boff + n * 2048 + k * 1024); } while (0)
#define PG8_MMA(ai, bj, At, Bt) do { __builtin_amdgcn_s_setprio(1); _Pragma("unroll") for (int m = 0; m < 4; ++m) _Pragma("unroll") for (int n = 0; n < 2; ++n) _Pragma("unroll") for (int k = 0; k < 2; ++k) \
        acc[ai][bj][m][n] = __builtin_amdgcn_mfma_f32_16x16x32_bf16(Bt[n][k], At[m][k], acc[ai][bj][m][n], 0, 0, 0); __builtin_amdgcn_s_setprio(0); } while (0)
#define PG8_WAIT_V(n) asm volatile("s_waitcnt vmcnt(" #n ")" ::: "memory")
#define PG8_WAIT_L(n) asm volatile("s_waitcnt lgkmcnt(" #n ")" ::: "memory")
#define PG8_BAR __builtin_amdgcn_s_barrier()
#define PG8_SCHED __builtin_amdgcn_sched_barrier(0)
    Unit cur, nxt; int ui = 0;
    if (!S.next(0, cur)) return;
    f32x4 acc[2][2][4][2];
#pragma unroll
    for (int a = 0; a < 2; ++a)
#pragma unroll
        for (int b = 0; b < 2; ++b)
#pragma unroll
            for (int m = 0; m < 4; ++m)
#pragma unroll
                for (int n = 0; n < 2; ++n) acc[a][b][m][n] = (f32x4){0.f, 0.f, 0.f, 0.f};
    bf16x8 At[4][2], B0[2][2], B1[2][2];
    const char* cA = (const char*)g.A + (size_t)cur.pm * tstep; const char* cB = (const char*)g.Bt + (size_t)cur.pn * tstep;
    S.a_ready(cur);
    if constexpr (SP2) {
        PG8_STAGE(PG8_SB(0, 0), cB, voffB); PG8_STAGE(PG8_SB(0, 1), cB + hstep, voffB); PG8_STAGE(PG8_SA(0, 0), cA, voffA); PG8_STAGE(PG8_SA(0, 1), cA + hstep, voffA);
        if (wr == 1) PG8_BAR;
        PG8_WAIT_V(2); PG8_BAR;
        PG8_STAGE(PG8_SB(1, 0), cB + kstep, voffB); PG8_STAGE(PG8_SA(1, 0), cA + kstep, voffA); PG8_STAGE(PG8_SB(1, 1), cB + hstep + kstep, voffB);
        PG8_WAIT_V(6); PG8_BAR;
    } else {
        PG8_STAGE(PG8_SB(0, 0), cB, voffB); PG8_STAGE(PG8_SA(0, 0), cA, voffA); PG8_STAGE(PG8_SB(0, 1), cB + hstep, voffB); PG8_STAGE(PG8_SA(0, 1), cA + hstep, voffA);
        if (wr == 1) PG8_BAR;
        PG8_WAIT_V(4); PG8_BAR;
        PG8_STAGE(PG8_SB(1, 0), cB + kstep, voffB); PG8_STAGE(PG8_SA(1, 0), cA + kstep, voffA); PG8_STAGE(PG8_SB(1, 1), cB + hstep + kstep, voffB);
        PG8_WAIT_V(6); PG8_BAR;
    }
    for (;;) {
        const bool has_next = S.next(ui + 1, nxt);
        const char* nA = has_next ? (const char*)g.A + (size_t)nxt.pm * tstep : cA; const char* nB = has_next ? (const char*)g.Bt + (size_t)nxt.pn * tstep : cB;
        for (int t = 0; t < nt; t += 2) {
            const bool last = (t == nt - 2);
            const char* a1 = cA + (size_t)(t + 1) * kstep;
            const char* a2 = last ? nA : cA + (size_t)(t + 2) * kstep; const char* b2 = last ? nB : cB + (size_t)(t + 2) * kstep;
            const char* a3 = a2 + kstep; const char* b3 = b2 + kstep;
            if (last && has_next) S.a_ready(nxt);
            if constexpr (SP2) {
            PG8_LDB(B0, 0, 0); PG8_LDB(B1, 0, 1); PG8_SCHED; PG8_LDA(At, 0, 0); PG8_STAGE(PG8_SA(1, 1), a1 + hstep, voffA);
            PG8_WAIT_V(8); PG8_WAIT_L(0); PG8_BAR; PG8_MMA(0, 0, At, B0); PG8_MMA(0, 1, At, B1); PG8_BAR; PG8_SCHED;
            PG8_LDA(At, 0, 1); PG8_STAGE(PG8_SB(0, 0), b2, voffB); PG8_STAGE(PG8_SB(0, 1), b2 + hstep, voffB); PG8_STAGE(PG8_SA(0, 0), a2, voffA);
            PG8_WAIT_V(8); PG8_WAIT_L(0); PG8_BAR; PG8_MMA(1, 0, At, B0); PG8_MMA(1, 1, At, B1); PG8_BAR; PG8_SCHED;
            PG8_LDB(B0, 1, 0); PG8_LDB(B1, 1, 1); PG8_SCHED; PG8_LDA(At, 1, 0); PG8_STAGE(PG8_SA(0, 1), a2 + hstep, voffA);
            PG8_WAIT_V(8); PG8_WAIT_L(0); PG8_BAR; PG8_MMA(0, 0, At, B0); PG8_MMA(0, 1, At, B1); PG8_BAR; PG8_SCHED;
            PG8_LDA(At, 1, 1); PG8_STAGE(PG8_SB(1, 0), b3, voffB); PG8_STAGE(PG8_SB(1, 1), b3 + hstep, voffB); PG8_STAGE(PG8_SA(1, 0), a3, voffA);
            PG8_WAIT_V(8); PG8_WAIT_L(0); PG8_BAR; PG8_MMA(1, 0, At, B0); PG8_MMA(1, 1, At, B1); PG8_BAR; PG8_SCHED;
            } else {
            PG8_LDB(B0, 0, 0); PG8_SCHED; PG8_LDA(At, 0, 0); PG8_STAGE(PG8_SA(1, 1), a1 + hstep, voffA);
            PG8_WAIT_L(8); PG8_BAR; PG8_WAIT_L(0); PG8_MMA(0, 0, At, B0); PG8_BAR; PG8_SCHED;
            PG8_LDB(B1, 0, 1); PG8_STAGE(PG8_SB(0, 0), b2, voffB);
            PG8_BAR; PG8_WAIT_L(0); PG8_MMA(0, 1, At, B1); PG8_BAR;
            PG8_LDA(At, 0, 1); PG8_STAGE(PG8_SA(0, 0), a2, voffA);
            PG8_BAR; PG8_WAIT_L(0); PG8_MMA(1, 0, At, B0); PG8_BAR; PG8_SCHED;
            PG8_STAGE(PG8_SB(0, 1), b2 + hstep, voffB);
            PG8_WAIT_V(6); PG8_BAR; PG8_MMA(1, 1, At, B1); PG8_BAR;
            PG8_LDB(B0, 1, 0); PG8_SCHED; PG8_LDA(At, 1, 0); PG8_STAGE(PG8_SA(0, 1), a2 + hstep, voffA);
            PG8_WAIT_L(8); PG8_BAR; PG8_WAIT_L(0); PG8_MMA(0, 0, At, B0); PG8_BAR; PG8_SCHED;
            PG8_LDB(B1, 1, 1); PG8_STAGE(PG8_SB(1, 0), b3, voffB);
            PG8_BAR; PG8_WAIT_L(0); PG8_MMA(0, 1, At, B1); PG8_BAR;
            PG8_LDA(At, 1, 1); PG8_STAGE(PG8_SA(1, 0), a3, voffA);
            PG8_BAR; PG8_WAIT_L(0); PG8_MMA(1, 0, At, B0); PG8_BAR; PG8_SCHED;
            PG8_STAGE(PG8_SB(1, 1), b3 + hstep, voffB);
            PG8_WAIT_V(6); PG8_BAR; PG8_MMA(1, 1, At, B1); PG8_BAR;
            }
        }
        if constexpr (ALIGN_EPI) { if (wr == 0) PG8_BAR; }
        if constexpr (!Epi::AFTER_DRAIN) { E(acc, cur, wr, wc, fr, fq); S.done(cur); }
        if (!has_next) break;
#pragma unroll
        for (int a = 0; a < 2; ++a)
#pragma unroll
            for (int b = 0; b < 2; ++b)
#pragma unroll
                for (int m = 0; m < 4; ++m)
#pragma unroll
                    for (int n = 0; n < 2; ++n) acc[a][b][m][n] = (f32x4){0.f, 0.f, 0.f, 0.f};
        cur = nxt; cA = nA; cB = nB; ++ui;
        if constexpr (ALIGN_EPI) { if (wr == 1) PG8_BAR; }
    }
    PG8_WAIT_V(0);
    if constexpr (!ALIGN_EPI) { if (wr == 0) PG8_BAR; }
    PG8_BAR;
#undef PG8_SA
#undef PG8_SB
#undef PG8_STAGE
#undef PG8_LDA
#undef PG8_LDB
#undef PG8_MMA
#undef PG8_WAIT_V
#undef PG8_WAIT_L
#undef PG8_BAR
#undef PG8_SCHED
}
}

constexpr int DM = 2048, NBATCH = 8, SEQ = 4096, DEPTH = 4, CTXL = 256, GRIDW = 64;
constexpr int MLAT = NBATCH * SEQ, MCTX = NBATCH * CTXL, MALL = MLAT + MCTX;
constexpr int POOLW = 1536, SSMW = 512, NGRP = 32, SGRP = 16, NSTATE = 64, PGRP = 384;
constexpr int DFF = 5632, DFF2 = 11264;
constexpr float EPSN = 1e-6f;
constexpr int NWAVES = 8, NTHREADS = 512;

constexpr size_t MiB = 1u << 20;
constexpr size_t WS_CTL = 0, CTL_BYTES = 1 * MiB;
constexpr size_t WS_MOD = 1 * MiB;
constexpr size_t WS_LAM = 3 * MiB;
constexpr size_t WS_BB = 4 * MiB;
constexpr size_t WS_CM = 6 * MiB;
constexpr size_t WS_WT = 8 * MiB;
constexpr size_t WT_IN = 0, WT_COMB = (size_t)DM * DM, WT_UP = 2 * (size_t)DM * DM, WT_DOWN = WT_UP + (size_t)DFF2 * DM, WT_GLU = WT_DOWN + (size_t)DM * DFF, WT_LAYER = WT_GLU + (size_t)SSMW * SSMW;
constexpr size_t WS_XB = WS_WT + 4 * WT_LAYER * 2;
constexpr size_t WS_BUFA = WS_XB + (size_t)MALL * DM * 2;
constexpr size_t BUF_BYTES = (size_t)MALL * DM * 2;
constexpr size_t WS_BUFB = WS_BUFA + BUF_BYTES, WS_BUFC = WS_BUFB + BUF_BYTES, WS_Z = WS_BUFC + BUF_BYTES;
constexpr int HALF1_ROW0 = 4 * SEQ;
constexpr size_t Z_FULL = (size_t)MALL * DFF2 * 2, Z_HALF = (size_t)(MALL - HALF1_ROW0) * DFF2 * 2;
constexpr size_t A_HALF = (size_t)(MALL - HALF1_ROW0) * DFF * 2;
constexpr size_t WS_NEED_FULL = WS_Z + Z_FULL, WS_NEED_HALF = WS_Z + Z_HALF;
static_assert(A_HALF + (size_t)(MALL - HALF1_ROW0) * DM * 2 <= 2 * BUF_BYTES, "half-mode a + f fit in bufB|bufC");
static_assert((size_t)MALL * DFF * 2 <= 3 * BUF_BYTES, "full-mode a fits in bufA|bufB|bufC");
static_assert(WS_XB % 256 == 0 && WS_BUFA % 256 == 0 && WS_Z % 256 == 0, "alignment");
constexpr int CW_QUEUE = 64;
constexpr int CW_BAR = 4096;

constexpr int SCRATCH_BYTES = 139264;
constexpr int MISC_OFF = SCRATCH_BYTES;
constexpr int LDS_BYTES = 147456;

#define LAS __attribute__((address_space(3)))
typedef unsigned short bf16;
typedef short bf16x8 __attribute__((ext_vector_type(8)));
typedef float f32x4 __attribute__((ext_vector_type(4)));
typedef float f32x16 __attribute__((ext_vector_type(16)));
typedef unsigned u32x4 __attribute__((ext_vector_type(4)));
typedef unsigned u32x2 __attribute__((ext_vector_type(2)));

__device__ __forceinline__ float bf2f(unsigned short b) { return __uint_as_float(((unsigned)b) << 16); }
__device__ __forceinline__ float bflo(unsigned w) { return __uint_as_float(w << 16); }
__device__ __forceinline__ float bfhi(unsigned w) { return __uint_as_float(w & 0xffff0000u); }
__device__ __forceinline__ unsigned pk2(float lo, float hi) { return pg8::cvt_pk_bf16(lo, hi); }
__device__ __forceinline__ float wave_sum(float v) {
#pragma unroll
    for (int o = 1; o < 64; o <<= 1) v += __shfl_xor(v, o);
    return v;
}
__device__ __forceinline__ void st16_wt(void* p, u32x4 v) { asm volatile("global_store_dwordx4 %0, %1, off sc1\n\ts_nop 1" :: "v"(p), "v"(v) : "memory"); }
__device__ __forceinline__ void st8_wt(void* p, u32x2 v) { asm volatile("global_store_dwordx2 %0, %1, off sc1\n\ts_nop 1" :: "v"(p), "v"(v) : "memory"); }
__device__ __forceinline__ float sigmoidf_(float t) { return __builtin_amdgcn_rcpf(1.0f + __builtin_amdgcn_exp2f(-1.4426950408889634f * t)); }

#define XB_TMO      128
#define XB_XCNT(j)  (256  + 64 * (j))
#define XB_XSUB(j)  (1280 + 64 * (j))
#define XB_XGEN(j)  (2304 + 64 * (j))
#define XB_TOP      3328
#define XB_TOPGEN   3392
#define XCD_BAR_WORDS 3456
#define XB_SPIN_CAP (1u << 20)

__device__ __forceinline__ unsigned xb_ld(unsigned* p)              { return __hip_atomic_load(p, __ATOMIC_RELAXED, __HIP_MEMORY_SCOPE_AGENT); }
__device__ __forceinline__ unsigned xb_add(unsigned* p, unsigned v) { return __hip_atomic_fetch_add(p, v, __ATOMIC_RELAXED, __HIP_MEMORY_SCOPE_AGENT); }
__device__ __forceinline__ unsigned xb_xcc_id() { return (unsigned)__builtin_amdgcn_s_getreg((3 << 11) | 20) & 0xFu; }
#define XB_SPIN(cond, bar) do { unsigned _sp = 0; while (cond) { __builtin_amdgcn_s_sleep(1); \
    if ((++_sp & 255u) == 0u) { if (xb_ld(&(bar)[XB_TMO])) break; if (_sp > XB_SPIN_CAP) { atomicAdd(&(bar)[XB_TMO], 1u); break; } } } } while (0)

struct XcdBarrier { unsigned* bar; unsigned x; volatile LAS unsigned* st; };

__device__ __forceinline__ XcdBarrier xcd_barrier_post(unsigned* bar, volatile LAS unsigned* st) {
    XcdBarrier b; b.bar = bar; b.x = xb_xcc_id(); b.st = st;
    if (threadIdx.x == 0) (void)xb_add(&bar[XB_XCNT(b.x)], 1u);
    return b;
}
__device__ __forceinline__ void xcd_barrier_complete(unsigned* bar, unsigned x, unsigned& nloc, unsigned& nx) {
    const unsigned G = gridDim.x * gridDim.y * gridDim.z;
    unsigned sum, cnt, mine, sp = 0u;
    for (;;) {
        sum = 0u; cnt = 0u; mine = 0u;
#pragma unroll
        for (unsigned j = 0; j < 16; ++j) { const unsigned c = xb_ld(&bar[XB_XCNT(j)]); sum += c; cnt += (c > 0u) ? 1u : 0u; mine = (j == x) ? c : mine; }
        if (sum == G) break;
        __builtin_amdgcn_s_sleep(1);
        if ((++sp & 255u) == 0u) { if (xb_ld(&bar[XB_TMO])) break; if (sp > XB_SPIN_CAP) { atomicAdd(&bar[XB_TMO], 1u); break; } }
    }
    nloc = mine > 0u ? mine : 1u; nx = cnt > 0u ? cnt : 1u;
}
__device__ __forceinline__ void xcd_barrier(const XcdBarrier& b) {
    asm volatile("s_waitcnt vmcnt(0)" ::: "memory");
    __syncthreads();
    if (threadIdx.x == 0) {
        unsigned* bar = b.bar;
        __builtin_amdgcn_s_waitcnt(0);
        unsigned nloc = b.st[0], nx = b.st[1];
        if (nloc == 0u) { xcd_barrier_complete(bar, b.x, nloc, nx); b.st[0] = nloc; b.st[1] = nx; }
        const unsigned old = xb_add(&bar[XB_XSUB(b.x)], 1u);
        const unsigned gen = old / nloc;
        asm volatile("buffer_inv sc1" ::: "memory");
        if (old + 1u == (gen + 1u) * nloc) {
            __builtin_amdgcn_fence(__ATOMIC_RELEASE, "agent");
            asm volatile("s_waitcnt vmcnt(0)" ::: "memory");
            const unsigned og = xb_add(&bar[XB_TOP], 1u);
            const unsigned tg = og / nx;
            if (og + 1u == (tg + 1u) * nx) xb_add(&bar[XB_TOPGEN], 1u);
            else XB_SPIN(xb_ld(&bar[XB_TOPGEN]) == tg, bar);
            xb_add(&bar[XB_XGEN(b.x)], 1u);
            asm volatile("s_waitcnt vmcnt(0)" ::: "memory");
        } else {
            XB_SPIN(xb_ld(&bar[XB_XGEN(b.x)]) == gen, bar);
            asm volatile("s_waitcnt vmcnt(0)" ::: "memory");
        }
    }
    __syncthreads();
}

struct Args {
    const float* in[26];
    float* out;
    unsigned char* ws;
    int seg_lo, seg_hi;
    int nhalf, dup;
};
typedef const Args __attribute__((address_space(4)))* ArgsP;
__device__ __forceinline__ ArgsP launder(ArgsP p) { asm volatile("" : "+s"(p)); return p; }
enum { IN_X = 0, IN_C, IN_CTX, IN_CCTX, IN_WADA, IN_BADA, IN_WIN, IN_WPOOL, IN_PSCALE, IN_ARE, IN_AIM, IN_LOGDT, IN_BRE, IN_BIM, IN_CRE, IN_CIM, IN_SSMD, IN_WGLU, IN_WOUT,
       IN_GPREMIX, IN_GPOSTMIX, IN_GPREFFN, IN_GPOSTFFN, IN_WUP, IN_WCONV, IN_WDOWN };

__device__ __forceinline__ void p0_mod_item(ArgsP a, LAS unsigned char* lds, int item, int tid) {
    const int l = item / 48, n0 = (item % 48) * 256;
    LAS float* sS = (LAS float*)lds;
    const float* c = a->in[IN_C]; const float* cc = a->in[IN_CCTX];
    for (int idx = tid; idx < 9 * DM; idx += NTHREADS) { const int j = idx >> 11, k = idx & (DM - 1); const float v = (j < 8) ? c[j * DM + k] : cc[k]; sS[idx] = v * sigmoidf_(v); }
    __syncthreads();
    const int q = tid & 63, ks = tid >> 6;
    f32x4 acc[9];
#pragma unroll
    for (int j = 0; j < 9; ++j) acc[j] = (f32x4){0.f, 0.f, 0.f, 0.f};
    const float* wp = a->in[IN_WADA] + ((size_t)l * DM + (size_t)ks * 256) * (6 * DM) + n0 + 4 * q;
#pragma unroll 2
    for (int kk = 0; kk < 256; kk += 4) {
        const f32x4 w0 = *(const f32x4*)(wp + (size_t)(kk + 0) * (6 * DM)), w1 = *(const f32x4*)(wp + (size_t)(kk + 1) * (6 * DM));
        const f32x4 w2 = *(const f32x4*)(wp + (size_t)(kk + 2) * (6 * DM)), w3 = *(const f32x4*)(wp + (size_t)(kk + 3) * (6 * DM));
#pragma unroll
        for (int j = 0; j < 9; ++j) { const f32x4 sv = *(const LAS f32x4*)(sS + j * DM + ks * 256 + kk);
            acc[j] += sv.x * w0 + sv.y * w1 + sv.z * w2 + sv.w * w3; }
    }
    __syncthreads();
    LAS float* red = (LAS float*)lds;
#pragma unroll
    for (int j = 0; j < 9; ++j) *(LAS f32x4*)(red + (ks * 9 + j) * 256 + 4 * q) = acc[j];
    __syncthreads();
    float* MOD = (float*)(a->ws + WS_MOD);
    const float* bada = a->in[IN_BADA];
    for (int o = tid; o < 9 * 256; o += NTHREADS) { const int j = o >> 8, col = o & 255; float s = bada[l * 6 * DM + n0 + col];
#pragma unroll
        for (int k2 = 0; k2 < 8; ++k2) s += red[(k2 * 9 + j) * 256 + col];
        MOD[((size_t)l * 9 + j) * (6 * DM) + n0 + col] = s; }
    __syncthreads();
}
__device__ __forceinline__ void p0_s5_item(ArgsP a, int e, int tid) {
    if (tid >= 64) return;
    const int p = tid, ldg = e;
    const int gp = ldg * 64 + p;
    const float a_re = a->in[IN_ARE][gp], a_im = a->in[IN_AIM][gp], dt = expf(a->in[IN_LOGDT][ldg]);
    const float mag = expf(a_re * dt), lam_re = mag * cosf(a_im * dt), lam_im = mag * sinf(a_im * dt);
    const float denom = a_re * a_re + a_im * a_im, nr = lam_re - 1.0f, ni = lam_im;
    const float f_re = (nr * a_re + ni * a_im) / denom, f_im = (ni * a_re - nr * a_im) / denom;
    float* LAM = (float*)(a->ws + WS_LAM); bf16* BB = (bf16*)(a->ws + WS_BB); bf16* CM = (bf16*)(a->ws + WS_CM);
    LAM[gp * 2 + 0] = lam_re; LAM[gp * 2 + 1] = lam_im;
    const float* bre = a->in[IN_BRE] + (size_t)gp * 16; const float* bim = a->in[IN_BIM] + (size_t)gp * 16;
#pragma unroll
    for (int h = 0; h < 16; h += 2) {
        const float r0 = f_re * bre[h] - f_im * bim[h], i0 = f_re * bim[h] + f_im * bre[h];
        const float r1 = f_re * bre[h + 1] - f_im * bim[h + 1], i1 = f_re * bim[h + 1] + f_im * bre[h + 1];
        *(unsigned*)(BB + ((size_t)ldg * 128 + p) * 16 + h) = pk2(r0, r1);
        *(unsigned*)(BB + ((size_t)ldg * 128 + 64 + p) * 16 + h) = pk2(i0, i1);
    }
    const float* cre = a->in[IN_CRE] + (size_t)ldg * 16 * 64; const float* cim = a->in[IN_CIM] + (size_t)ldg * 16 * 64;
#pragma unroll
    for (int h = 0; h < 16; ++h) *(unsigned*)(CM + ((size_t)ldg * 16 + h) * 128 + 2 * p) = pk2(cre[h * 64 + p], -cim[h * 64 + p]);
}
__device__ __forceinline__ void p0_fold_tile(ArgsP a, int l, int wt, int lane) {
    const int nb = wt / 48, cbk = wt % 48, g = cbk / 12, c0 = (cbk % 12) * 32, n0 = nb * 32;
    const float* wout = a->in[IN_WOUT] + (size_t)l * DM * DM + (size_t)(g * PGRP) * DM + n0 + (lane & 31);
    const float* wpool = a->in[IN_WPOOL] + ((size_t)(l * 4 + g) * PGRP + c0 + (lane & 31)) * PGRP;
    const float* ps = a->in[IN_PSCALE] + l * POOLW + g * PGRP;
    f32x16 acc;
#pragma unroll
    for (int r = 0; r < 16; ++r) acc[r] = 0.f;
    const int h8 = 8 * (lane >> 5);
    for (int d0 = 0; d0 < PGRP; d0 += 16) {
        float av[8];
#pragma unroll
        for (int j = 0; j < 8; ++j) av[j] = wout[(size_t)(d0 + h8 + j) * DM] * ps[d0 + h8 + j];
        const f32x4 b0 = *(const f32x4*)(wpool + d0 + h8), b1 = *(const f32x4*)(wpool + d0 + h8 + 4);
        u32x4 aw, bw;
        aw.x = pk2(av[0], av[1]); aw.y = pk2(av[2], av[3]); aw.z = pk2(av[4], av[5]); aw.w = pk2(av[6], av[7]);
        bw.x = pk2(b0.x, b0.y); bw.y = pk2(b0.z, b0.w); bw.z = pk2(b1.x, b1.y); bw.w = pk2(b1.z, b1.w);
        acc = __builtin_amdgcn_mfma_f32_32x32x16_bf16(__builtin_bit_cast(bf16x8, aw), __builtin_bit_cast(bf16x8, bw), acc, 0, 0, 0);
    }
    asm volatile("s_nop 15\n\ts_nop 15\n\ts_nop 15\n\ts_nop 15" : "+v"(acc));
    bf16* WT = (bf16*)(a->ws + WS_WT) + (size_t)l * WT_LAYER + WT_COMB;
#pragma unroll
    for (int r = 0; r < 16; ++r) { const int n = n0 + (r & 3) + 8 * (r >> 2) + 4 * (lane >> 5);
        WT[(size_t)n * DM + g * PGRP + c0 + (lane & 31)] = (bf16)(pk2(acc[r], 0.f) & 0xffffu); }
}
__device__ __forceinline__ void p0_transpose_tile(const float* W, int N, bf16* WT, int ldt, int kdst, LAS float* scr, int kb, int nb, int lane) {
    const int k0 = 64 * kb, n0 = 32 * nb;
#pragma unroll 8
    for (int i = 0; i < 32; ++i) { const int kk = 2 * i + (lane >> 5); scr[kk * 33 + (lane & 31)] = W[(size_t)(k0 + kk) * N + n0 + (lane & 31)]; }
    asm volatile("s_waitcnt lgkmcnt(0)" ::: "memory");
    const int c = lane & 7;
#pragma unroll
    for (int j = 0; j < 4; ++j) { const int n = (lane >> 3) + 8 * j; const LAS float* s = scr + (8 * c) * 33 + n;
        u32x4 o; o.x = pk2(s[0 * 33], s[1 * 33]); o.y = pk2(s[2 * 33], s[3 * 33]); o.z = pk2(s[4 * 33], s[5 * 33]); o.w = pk2(s[6 * 33], s[7 * 33]);
        *(u32x4*)(WT + (size_t)(n0 + n) * ldt + kdst + k0 + 8 * c) = o; }
    asm volatile("s_waitcnt lgkmcnt(0)" ::: "memory");
}
constexpr int Q_MOD = 192, Q_S5 = 256, Q_FOLD = 4 * 384;
constexpr int TI_IN = 32 * 8, TI_OUTS = 8 * 8, TI_UP = 32 * 44, TI_DOWN = 88 * 8, TI_GLU = 8 * 2, TI_LAYER = TI_IN + TI_OUTS + TI_UP + TI_DOWN + TI_GLU;
constexpr int Q_TOTAL = Q_MOD + Q_S5 + Q_FOLD + 4 * TI_LAYER;
__device__ __forceinline__ void p0_transpose_item(ArgsP a, LAS unsigned char* lds, int it, int wave, int lane) {
    const int l = it / TI_LAYER; int r = it % TI_LAYER;
    LAS float* scr = (LAS float*)(lds + wave * 16384);
    bf16* WTL = (bf16*)(a->ws + WS_WT) + (size_t)l * WT_LAYER;
    if (r < TI_IN) { p0_transpose_tile(a->in[IN_WIN] + (size_t)l * DM * DM, DM, WTL + WT_IN, DM, 0, scr, r / 8, (r % 8) * 8 + wave, lane); return; } r -= TI_IN;
    if (r < TI_OUTS) { p0_transpose_tile(a->in[IN_WOUT] + (size_t)l * DM * DM + (size_t)POOLW * DM, DM, WTL + WT_COMB, DM, POOLW, scr, r / 8, (r % 8) * 8 + wave, lane); return; } r -= TI_OUTS;
    if (r < TI_UP) { p0_transpose_tile(a->in[IN_WUP] + (size_t)l * DM * DFF2, DFF2, WTL + WT_UP, DM, 0, scr, r / 44, (r % 44) * 8 + wave, lane); return; } r -= TI_UP;
    if (r < TI_DOWN) { p0_transpose_tile(a->in[IN_WDOWN] + (size_t)l * DFF * DM, DM, WTL + WT_DOWN, DFF, 0, scr, r / 8, (r % 8) * 8 + wave, lane); return; } r -= TI_DOWN;
    p0_transpose_tile(a->in[IN_WGLU] + (size_t)l * SSMW * SSMW, SSMW, WTL + WT_GLU, SSMW, 0, scr, r / 2, (r % 2) * 8 + wave, lane);
}
__device__ __forceinline__ void phase_prologue(ArgsP a, LAS unsigned char* lds, int tid, int wave, int lane) {
    unsigned* qhead = (unsigned*)(a->ws + WS_CTL) + CW_QUEUE;
    volatile LAS unsigned* slot = (volatile LAS unsigned*)(lds + MISC_OFF + 64);
    for (;;) {
        if (tid == 0) slot[0] = __hip_atomic_fetch_add(qhead, 1u, __ATOMIC_RELAXED, __HIP_MEMORY_SCOPE_AGENT);
        __syncthreads();
        const int it = (int)slot[0];
        __syncthreads();
        if (it >= Q_TOTAL) break;
        if (it < Q_MOD) { p0_mod_item(a, lds, it, tid); continue; }
        if (it < Q_MOD + Q_S5) { p0_s5_item(a, it - Q_MOD, tid); continue; }
        if (it < Q_MOD + Q_S5 + Q_FOLD) { const int f = it - Q_MOD - Q_S5; p0_fold_tile(a, f / 384, (f % 384) * 8 + wave, lane); continue; }
        p0_transpose_item(a, lds, it - Q_MOD - Q_S5 - Q_FOLD, wave, lane);
    }
}

struct NormP {
    const bf16* y; int y_row0;
    const float* xin_lat; const float* xin_ctx;
    bf16* xb;
    float* out_f32;
    bf16* h;
    const float* gate; const float* g_post;
    const float* g_pre; const float* shift; const float* scale;
};
__device__ __forceinline__ void phase_norm(const NormP& P, int r0, int r1, int gw, int ngw, int lane) {
    const int nrows = r1 - r0, per = (nrows + ngw - 1) / ngw;
    int m = r0 + gw * per; const int mend = (m + per < r1) ? m + per : r1;
    int curj = -1;
    f32x4 A1[8], A2[8], SH[8];
#pragma unroll
    for (int i = 0; i < 8; ++i) { A1[i] = (f32x4){0.f, 0.f, 0.f, 0.f}; A2[i] = A1[i]; SH[i] = A1[i]; }
    for (; m < mend; ++m) {
        const int j = (m < MLAT) ? (m >> 12) : 8;
        if (j != curj) { curj = j;
#pragma unroll
            for (int jj = 0; jj < 4; ++jj)
#pragma unroll
                for (int hh = 0; hh < 2; ++hh) { const int e = 512 * jj + 8 * lane + 4 * hh;
                    if (P.y) A1[jj * 2 + hh] = *(const f32x4*)(P.gate + (size_t)j * 6 * DM + e) * *(const f32x4*)(P.g_post + e);
                    if (P.h) { A2[jj * 2 + hh] = *(const f32x4*)(P.g_pre + e) * (*(const f32x4*)(P.scale + (size_t)j * 6 * DM + e) + 1.0f); SH[jj * 2 + hh] = *(const f32x4*)(P.shift + (size_t)j * 6 * DM + e); } }
        }
        f32x4 xv[8];
        if (P.xin_lat) {
            const float* xs = (m < MLAT) ? P.xin_lat + (size_t)m * DM : P.xin_ctx + (size_t)(m - MLAT) * DM;
#pragma unroll
            for (int jj = 0; jj < 4; ++jj) { xv[2 * jj] = *(const f32x4*)(xs + 512 * jj + 8 * lane); xv[2 * jj + 1] = *(const f32x4*)(xs + 512 * jj + 8 * lane + 4); }
        } else {
            const bf16* xs = P.xb + (size_t)m * DM;
#pragma unroll
            for (int jj = 0; jj < 4; ++jj) { const u32x4 w = __builtin_nontemporal_load((const u32x4*)(xs + 512 * jj + 8 * lane));
                xv[2 * jj] = (f32x4){bflo(w.x), bfhi(w.x), bflo(w.y), bfhi(w.y)}; xv[2 * jj + 1] = (f32x4){bflo(w.z), bfhi(w.z), bflo(w.w), bfhi(w.w)}; }
        }
        if (P.y) {
            const bf16* yr = P.y + (size_t)(m - P.y_row0) * DM;
            f32x4 yv[8]; float ss = 0.f;
#pragma unroll
            for (int jj = 0; jj < 4; ++jj) { const u32x4 w = __builtin_nontemporal_load((const u32x4*)(yr + 512 * jj + 8 * lane));
                yv[2 * jj] = (f32x4){bflo(w.x), bfhi(w.x), bflo(w.y), bfhi(w.y)}; yv[2 * jj + 1] = (f32x4){bflo(w.z), bfhi(w.z), bflo(w.w), bfhi(w.w)}; }
#pragma unroll
            for (int i = 0; i < 8; ++i) ss += (yv[i].x * yv[i].x + yv[i].y * yv[i].y) + (yv[i].z * yv[i].z + yv[i].w * yv[i].w);
            const float rstd = 1.0f / sqrtf(wave_sum(ss) * (1.0f / DM) + EPSN);
#pragma unroll
            for (int i = 0; i < 8; ++i) xv[i] += A1[i] * (yv[i] * rstd);
        }
        if (P.out_f32) {
            float* xd = P.out_f32 + (size_t)m * DM;
#pragma unroll
            for (int jj = 0; jj < 4; ++jj) { *(f32x4*)(xd + 512 * jj + 8 * lane) = xv[2 * jj]; *(f32x4*)(xd + 512 * jj + 8 * lane + 4) = xv[2 * jj + 1]; }
        } else {
            bf16* xd = P.xb + (size_t)m * DM;
#pragma unroll
            for (int jj = 0; jj < 4; ++jj) { u32x4 w; w.x = pk2(xv[2 * jj].x, xv[2 * jj].y); w.y = pk2(xv[2 * jj].z, xv[2 * jj].w); w.z = pk2(xv[2 * jj + 1].x, xv[2 * jj + 1].y); w.w = pk2(xv[2 * jj + 1].z, xv[2 * jj + 1].w);
                st16_wt(xd + 512 * jj + 8 * lane, w); }
        }
        if (P.h) {
            float ss = 0.f;
#pragma unroll
            for (int i = 0; i < 8; ++i) ss += (xv[i].x * xv[i].x + xv[i].y * xv[i].y) + (xv[i].z * xv[i].z + xv[i].w * xv[i].w);
            const float rstd = 1.0f / sqrtf(wave_sum(ss) * (1.0f / DM) + EPSN);
            bf16* hr = P.h + (size_t)m * DM;
#pragma unroll
            for (int jj = 0; jj < 4; ++jj) { const f32x4 o0 = xv[2 * jj] * rstd * A2[2 * jj] + SH[2 * jj], o1 = xv[2 * jj + 1] * rstd * A2[2 * jj + 1] + SH[2 * jj + 1];
                u32x4 w; w.x = pk2(o0.x, o0.y); w.y = pk2(o0.z, o0.w); w.z = pk2(o1.x, o1.y); w.w = pk2(o1.z, o1.w);
                st16_wt(hr + 512 * jj + 8 * lane, w); }
        }
    }
}

#define POOL_ACC(sgn, VV) do { const u32x4 q_ = (VV); s[0] sgn bflo(q_.x); s[1] sgn bfhi(q_.x); s[2] sgn bflo(q_.y); s[3] sgn bfhi(q_.y); s[4] sgn bflo(q_.z); s[5] sgn bfhi(q_.z); s[6] sgn bflo(q_.w); s[7] sgn bfhi(q_.w); } while (0)
template <int H> __device__ __forceinline__ void pool_batch(const bf16* u, bf16* PA, int m0, int ch0) {
    constexpr int NR = 7 + 2 * H;
    int base, t0, n;
    if (m0 < MLAT) { base = m0 & ~(SEQ - 1); t0 = m0 & (SEQ - 1); n = SEQ; } else { const int mm = m0 - MLAT; base = MLAT + (mm & ~(CTXL - 1)); t0 = mm & (CTXL - 1); n = CTXL; }
    u32x4 v[NR];
#pragma unroll
    for (int k = 0; k < NR; ++k) { const int tt = t0 - H + k; v[k] = (u32x4){0u, 0u, 0u, 0u}; if (tt >= 0 && tt < n) v[k] = *(const u32x4*)(u + (size_t)(base + tt) * DM + ch0); }
    float s[8];
#pragma unroll
    for (int e = 0; e < 8; ++e) s[e] = 0.f;
#pragma unroll
    for (int k = 0; k < 2 * H; ++k) POOL_ACC(+=, v[k]);
#pragma unroll
    for (int i = 0; i < 8; ++i) {
        if (i > 0) { POOL_ACC(+=, v[i + 2 * H - 1]); POOL_ACC(-=, v[i - 1]); }
        const int t = t0 + i, lo = (t - H > 0) ? t - H : 0, hi = (t + H < n) ? t + H : n;
        const float inv = 1.0f / (float)(hi - lo);
        const u32x4 c = v[H + i];
        u32x4 o; o.x = pk2(s[0] * inv - bflo(c.x), s[1] * inv - bfhi(c.x)); o.y = pk2(s[2] * inv - bflo(c.y), s[3] * inv - bfhi(c.y));
        o.z = pk2(s[4] * inv - bflo(c.z), s[5] * inv - bfhi(c.z)); o.w = pk2(s[6] * inv - bflo(c.w), s[7] * inv - bfhi(c.w));
        st16_wt(PA + (size_t)(m0 + i) * DM + ch0, o);
    }
}
__device__ __forceinline__ void pool_rows(const bf16* u, bf16* PA, int row0, int nbatch, int pw  , int lane) {
    if (lane >= 48) return;
    for (int it = pw; it < nbatch * 4; it += 4) {
        const int batch = it >> 2, grp = (it + batch) & 3, m0 = row0 + 8 * batch, ch0 = grp * PGRP + 8 * lane;
        if (grp == 0) pool_batch<1>(u, PA, m0, ch0); else if (grp == 1) pool_batch<2>(u, PA, m0, ch0); else if (grp == 2) pool_batch<4>(u, PA, m0, ch0); else pool_batch<8>(u, PA, m0, ch0);
    }
}
__device__ __forceinline__ int chain_row(int q, int dir, int b) {
    if (q < CTXL) { const int tt = dir ? (CTXL - 1 - q) : q; return MLAT + b * CTXL + tt; }
    const int qq = q - CTXL; const int tt = dir ? (SEQ - 1 - qq) : qq; return b * SEQ + tt;
}
constexpr int STASH_KCB = 528, STASH_BUFB = 16 * STASH_KCB;
__device__ __forceinline__ void ssm_chain(LAS unsigned char* stash, const bf16* u, bf16* Y, const float* LAM, const bf16* BB, const bf16* CM, int l, int b, int g, int dir, int lane) {
    const int ldg = (l * 2 + dir) * NGRP + g;
    const float lr = LAM[(ldg * 64 + lane) * 2], li = LAM[(ldg * 64 + lane) * 2 + 1];
    bf16x8 Bf[4], Cf[4];
#pragma unroll
    for (int cb = 0; cb < 4; ++cb) Bf[cb] = *(const bf16x8*)(BB + ((size_t)ldg * 128 + cb * 32 + (lane & 31)) * 16 + 8 * (lane >> 5));
#pragma unroll
    for (int ks = 0; ks < 4; ++ks) Cf[ks] = *(const bf16x8*)(CM + ((size_t)ldg * 16 + (lane & 15)) * 128 + 32 * ks + 8 * (lane >> 4));
    float hr = 0.f, hi = 0.f;
    const int ucol = POOLW + SGRP * g + 8 * (lane >> 5);
    const int sgn = dir ? -1 : 1;
    const int uoff = sgn * (lane & 31) * DM + ucol;
    const int yo0 = sgn * (lane & 15) * SSMW + SGRP * g + 4 * (lane >> 4), yo1 = yo0 + sgn * 16 * SSMW;
    const unsigned wad = (unsigned)(size_t)(stash + (lane >> 2) * STASH_KCB + (lane & 3) * 4);
    bf16x8 cur[8], nxt[8];
#pragma unroll
    for (int c = 0; c < 8; ++c) cur[c] = *(const bf16x8*)(u + (ptrdiff_t)chain_row(32 * c, dir, b) * DM + uoff);
    for (int sc = 0; sc < 17; ++sc) {
        if (sc + 1 < 17) {
#pragma unroll
            for (int c = 0; c < 8; ++c) nxt[c] = *(const bf16x8*)(u + (ptrdiff_t)chain_row(256 * (sc + 1) + 32 * c, dir, b) * DM + uoff);
        }
#pragma unroll
        for (int c = 0; c < 8; ++c) {
            const int q0 = 256 * sc + 32 * c;
            const LAS unsigned char* stp = stash + ((c & 1) ^ 1) * STASH_BUFB;
            bf16x8 a0[4], a1[4];
#pragma unroll
            for (int ks = 0; ks < 4; ++ks) {
                a0[ks] = *(const LAS bf16x8*)(stp + (4 * ks + (lane >> 4)) * STASH_KCB + (lane & 15) * 16);
                a1[ks] = *(const LAS bf16x8*)(stp + (4 * ks + (lane >> 4)) * STASH_KCB + (16 + (lane & 15)) * 16);
            }
            f32x16 z16;
#pragma unroll
            for (int r = 0; r < 16; ++r) z16[r] = 0.f;
            f32x16 D0 = __builtin_amdgcn_mfma_f32_32x32x16_bf16(cur[c], Bf[0], z16, 0, 0, 0);
            f32x16 D1 = __builtin_amdgcn_mfma_f32_32x32x16_bf16(cur[c], Bf[1], z16, 0, 0, 0);
            f32x16 D2 = __builtin_amdgcn_mfma_f32_32x32x16_bf16(cur[c], Bf[2], z16, 0, 0, 0);
            f32x16 D3 = __builtin_amdgcn_mfma_f32_32x32x16_bf16(cur[c], Bf[3], z16, 0, 0, 0);
            f32x4 acc0 = (f32x4){0.f, 0.f, 0.f, 0.f}, acc1 = acc0;
            asm volatile("" : "+v"(D0), "+v"(D1), "+v"(D2), "+v"(D3), "+v"(acc0), "+v"(acc1) :: "memory");
#pragma unroll
            for (int ks = 0; ks < 4; ++ks) {
                acc0 = __builtin_amdgcn_mfma_f32_16x16x32_bf16(Cf[ks], a0[ks], acc0, 0, 0, 0);
                acc1 = __builtin_amdgcn_mfma_f32_16x16x32_bf16(Cf[ks], a1[ks], acc1, 0, 0, 0);
            }
            asm volatile("s_waitcnt lgkmcnt(0)\n\ts_nop 15\n\ts_nop 15" : "+v"(acc0), "+v"(acc1) :: "memory");
            if (q0 > 0) {
                bf16* yb = Y + (ptrdiff_t)chain_row(q0 - 32, dir, b) * SSMW;
                u32x2 w0, w1; w0.x = pk2(acc0[0], acc0[1]); w0.y = pk2(acc0[2], acc0[3]); w1.x = pk2(acc1[0], acc1[1]); w1.y = pk2(acc1[2], acc1[3]);
                *(u32x2*)(yb + yo0) = w0;
                *(u32x2*)(yb + yo1) = w1;
            }
            asm volatile("s_nop 3" : "+v"(D0), "+v"(D1), "+v"(D2), "+v"(D3));
            float bre[32], bim[32];
#pragma unroll
            for (int r = 0; r < 16; ++r) { const int p0 = (r & 3) + 8 * (r >> 2);
                auto rr = __builtin_amdgcn_permlane32_swap(__float_as_uint(D0[r]), __float_as_uint(D1[r]), false, false);
                bre[p0] = __uint_as_float(rr[0]); bre[p0 + 4] = __uint_as_float(rr[1]);
                auto ri = __builtin_amdgcn_permlane32_swap(__float_as_uint(D2[r]), __float_as_uint(D3[r]), false, false);
                bim[p0] = __uint_as_float(ri[0]); bim[p0 + 4] = __uint_as_float(ri[1]); }
#pragma unroll
            for (int pos = 0; pos < 32; pos += 2) {
                const float nr = fmaf(-li, hi, fmaf(lr, hr, bre[pos]));
                const float ni = fmaf(li, hr, fmaf(lr, hi, bim[pos]));
                const unsigned p0 = pk2(nr, ni);
                hr = fmaf(-li, ni, fmaf(lr, nr, bre[pos + 1]));
                hi = fmaf(li, nr, fmaf(lr, ni, bim[pos + 1]));
                const unsigned p1 = pk2(hr, hi);
                asm volatile("ds_write2_b32 %0, %1, %2 offset0:%3 offset1:%4" :: "v"(wad + (unsigned)((c & 1) * STASH_BUFB)), "v"(p0), "v"(p1), "n"(4 * pos), "n"(4 * pos + 4) : "memory");
            }
        }
#pragma unroll
        for (int c = 0; c < 8; ++c) cur[c] = nxt[c];
    }
    {
        const LAS unsigned char* stp = stash + 1 * STASH_BUFB;
        asm volatile("s_waitcnt lgkmcnt(0)" ::: "memory");
        f32x4 acc0 = (f32x4){0.f, 0.f, 0.f, 0.f}, acc1 = acc0;
#pragma unroll
        for (int ks = 0; ks < 4; ++ks) {
            const bf16x8 a0 = *(const LAS bf16x8*)(stp + (4 * ks + (lane >> 4)) * STASH_KCB + (lane & 15) * 16);
            const bf16x8 a1 = *(const LAS bf16x8*)(stp + (4 * ks + (lane >> 4)) * STASH_KCB + (16 + (lane & 15)) * 16);
            acc0 = __builtin_amdgcn_mfma_f32_16x16x32_bf16(Cf[ks], a0, acc0, 0, 0, 0);
            acc1 = __builtin_amdgcn_mfma_f32_16x16x32_bf16(Cf[ks], a1, acc1, 0, 0, 0);
        }
        asm volatile("s_waitcnt lgkmcnt(0)\n\ts_nop 15\n\ts_nop 15" : "+v"(acc0), "+v"(acc1) :: "memory");
        bf16* yb = Y + (ptrdiff_t)chain_row(256 * 16 + 32 * 7, dir, b) * SSMW;
        u32x2 w0, w1; w0.x = pk2(acc0[0], acc0[1]); w0.y = pk2(acc0[2], acc0[3]); w1.x = pk2(acc1[0], acc1[1]); w1.y = pk2(acc1[2], acc1[3]);
        *(u32x2*)(yb + yo0) = w0;
        *(u32x2*)(yb + yo1) = w1;
    }
}
__device__ __forceinline__ void phase_mix_a(ArgsP a, LAS unsigned char* lds, int l, int mrows, int wave, int lane, int tid) {
    const bf16* u = (const bf16*)(a->ws + WS_BUFB);
    if (wave < 2) {
        const int bx = blockIdx.x, xcd = bx & 7, jj = bx >> 3;
        for (int it = jj; it < 32; it += (int)(gridDim.x >> 3)) {
            const int g = 4 * xcd + (it & 3), b = it >> 2;
            bf16* Y = (bf16*)(a->ws + WS_BUFA) + (size_t)wave * MALL * SSMW;
            ssm_chain(lds + wave * 32768, u, Y, (const float*)(a->ws + WS_LAM), (const bf16*)(a->ws + WS_BB), (const bf16*)(a->ws + WS_CM), l, b, g, wave, lane);
        }
    } else if (wave != 4 && wave != 5) {
        const int per = mrows / 256;
        for (int wgi = blockIdx.x; wgi < 256; wgi += gridDim.x) pool_rows(u, (bf16*)(a->ws + WS_BUFC), wgi * per, per / 8, (wave < 4) ? wave - 2 : wave - 4, lane);
    }
}

__device__ __forceinline__ float gelu_tanh(float x) { const float z = 0.7978845608028654f * (x + 0.044715f * x * x * x); return x * sigmoidf_(2.0f * z); }
__device__ __forceinline__ int glu_lds_off(int row, int chunk) { return row * 1024 + ((chunk ^ (row & 15)) << 4); }
__device__ __forceinline__ void phase_mix_b(ArgsP a, LAS unsigned char* lds, int l, int mrows, int tid, int wave, int lane) {
    const bf16* Y0 = (const bf16*)(a->ws + WS_BUFA); const bf16* Y1 = Y0 + (size_t)MALL * SSMW;
    const bf16* u = (const bf16*)(a->ws + WS_BUFB);
    const float* Dv = a->in[IN_SSMD] + l * SSMW;
    const bf16* Wg = (const bf16*)(a->ws + WS_WT) + (size_t)l * WT_LAYER + WT_GLU;
    bf16* PA = (bf16*)(a->ws + WS_BUFC);
    const int RPW = mrows / 256;
    for (int wgi = blockIdx.x; wgi < 256; wgi += gridDim.x) {
        const int row0 = wgi * RPW;
        {
            const int c = lane, k0 = 8 * c;
            const f32x4 d0 = *(const f32x4*)(Dv + k0), d1 = *(const f32x4*)(Dv + k0 + 4);
#pragma unroll 4
            for (int i = 0; i < RPW / 8; ++i) {
                const int r = wave + 8 * i; const size_t mr = (size_t)(row0 + r);
                const u32x4 y0w = __builtin_nontemporal_load((const u32x4*)(Y0 + mr * SSMW + k0)), y1w = __builtin_nontemporal_load((const u32x4*)(Y1 + mr * SSMW + k0));
                const f32x4 y00 = (f32x4){bflo(y0w.x), bfhi(y0w.x), bflo(y0w.y), bfhi(y0w.y)}, y01 = (f32x4){bflo(y0w.z), bfhi(y0w.z), bflo(y0w.w), bfhi(y0w.w)};
                const f32x4 y10 = (f32x4){bflo(y1w.x), bfhi(y1w.x), bflo(y1w.y), bfhi(y1w.y)}, y11 = (f32x4){bflo(y1w.z), bfhi(y1w.z), bflo(y1w.w), bfhi(y1w.w)};
                const u32x4 uw = *(const u32x4*)(u + mr * DM + POOLW + k0);
                const f32x4 u0 = (f32x4){bflo(uw.x), bfhi(uw.x), bflo(uw.y), bfhi(uw.y)}, u1 = (f32x4){bflo(uw.z), bfhi(uw.z), bflo(uw.w), bfhi(uw.w)};
                const f32x4 v0 = y00 + y10 + d0 * u0, v1 = y01 + y11 + d1 * u1;
                u32x4 w; w.x = pk2(gelu_tanh(v0.x), gelu_tanh(v0.y)); w.y = pk2(gelu_tanh(v0.z), gelu_tanh(v0.w)); w.z = pk2(gelu_tanh(v1.x), gelu_tanh(v1.y)); w.w = pk2(gelu_tanh(v1.z), gelu_tanh(v1.w));
                *(LAS u32x4*)(lds + glu_lds_off(r, c)) = w;
            }
        }
        __syncthreads();
#pragma unroll 1
        for (int mh = 0; mh < 2; ++mh) {
            const int fr = lane & 15, kq = lane >> 4, nbase = 64 * wave, mb0 = 5 * mh;
            f32x4 acc[5][4];
#pragma unroll
            for (int mb = 0; mb < 5; ++mb)
#pragma unroll
                for (int nb = 0; nb < 4; ++nb) acc[mb][nb] = (f32x4){0.f, 0.f, 0.f, 0.f};
            const bf16* wrow = Wg + (size_t)(nbase + fr) * SSMW + 8 * kq;
            bf16x8 Wc[4], Wn[4];
#pragma unroll
            for (int nb = 0; nb < 4; ++nb) Wc[nb] = *(const bf16x8*)(wrow + (size_t)(16 * nb) * SSMW);
#pragma unroll 1
            for (int ks = 0; ks < 16; ++ks) {
                if (ks + 1 < 16) {
#pragma unroll
                    for (int nb = 0; nb < 4; ++nb) Wn[nb] = *(const bf16x8*)(wrow + (size_t)(16 * nb) * SSMW + 32 * (ks + 1));
                }
#pragma unroll
                for (int mb = 0; mb < 5; ++mb) {
                    int rr = 16 * (mb0 + mb) + fr; rr = rr < RPW ? rr : RPW - 1;
                    const bf16x8 af = *(const LAS bf16x8*)(lds + glu_lds_off(rr, 4 * ks + kq));
#pragma unroll
                    for (int nb = 0; nb < 4; ++nb) acc[mb][nb] = __builtin_amdgcn_mfma_f32_16x16x32_bf16(Wc[nb], af, acc[mb][nb], 0, 0, 0);
                }
#pragma unroll
                for (int nb = 0; nb < 4; ++nb) Wc[nb] = Wn[nb];
            }
#pragma unroll
            for (int mb = 0; mb < 5; ++mb) {
                const int tok = 16 * (mb0 + mb) + fr;
                if (tok < RPW) {
#pragma unroll
                    for (int nb = 0; nb < 4; ++nb) {
                        const int n = nbase + 16 * nb + 4 * kq;
                        const u32x2 yw = *(const LAS u32x2*)(lds + glu_lds_off(tok, n >> 3) + (n & 7) * 2);
                        const f32x4 g = acc[mb][nb];
                        u32x2 o; o.x = pk2(bflo(yw.x) * sigmoidf_(g.x), bfhi(yw.x) * sigmoidf_(g.y)); o.y = pk2(bflo(yw.y) * sigmoidf_(g.z), bfhi(yw.y) * sigmoidf_(g.w));
                        *(u32x2*)(PA + (size_t)(row0 + tok) * DM + POOLW + n) = o;
                    }
                }
            }
        }
        __syncthreads();
    }
}

struct ConvF { f32x4 v[3], g[3]; };
constexpr int CV_ROWB = 1024, CV_COLB = 10 * CV_ROWB, CV_PAIRB = 2 * CV_COLB, CV_DEPTH = 6;
__device__ __forceinline__ void conv_wg_item(LAS unsigned char* lds, const bf16* z  , bf16* aout  , const float* wc, int mloc0, int mglob0, int cg, int wave, int lane) {
    const bool ctx = mglob0 >= MLAT;
    const int gr0 = (mglob0 >> 6) & 63;
    const int f0c = cg * 256, f0 = f0c + 4 * lane;
    f32x4 wv[3][3], wg[3][3];
#pragma unroll
    for (int i = 0; i < 3; ++i)
#pragma unroll
        for (int j = 0; j < 3; ++j) { wv[i][j] = *(const f32x4*)(wc + (size_t)(i * 3 + j) * DFF2 + f0); wg[i][j] = *(const f32x4*)(wc + (size_t)(i * 3 + j) * DFF2 + DFF + f0); }
    asm volatile("s_waitcnt vmcnt(0)" : "+v"(wv[0][0]), "+v"(wv[0][1]), "+v"(wv[0][2]), "+v"(wv[1][0]), "+v"(wv[1][1]), "+v"(wv[1][2]), "+v"(wv[2][0]), "+v"(wv[2][1]), "+v"(wv[2][2]),
                 "+v"(wg[0][0]), "+v"(wg[0][1]), "+v"(wg[0][2]), "+v"(wg[1][0]), "+v"(wg[1][1]), "+v"(wg[1][2]), "+v"(wg[2][0]), "+v"(wg[2][1]), "+v"(wg[2][2]) :: "memory");
    const int mrun = mglob0 + 64 * wave;
    bool up, down, left, right;
    if (!ctx) { const int gr = (mrun >> 6) & 63; up = gr > 0; down = gr < 63; left = false; right = false; }
    else { const int seg = ((mrun - MLAT) >> 6) & 3; up = false; down = false; left = seg > 0; right = seg < 3; }
    bf16* ao = aout + (size_t)(mloc0 + 64 * wave) * DFF + f0;
    const int lane_off = (lane < 32) ? (f0c + 8 * lane) : (DFF + f0c + 8 * (lane - 32));
#define CV_DMA(hr, k, p, kc) do { int jj_ = (hr) - 1; bool rv_; \
        if (!ctx) { rv_ = (jj_ >= 0 && jj_ < 8) || (jj_ < 0 && gr0 > 0) || (jj_ == 8 && gr0 + 8 < 64); } else { rv_ = (jj_ >= 0 && jj_ < 8); } \
        if (!rv_) jj_ = jj_ < 0 ? 0 : 7; \
        int kk_ = (k); bool cv_ = (kk_ >= 0 && kk_ < GRIDW); \
        if (!cv_ && ctx && rv_) { const int sg_ = ((mglob0 + 64 * jj_ - MLAT) >> 6) & 3; cv_ = (kk_ < 0) ? (sg_ > 0) : (sg_ < 3); } \
        if (!cv_) kk_ = kk_ < 0 ? 0 : GRIDW - 1; \
        const bf16* src_ = z + (size_t)(mloc0 + 64 * jj_ + kk_) * DFF2 + lane_off; \
        __builtin_amdgcn_global_load_lds((const unsigned*)src_, (LAS unsigned*)(lds + ((p) % CV_DEPTH) * CV_PAIRB + (kc) * CV_COLB + (hr) * CV_ROWB), 16, 0, 2); } while (0)
#define CV_DMA_PAIR(p) do { const int pp_ = (p) > 32 ? 32 : (p);   \
        CV_DMA(wave, 2 * pp_ - 1, p, 0); CV_DMA(wave, 2 * pp_, p, 1); \
        if (wave < 2) { CV_DMA(8 + wave, 2 * pp_ - 1, p, 0); CV_DMA(8 + wave, 2 * pp_, p, 1); } } while (0)
#define CV_F4(w2) ((f32x4){bflo((w2).x), bfhi((w2).x), bflo((w2).y), bfhi((w2).y)})
    const f32x4 zero4 = (f32x4){0.f, 0.f, 0.f, 0.f};
#define CV_CVT(slot, p, kc, k) do { const bool cok_ = ((k) >= 0 && (k) < GRIDW) || ((k) < 0 && left) || ((k) >= GRIDW && right); \
        LAS const unsigned char* b_ = lds + ((p) % CV_DEPTH) * CV_PAIRB + (kc) * CV_COLB + wave * CV_ROWB + 8 * lane; \
        _Pragma("unroll") for (int i_ = 0; i_ < 3; ++i_) { const bool ok_ = cok_ && (i_ == 1 || (i_ == 0 && up) || (i_ == 2 && down)); \
            if (ok_) { const u32x2 a_ = *(LAS const u32x2*)(b_ + i_ * CV_ROWB), g_ = *(LAS const u32x2*)(b_ + i_ * CV_ROWB + 512); F[slot].v[i_] = CV_F4(a_); F[slot].g[i_] = CV_F4(g_); } \
            else { F[slot].v[i_] = zero4; F[slot].g[i_] = zero4; } } } while (0)
#define CV_OUT(c, sm, s0, sp) do { f32x4 ov = wv[0][0] * F[sm].v[0], og = wg[0][0] * F[sm].g[0]; \
        ov += wv[1][0] * F[sm].v[1]; og += wg[1][0] * F[sm].g[1]; ov += wv[2][0] * F[sm].v[2]; og += wg[2][0] * F[sm].g[2]; \
        _Pragma("unroll") for (int i_ = 0; i_ < 3; ++i_) { ov += wv[i_][1] * F[s0].v[i_]; og += wg[i_][1] * F[s0].g[i_]; ov += wv[i_][2] * F[sp].v[i_]; og += wg[i_][2] * F[sp].g[i_]; } \
        const f32x4 o_ = ov * og * (f32x4){sigmoidf_(og.x), sigmoidf_(og.y), sigmoidf_(og.z), sigmoidf_(og.w)}; \
        u32x2 w_; w_.x = pk2(o_.x, o_.y); w_.y = pk2(o_.z, o_.w); st8_wt(ao + (size_t)(c) * DFF, w_); } while (0)
#define CV_ARRIVE(p, EXACT) do { if (EXACT) { if (wave < 2) asm volatile("s_waitcnt vmcnt(26)" ::: "memory"); else asm volatile("s_waitcnt vmcnt(18)" ::: "memory"); } \
        else { if (wave < 2) asm volatile("s_waitcnt vmcnt(16)" ::: "memory"); else asm volatile("s_waitcnt vmcnt(8)" ::: "memory"); } \
        asm volatile("s_waitcnt lgkmcnt(0)" ::: "memory"); __builtin_amdgcn_s_barrier(); asm volatile("" ::: "memory"); CV_DMA_PAIR((p) + 5); } while (0)
    ConvF F[4];
    CV_DMA_PAIR(0); CV_DMA_PAIR(1); CV_DMA_PAIR(2); CV_DMA_PAIR(3); CV_DMA_PAIR(4);
    CV_ARRIVE(0, false); CV_CVT(0, 0, 0, -1); CV_CVT(1, 0, 1, 0);
#pragma unroll 1
    for (int q = 0; q < 16; ++q) {
        const int po = 2 * q + 1, pe = 2 * q + 2;
        const bool ex = q >= 3;
        CV_ARRIVE(po, ex); CV_CVT(2, po, 0, 2 * po - 1); CV_CVT(3, po, 1, 2 * po);
        CV_OUT(2 * po - 2, 0, 1, 2); CV_OUT(2 * po - 1, 1, 2, 3);
        CV_ARRIVE(pe, ex); CV_CVT(0, pe, 0, 2 * pe - 1); CV_CVT(1, pe, 1, 2 * pe);
        CV_OUT(2 * pe - 2, 2, 3, 0); CV_OUT(2 * pe - 1, 3, 0, 1);
    }
    asm volatile("s_waitcnt vmcnt(0) lgkmcnt(0)" ::: "memory"); __builtin_amdgcn_s_barrier(); asm volatile("" ::: "memory");
#undef CV_DMA
#undef CV_DMA_PAIR
#undef CV_F4
#undef CV_CVT
#undef CV_OUT
#undef CV_ARRIVE
}
__device__ __forceinline__ void phase_conv(ArgsP a, LAS unsigned char* lds, int l, int r0, int r1, const bf16* z, bf16* aout, int wave, int lane) {
    const float* wc = a->in[IN_WCONV] + (size_t)l * 9 * DFF2;
    const int nitems = ((r1 - r0) / (GRIDW * 8)) * 22;
    for (int it = blockIdx.x; it < nitems; it += gridDim.x) {
        const int rb = it / 22, cg = it % 22;
        conv_wg_item(lds, z, aout, wc, rb * 8 * GRIDW, r0 + rb * 8 * GRIDW, cg, wave, lane);
    }
}

constexpr int PH_PER_LAYER = 13;
constexpr int PH_TOTAL = 2 + DEPTH * PH_PER_LAYER;
constexpr int NORM_WGS = 64;

__global__ void __launch_bounds__(NTHREADS, 2) mk_fwd(Args args) {
    extern __shared__ __attribute__((aligned(16))) unsigned char lds_raw[];
    LAS unsigned char* lds = (LAS unsigned char*)lds_raw;
    const ArgsP kp = (ArgsP)__builtin_amdgcn_kernarg_segment_ptr();
    (void)args;
    volatile LAS unsigned* MISC = (volatile LAS unsigned*)(lds + MISC_OFF);
    if (threadIdx.x < 64) MISC[threadIdx.x] = 0u;
    __syncthreads();
    const int lo = kp->seg_lo, hi = kp->seg_hi;
    XcdBarrier bar; bar.bar = (unsigned*)(kp->ws + WS_CTL) + CW_BAR; bar.x = 0; bar.st = MISC + 8;
    if (hi - lo > 1) bar = xcd_barrier_post((unsigned*)(kp->ws + WS_CTL) + CW_BAR, MISC + 8);
#ifndef PHEN
#define PHEN 0xffff
#endif
#define IN(k) (lo <= (k) && (k) < hi)
#define SEAM(k) do { if ((k) + 1 < hi) xcd_barrier(bar); } while (0)
#define REP(bit) for (int rep_ = 0, nrep_ = ((kp->dup & (bit)) ? 2 : 1); rep_ < nrep_; ++rep_)
#define TIDV int tid_ = threadIdx.x; asm volatile("" : "+v"(tid_)); const int tid = tid_, lane = tid & 63, wave = __builtin_amdgcn_readfirstlane(tid >> 6); const int G = gridDim.x, gw = blockIdx.x * NWAVES + wave, ngw = G * NWAVES; (void)lane; (void)gw; (void)ngw; (void)G

    if ((PHEN & 1) && IN(0)) { TIDV; phase_prologue(launder(kp), lds, tid, wave, lane); SEAM(0); }
    if ((PHEN & 2) && IN(1)) {
        TIDV; const ArgsP a = launder(kp); float* MOD = (float*)(a->ws + WS_MOD);
        NormP P; P.y = nullptr; P.y_row0 = 0; P.xin_lat = a->in[IN_X]; P.xin_ctx = a->in[IN_CTX]; P.xb = (bf16*)(a->ws + WS_XB); P.out_f32 = nullptr; P.h = (bf16*)(a->ws + WS_BUFA);
        P.gate = nullptr; P.g_post = nullptr; P.g_pre = a->in[IN_GPREMIX]; P.shift = MOD + 0 * DM; P.scale = MOD + 1 * DM;
        phase_norm(P, 0, MALL, gw, ngw, lane);
        SEAM(1);
    }
    for (int l = 0; l < DEPTH; ++l) {
        const int pb = 2 + l * PH_PER_LAYER;
        if (pb + PH_PER_LAYER <= lo || pb >= hi) continue;
        const int mrows = (l == DEPTH - 1) ? MLAT : MALL;
        if ((PHEN & 4) && IN(pb + 0)) {
            const ArgsP a = launder(kp); const pg8::bf16_t* WTL = (const pg8::bf16_t*)(a->ws + WS_WT) + (size_t)l * WT_LAYER;
            pg8::Gemm g{(const bf16*)(a->ws + WS_BUFA), WTL + WT_IN, MALL, DM, DM}; pg8::StaticOrder S; S.init(MALL, DM, (int)gridDim.x, (int)blockIdx.x);
            pg8::EpiBf16 E{(bf16*)(a->ws + WS_BUFB), DM};
            REP(4) pg8::gemm_phase<pg8::EpiBf16, pg8::StaticOrder, true, true>(lds, g, S, E);
            SEAM(pb + 0);
        }
        if ((PHEN & 8) && IN(pb + 1)) { TIDV; REP(8) phase_mix_a(launder(kp), lds, l, mrows, wave, lane, tid); SEAM(pb + 1); }
        if ((PHEN & 16) && IN(pb + 2)) { TIDV; REP(16) phase_mix_b(launder(kp), lds, l, mrows, tid, wave, lane); SEAM(pb + 2); }
        if ((PHEN & 32) && IN(pb + 3)) {
            const ArgsP a = launder(kp); const pg8::bf16_t* WTL = (const pg8::bf16_t*)(a->ws + WS_WT) + (size_t)l * WT_LAYER;
            pg8::Gemm g{(const bf16*)(a->ws + WS_BUFC), WTL + WT_COMB, mrows, DM, DM}; pg8::StaticOrder S; S.init(mrows, DM, (int)gridDim.x, (int)blockIdx.x);
            pg8::EpiBf16 E{(bf16*)(a->ws + WS_BUFB), DM};
            REP(4) pg8::gemm_phase<pg8::EpiBf16, pg8::StaticOrder, true, true>(lds, g, S, E);
            SEAM(pb + 3);
        }
        if ((PHEN & 64) && IN(pb + 4)) {
            TIDV; const ArgsP a = launder(kp); const float* MODL = (const float*)(a->ws + WS_MOD) + (size_t)l * 9 * 6 * DM;
            NormP P; P.y = (const bf16*)(a->ws + WS_BUFB); P.y_row0 = 0; P.xin_lat = nullptr; P.xin_ctx = nullptr; P.xb = (bf16*)(a->ws + WS_XB); P.out_f32 = nullptr; P.h = (bf16*)(a->ws + WS_BUFA);
            P.gate = MODL + 2 * DM; P.g_post = a->in[IN_GPOSTMIX] + l * DM; P.g_pre = a->in[IN_GPREFFN] + l * DM; P.shift = MODL + 3 * DM; P.scale = MODL + 4 * DM;
            phase_norm(P, 0, mrows, gw, ngw, lane);
            SEAM(pb + 4);
        }
        for (int hf = 0; hf < 2; ++hf) {
            const int nhalf = kp->nhalf;
            if (hf >= nhalf) break;
            const int r0 = (nhalf == 1) ? 0 : (hf == 0 ? 0 : HALF1_ROW0), r1 = (nhalf == 1) ? mrows : (hf == 0 ? HALF1_ROW0 : mrows);
            const int ph = pb + 5 + 4 * hf;
            const size_t a_off = (nhalf == 1) ? WS_BUFA : WS_BUFB, f_off = (nhalf == 1) ? WS_Z : (hf == 0 ? WS_BUFB + A_HALF : WS_Z);
            const bool pair_norm0 = (nhalf == 2 && l < DEPTH - 1);
            if ((PHEN & 128) && IN(ph + 0)) {
                const ArgsP a = launder(kp); const pg8::bf16_t* WTL = (const pg8::bf16_t*)(a->ws + WS_WT) + (size_t)l * WT_LAYER;
                pg8::Gemm g{(const bf16*)(a->ws + WS_BUFA) + (size_t)r0 * DM, WTL + WT_UP, r1 - r0, DFF2, DM}; pg8::StaticOrder S; S.init(r1 - r0, DFF2, (int)gridDim.x, (int)blockIdx.x);
                pg8::EpiBf16 E{(bf16*)(a->ws + WS_Z), DFF2};
                REP(4) pg8::gemm_phase<pg8::EpiBf16, pg8::StaticOrder, true, true>(lds, g, S, E);
                SEAM(ph + 0);
            }
            if ((PHEN & 256) && IN(ph + 1)) { TIDV; const ArgsP a = launder(kp); REP(256) phase_conv(a, lds, l, r0, r1, (const bf16*)(a->ws + WS_Z), (bf16*)(a->ws + a_off), wave, lane); SEAM(ph + 1); }
            if ((PHEN & 512) && IN(ph + 2)) {
                const bool paired = pair_norm0 && hf == 1;
                const int gG = paired ? (int)gridDim.x - NORM_WGS : (int)gridDim.x;
                if ((int)blockIdx.x < gG) {
                    const ArgsP a = launder(kp); const pg8::bf16_t* WTL = (const pg8::bf16_t*)(a->ws + WS_WT) + (size_t)l * WT_LAYER;
                    pg8::Gemm g{(const bf16*)(a->ws + a_off), WTL + WT_DOWN, r1 - r0, DM, DFF}; pg8::StaticOrder S; S.init(r1 - r0, DM, gG, (int)blockIdx.x);
                    pg8::EpiBf16 E{(bf16*)(a->ws + f_off), DM};
                    REP(4) pg8::gemm_phase<pg8::EpiBf16, pg8::StaticOrder, true, true>(lds, g, S, E);
                } else {
                    TIDV; const ArgsP a = launder(kp);
                    const float* MODL = (const float*)(a->ws + WS_MOD) + (size_t)l * 9 * 6 * DM; const float* MODN = MODL + 9 * 6 * DM;
                    NormP P; P.y = (const bf16*)(a->ws + WS_BUFB + A_HALF); P.y_row0 = 0; P.xin_lat = nullptr; P.xin_ctx = nullptr; P.xb = (bf16*)(a->ws + WS_XB); P.out_f32 = nullptr;
                    P.h = (bf16*)(a->ws + WS_BUFA);
                    P.gate = MODL + 5 * DM; P.g_post = a->in[IN_GPOSTFFN] + l * DM;
                    P.g_pre = a->in[IN_GPREMIX] + (l + 1) * DM; P.shift = MODN + 0 * DM; P.scale = MODN + 1 * DM;
                    phase_norm(P, 0, HALF1_ROW0, ((int)blockIdx.x - gG) * NWAVES + wave, NORM_WGS * NWAVES, lane);
                }
                SEAM(ph + 2);
            }
            if ((PHEN & 1024) && IN(ph + 3) && !(pair_norm0 && hf == 0)) {
                TIDV; const ArgsP a = launder(kp); const bool lastl = (l == DEPTH - 1);
                const float* MODL = (const float*)(a->ws + WS_MOD) + (size_t)l * 9 * 6 * DM; const float* MODN = MODL + (lastl ? 0 : 9 * 6 * DM);
                NormP P; P.y = (const bf16*)(a->ws + f_off); P.y_row0 = r0; P.xin_lat = nullptr; P.xin_ctx = nullptr; P.xb = (bf16*)(a->ws + WS_XB); P.out_f32 = lastl ? a->out : nullptr;
                P.h = lastl ? nullptr : (bf16*)(a->ws + WS_BUFA);
                P.gate = MODL + 5 * DM; P.g_post = a->in[IN_GPOSTFFN] + l * DM;
                P.g_pre = a->in[IN_GPREMIX] + (lastl ? l : l + 1) * DM; P.shift = MODN + 0 * DM; P.scale = MODN + 1 * DM;
                phase_norm(P, r0, r1, gw, ngw, lane);
                SEAM(ph + 3);
            }
        }
    }
#undef IN
#undef SEAM
#undef TIDV
}

extern "C" void kernel_launch(void* const* d_in, const int* in_sizes, int n_in, void* d_out, int out_size, void* d_ws, size_t ws_size, hipStream_t stream) {
    static int grid = 0;
    if (grid == 0) {
        if (n_in != 26 || out_size != MLAT * DM || ws_size < WS_NEED_HALF) { fprintf(stderr, "kernel_launch: unexpected problem shape / workspace (n_in %d, out %d, ws %zu, need %zu)\n", n_in, out_size, ws_size, (size_t)WS_NEED_HALF); grid = -1; return; }
        int dev = 0, cus = 0, per_cu = 0;
        if (hipGetDevice(&dev) != hipSuccess || hipDeviceGetAttribute(&cus, hipDeviceAttributeMultiprocessorCount, dev) != hipSuccess) { grid = -1; return; }
        if (hipFuncSetAttribute((const void*)mk_fwd, hipFuncAttributeMaxDynamicSharedMemorySize, LDS_BYTES) != hipSuccess) { fprintf(stderr, "kernel_launch: hipFuncSetAttribute failed\n"); grid = -1; return; }
        if (hipOccupancyMaxActiveBlocksPerMultiprocessor(&per_cu, (const void*)mk_fwd, NTHREADS, LDS_BYTES) != hipSuccess || per_cu < 1)
            fprintf(stderr, "kernel_launch: note: occupancy query reports %d workgroups per CU\n", per_cu);
        (void)hipGetLastError();
        grid = cus;
        if (grid != 256) fprintf(stderr, "kernel_launch: note: %d CUs (built for 256)\n", grid);
    }
    if (grid < 0) return;
    if (hipMemsetAsync((char*)d_ws + WS_CTL, 0, CTL_BYTES, stream) != hipSuccess) { fprintf(stderr, "kernel_launch: memset failed\n"); return; }
    Args a{};
    for (int i = 0; i < 26; ++i) a.in[i] = (const float*)d_in[i];
    a.out = (float*)d_out; a.ws = (unsigned char*)d_ws;
    a.nhalf = 2;
    a.dup = MK_DUP;
#if MK_MULTI_LAUNCH
    for (int ph = 0; ph < PH_TOTAL; ++ph) {
        if (ph >= 2) { const int k = (ph - 2) % PH_PER_LAYER, ll = (ph - 2) / PH_PER_LAYER; if (a.nhalf == 1 && k >= 9) continue; if (a.nhalf == 2 && k == 8 && ll < DEPTH - 1) continue; }
        a.seg_lo = ph; a.seg_hi = ph + 1;
        hipLaunchKernelGGL(mk_fwd, dim3(grid), dim3(NTHREADS), LDS_BYTES, stream, a);
    }
#else
    a.seg_lo = 0; a.seg_hi = PH_TOTAL;
    hipLaunchKernelGGL(mk_fwd, dim3(grid), dim3(NTHREADS), LDS_BYTES, stream, a);
#endif
    const hipError_t le = hipPeekAtLastError();
    if (le != hipSuccess) fprintf(stderr, "kernel_launch: launch failed: %s\n", hipGetErrorName(le));
}
```

```cpp
#include <hip/hip_runtime.h>
#include <cstdio>
#include <cstdint>

#ifndef MK_DUP
#define MK_DUP 0
#endif
#ifndef MK_MULTI_LAUNCH
#define MK_MULTI_LAUNCH 0
#endif

namespace pg8 {
#define PG8_LAS __attribute__((address_space(3)))
typedef unsigned short bf16_t;
typedef short bf16x8 __attribute__((ext_vector_type(8)));
typedef float f32x4 __attribute__((ext_vector_type(4)));
typedef unsigned u32x4 __attribute__((ext_vector_type(4)));
constexpr int BM = 256, BK = 64, HALF = 128, HTB = HALF * BK * 2, STAGE_BYTES = 8 * HTB, NXCD = 8, WGM = 8;

__host__ __device__ __forceinline__ int lds_byte(int r, int c) { const int st = (r >> 4) * 2 + (c >> 5), rr = r & 15, cc = c & 31, ob = rr * 64 + cc * 2; return st * 1024 + (ob ^ (((ob >> 9) & 1) << 5)); }
__host__ __device__ __forceinline__ void stage_rc(int b, int& R, int& C) { const int st = b / 1024, sb = b % 1024, swz = sb ^ (((sb >> 9) & 1) << 5); R = (st >> 1) * 16 + swz / 64; C = (st & 1) * 32 + (swz % 64) / 2; }
__host__ __device__ __forceinline__ int perm32(int rho) { const int n = rho >> 4, i = rho & 15; return 8 * (i >> 2) + 4 * n + (i & 3); }

struct Unit { int pm, pn; };
struct Gemm { const bf16_t* A; const bf16_t* Bt; int M, N, K; };

struct StaticOrder {
    int nM, nN, nwg, G, c;
    __host__ __device__ void init(int M, int N, int G_, int c_) { nM = M / BM; nN = N / BM; nwg = nM * nN; G = G_; c = c_; }
    __host__ __device__ bool next(int i, Unit& u) const {
        const long L = (long)i * G + c; if (L >= nwg) return false;
        int wgid = (int)L; { const int q = nwg / NXCD, r = nwg % NXCD, xcd = wgid % NXCD, off = wgid / NXCD; wgid = (xcd < r ? xcd * (q + 1) : r * (q + 1) + (xcd - r) * q) + off; }
        const int nig = WGM * nN, gid = wgid / nig, fm = gid * WGM, gsz = (nM - fm) < WGM ? (nM - fm) : WGM;
        u.pm = fm + ((wgid % nig) % gsz); u.pn = (wgid % nig) / gsz; return true;
    }
    __device__ __forceinline__ void a_ready(const Unit&) const {}
    __device__ __forceinline__ void done(const Unit&) const {}
};

__device__ __forceinline__ unsigned cvt_pk_bf16(float lo, float hi) { unsigned r; asm volatile("v_cvt_pk_bf16_f32 %0, %1, %2" : "=v"(r) : "v"(lo), "v"(hi)); return r; }

struct EpiBf16 {
    static constexpr bool PERM = true, AFTER_DRAIN = false;
    bf16_t* O; int ldc;
    __device__ __forceinline__ void operator()(const f32x4 (&acc)[2][2][4][2], const Unit& u, int wr, int wc, int fr, int fq, bool last) const {
        const int row0 = u.pm * BM + wr * 64 + fr; const int col0 = u.pn * BM + wc * 32 + 8 * fq;
#pragma unroll
        for (int ai = 0; ai < 2; ++ai)
#pragma unroll
            for (int m = 0; m < 4; ++m) { bf16_t* rowp = O + (size_t)(row0 + ai * HALF + m * 16) * ldc + col0;
#pragma unroll
                for (int bj = 0; bj < 2; ++bj) { const f32x4 v0 = acc[ai][bj][m][0], v1 = acc[ai][bj][m][1];
                    u32x4 w; w.x = cvt_pk_bf16(v0[0], v0[1]); w.y = cvt_pk_bf16(v0[2], v0[3]); w.z = cvt_pk_bf16(v1[0], v1[1]); w.w = cvt_pk_bf16(v1[2], v1[3]);
                    if (last) asm volatile("global_store_dwordx4 %0, %1, off sc1\n\ts_nop 1" :: "v"(rowp + bj * HALF), "v"(w) : "memory"); else *(u32x4*)(rowp + bj * HALF) = w; } }
    }
};

template <class Epi, class Sched, bool ALIGN_EPI = false, bool SP2 = false>
__device__ __forceinline__ void gemm_phase(PG8_LAS unsigned char* lds, const Gemm g, const Sched& S, const Epi& E) {
    int tid_ = threadIdx.x; asm volatile("" : "+v"(tid_));
    const int tid = tid_, wid = __builtin_amdgcn_readfirstlane(tid >> 6), lane = tid & 63, wr = wid >> 2, wc = wid & 3, fr = lane & 15, fq = lane >> 4;
    const int K = g.K, nt = K / BK;
    unsigned voffA[2], voffB[2];
#pragma unroll
    for (int i = 0; i < 2; ++i) { int R, C; stage_rc(tid * 16 + i * 8192, R, C); const int Rb = Epi::PERM ? ((R & ~31) + perm32(R & 31)) : R;
        voffA[i] = (unsigned)(R * K + C) * 2u; voffB[i] = (unsigned)(Rb * K + C) * 2u; }
    const size_t kstep = (size_t)(BK * 2);
    const size_t hstep = (size_t)HALF * K * 2;
    const size_t tstep = 2 * hstep;
    const unsigned ldsw = (unsigned)wid * 1024u;
    const int aoff = lds_byte(wr * 64 + fr, fq * 8), boff = lds_byte(wc * 32 + fr, fq * 8);
#define PG8_SA(b, h) (((b) * 2 + (h)) * HTB)
#define PG8_SB(b, h) ((4 + (b) * 2 + (h)) * HTB)
#define PG8_STAGE(bufoff, gbase, voff) do { _Pragma("unroll") for (int _i = 0; _i < 2; ++_i) \
        __builtin_amdgcn_global_load_lds((const unsigned*)((const char*)(gbase) + (voff)[_i]), (PG8_LAS unsigned*)(lds + (bufoff) + ldsw + _i * 8192), 16, 0, 0); } while (0)
#define PG8_LDA(dst, b, h) do { _Pragma("unroll") for (int m = 0; m < 4; ++m) _Pragma("unroll") for (int k = 0; k < 2; ++k) dst[m][k] = *(const PG8_LAS bf16x8*)(lds + PG8_SA(b, h) + aoff + m * 2048 + k * 1024); } while (0)
#define PG8_LDB(dst, b, h) do { _Pragma("unroll") for (int n = 0; n < 2; ++n) _Pragma("unroll") for (int k = 0; k < 2; ++k) dst[n][k] = *(const PG8_LAS bf16x8*)(lds + PG8_SB(b, h) + boff + n * 2048 + k * 1024); } while (0)
#define PG8_MMA(ai, bj, At, Bt) do { __builtin_amdgcn_s_setprio(1); _Pragma("unroll") for (int m = 0; m < 4; ++m) _Pragma("unroll") for (int n = 0; n < 2; ++n) _Pragma("unroll") for (int k = 0; k < 2; ++k) \
        acc[ai][bj][m][n] = __builtin_amdgcn_mfma_f32_16x16x32_bf16(Bt[n][k], At[m][k], acc[ai][bj][m][n], 0, 0, 0); __builtin_amdgcn_s_setprio(0); } while (0)
#define PG8_WAIT_V(n) asm volatile("s_waitcnt vmcnt(" #n ")" ::: "memory")
#define PG8_WAIT_L(n) asm volatile("s_waitcnt lgkmcnt(" #n ")" ::: "memory")
#define PG8_BAR __builtin_amdgcn_s_barrier()
#define PG8_SCHED __builtin_amdgcn_sched_barrier(0)
    Unit cur, nxt; int ui = 0;
    if (!S.next(0, cur)) return;
    f32x4 acc[2][2][4][2];
#pragma unroll
    for (int a = 0; a < 2; ++a)
#pragma unroll
        for (int b = 0; b < 2; ++b)
#pragma unroll
            for (int m = 0; m < 4; ++m)
#pragma unroll
                for (int n = 0; n < 2; ++n) acc[a][b][m][n] = (f32x4){0.f, 0.f, 0.f, 0.f};
    bf16x8 At[4][2], B0[2][2], B1[2][2];
    const char* cA = (const char*)g.A + (size_t)cur.pm * tstep; const char* cB = (const char*)g.Bt + (size_t)cur.pn * tstep;
    S.a_ready(cur);
    if constexpr (SP2) {
        PG8_STAGE(PG8_SB(0, 0), cB, voffB); PG8_STAGE(PG8_SB(0, 1), cB + hstep, voffB); PG8_STAGE(PG8_SA(0, 0), cA, voffA); PG8_STAGE(PG8_SA(0, 1), cA + hstep, voffA);
        if (wr == 1) PG8_BAR;
        PG8_WAIT_V(2); PG8_BAR;
        PG8_STAGE(PG8_SB(1, 0), cB + kstep, voffB); PG8_STAGE(PG8_SA(1, 0), cA + kstep, voffA); PG8_STAGE(PG8_SB(1, 1), cB + hstep + kstep, voffB);
        PG8_WAIT_V(6); PG8_BAR;
    } else {
        PG8_STAGE(PG8_SB(0, 0), cB, voffB); PG8_STAGE(PG8_SA(0, 0), cA, voffA); PG8_STAGE(PG8_SB(0, 1), cB + hstep, voffB); PG8_STAGE(PG8_SA(0, 1), cA + hstep, voffA);
        if (wr == 1) PG8_BAR;
        PG8_WAIT_V(4); PG8_BAR;
        PG8_STAGE(PG8_SB(1, 0), cB + kstep, voffB); PG8_STAGE(PG8_SA(1, 0), cA + kstep, voffA); PG8_STAGE(PG8_SB(1, 1), cB + hstep + kstep, voffB);
        PG8_WAIT_V(6); PG8_BAR;
    }
    for (;;) {
        const bool has_next = S.next(ui + 1, nxt);
        const char* nA = has_next ? (const char*)g.A + (size_t)nxt.pm * tstep : cA; const char* nB = has_next ? (const char*)g.Bt + (size_t)nxt.pn * tstep : cB;
        for (int t = 0; t < nt; t += 2) {
            const bool last = (t == nt - 2);
            const char* a1 = cA + (size_t)(t + 1) * kstep;
            const char* a2 = last ? nA : cA + (size_t)(t + 2) * kstep; const char* b2 = last ? nB : cB + (size_t)(t + 2) * kstep;
            const char* a3 = a2 + kstep; const char* b3 = b2 + kstep;
            if (last && has_next) S.a_ready(nxt);
            if constexpr (SP2) {
            PG8_LDB(B0, 0, 0); PG8_LDB(B1, 0, 1); PG8_SCHED; PG8_LDA(At, 0, 0); PG8_STAGE(PG8_SA(1, 1), a1 + hstep, voffA);
            PG8_WAIT_V(8); PG8_WAIT_L(0); PG8_BAR; PG8_MMA(0, 0, At, B0); PG8_MMA(0, 1, At, B1); PG8_BAR; PG8_SCHED;
            PG8_LDA(At, 0, 1); PG8_STAGE(PG8_SB(0, 0), b2, voffB); PG8_STAGE(PG8_SB(0, 1), b2 + hstep, voffB); PG8_STAGE(PG8_SA(0, 0), a2, voffA);
            PG8_WAIT_V(8); PG8_WAIT_L(0); PG8_BAR; PG8_MMA(1, 0, At, B0); PG8_MMA(1, 1, At, B1); PG8_BAR; PG8_SCHED;
            PG8_LDB(B0, 1, 0); PG8_LDB(B1, 1, 1); PG8_SCHED; PG8_LDA(At, 1, 0); PG8_STAGE(PG8_SA(0, 1), a2 + hstep, voffA);
            PG8_WAIT_V(8); PG8_WAIT_L(0); PG8_BAR; PG8_MMA(0, 0, At, B0); PG8_MMA(0, 1, At, B1); PG8_BAR; PG8_SCHED;
            PG8_LDA(At, 1, 1); PG8_STAGE(PG8_SB(1, 0), b3, voffB); PG8_STAGE(PG8_SB(1, 1), b3 + hstep, voffB); PG8_STAGE(PG8_SA(1, 0), a3, voffA);
            PG8_WAIT_V(8); PG8_WAIT_L(0); PG8_BAR; PG8_MMA(1, 0, At, B0); PG8_MMA(1, 1, At, B1); PG8_BAR; PG8_SCHED;
            } else {
            PG8_LDB(B0, 0, 0); PG8_SCHED; PG8_LDA(At, 0, 0); PG8_STAGE(PG8_SA(1, 1), a1 + hstep, voffA);
            PG8_WAIT_L(8); PG8_BAR; PG8_WAIT_L(0); PG8_MMA(0, 0, At, B0); PG8_BAR; PG8_SCHED;
            PG8_LDB(B1, 0, 1); PG8_STAGE(PG8_SB(0, 0), b2, voffB);
            PG8_BAR; PG8_WAIT_L(0); PG8_MMA(0, 1, At, B1); PG8_BAR;
            PG8_LDA(At, 0, 1); PG8_STAGE(PG8_SA(0, 0), a2, voffA);
            PG8_BAR; PG8_WAIT_L(0); PG8_MMA(1, 0, At, B0); PG8_BAR; PG8_SCHED;
            PG8_STAGE(PG8_SB(0, 1), b2 + hstep, voffB);
            PG8_WAIT_V(6); PG8_BAR; PG8_MMA(1, 1, At, B1); PG8_BAR;
            PG8_LDB(B0, 1, 0); PG8_SCHED; PG8_LDA(At, 1, 0); PG8_STAGE(PG8_SA(0, 1), a2 + hstep, voffA);
            PG8_WAIT_L(8); PG8_BAR; PG8_WAIT_L(0); PG8_MMA(0, 0, At, B0); PG8_BAR; PG8_SCHED;
            PG8_LDB(B1, 1, 1); PG8_STAGE(PG8_SB(1, 0), b3, voffB);
            PG8_BAR; PG8_WAIT_L(0); PG8_MMA(0, 1, At, B1); PG8_BAR;
            PG8_LDA(At, 1, 1); PG8_STAGE(PG8_SA(1, 0), a3, voffA);
            PG8_BAR; PG8_WAIT_L(0); PG8_MMA(1, 0, At, B0); PG8_BAR; PG8_SCHED;
            PG8_STAGE(PG8_SB(1, 1), b3 + hstep, voffB);
            PG8_WAIT_V(6); PG8_BAR; PG8_MMA(1, 1, At, B1); PG8_BAR;
            }
        }
        if constexpr (ALIGN_EPI) { if (wr == 0) PG8_BAR; }
        if constexpr (!Epi::AFTER_DRAIN) { E(acc, cur, wr, wc, fr, fq, !has_next); S.done(cur); }
        if (!has_next) break;
#pragma unroll
        for (int a = 0; a < 2; ++a)
#pragma unroll
            for (int b = 0; b < 2; ++b)
#pragma unroll
                for (int m = 0; m < 4; ++m)
#pragma unroll
                    for (int n = 0; n < 2; ++n) acc[a][b][m][n] = (f32x4){0.f, 0.f, 0.f, 0.f};
        cur = nxt; cA = nA; cB = nB; ++ui;
        if constexpr (ALIGN_EPI) { if (wr == 1) PG8_BAR; }
    }
    PG8_WAIT_V(0);
    if constexpr (!ALIGN_EPI) { if (wr == 0) PG8_BAR; }
    PG8_BAR;
#undef PG8_SA
#undef PG8_SB
#undef PG8_STAGE
#undef PG8_LDA
#undef PG8_LDB
#undef PG8_MMA
#undef PG8_WAIT_V
#undef PG8_WAIT_L
#undef PG8_BAR
#undef PG8_SCHED
}
}

constexpr int DM = 2048, NBATCH = 8, SEQ = 4096, DEPTH = 4, CTXL = 256, GRIDW = 64;
constexpr int MLAT = NBATCH * SEQ, MCTX = NBATCH * CTXL, MALL = MLAT + MCTX;
constexpr int POOLW = 1536, SSMW = 512, NGRP = 32, SGRP = 16, NSTATE = 64, PGRP = 384;
constexpr int DFF = 5632, DFF2 = 11264;
constexpr float EPSN = 1e-6f;
constexpr int NWAVES = 8, NTHREADS = 512;

constexpr size_t MiB = 1u << 20;
constexpr size_t WS_CTL = 0, CTL_BYTES = 1 * MiB;
constexpr size_t WS_MOD = 1 * MiB;
constexpr size_t WS_LAM = 3 * MiB;
constexpr size_t WS_BB = 4 * MiB;
constexpr size_t WS_CM = 6 * MiB;
constexpr size_t WS_WT = 8 * MiB;
constexpr size_t WT_IN = 0, WT_COMB = (size_t)DM * DM, WT_UP = 2 * (size_t)DM * DM, WT_DOWN = WT_UP + (size_t)DFF2 * DM, WT_GLU = WT_DOWN + (size_t)DM * DFF, WT_LAYER = WT_GLU + (size_t)SSMW * SSMW;
constexpr size_t WS_XB = WS_WT + 4 * WT_LAYER * 2;
constexpr size_t WS_BUFA = WS_XB + (size_t)MALL * DM * 2;
constexpr size_t BUF_BYTES = (size_t)MALL * DM * 2;
constexpr size_t WS_BUFB = WS_BUFA + BUF_BYTES, WS_BUFC = WS_BUFB + BUF_BYTES, WS_Z = WS_BUFC + BUF_BYTES;
constexpr int HALF1_ROW0 = 4 * SEQ;
constexpr size_t Z_FULL = (size_t)MALL * DFF2 * 2, Z_HALF = (size_t)(MALL - HALF1_ROW0) * DFF2 * 2;
constexpr size_t A_HALF = (size_t)(MALL - HALF1_ROW0) * DFF * 2;
constexpr size_t WS_NEED_FULL = WS_Z + Z_FULL, WS_NEED_HALF = WS_Z + Z_HALF;
static_assert(A_HALF + (size_t)(MALL - HALF1_ROW0) * DM * 2 <= 2 * BUF_BYTES, "half-mode a + f fit in bufB|bufC");
static_assert((size_t)MALL * DFF * 2 <= 3 * BUF_BYTES, "full-mode a fits in bufA|bufB|bufC");
static_assert(WS_XB % 256 == 0 && WS_BUFA % 256 == 0 && WS_Z % 256 == 0, "alignment");
constexpr int CW_QUEUE = 64;
constexpr int CW_BAR = 4096;

constexpr int SCRATCH_BYTES = 139264;
constexpr int MISC_OFF = SCRATCH_BYTES;
constexpr int LDS_BYTES = 147456;

#define LAS __attribute__((address_space(3)))
typedef unsigned short bf16;
typedef short bf16x8 __attribute__((ext_vector_type(8)));
typedef float f32x4 __attribute__((ext_vector_type(4)));
typedef float f32x16 __attribute__((ext_vector_type(16)));
typedef unsigned u32x4 __attribute__((ext_vector_type(4)));
typedef unsigned u32x2 __attribute__((ext_vector_type(2)));

__device__ __forceinline__ float bf2f(unsigned short b) { return __uint_as_float(((unsigned)b) << 16); }
__device__ __forceinline__ float bflo(unsigned w) { return __uint_as_float(w << 16); }
__device__ __forceinline__ float bfhi(unsigned w) { return __uint_as_float(w & 0xffff0000u); }
__device__ __forceinline__ unsigned pk2(float lo, float hi) { return pg8::cvt_pk_bf16(lo, hi); }
__device__ __forceinline__ float wave_sum(float v) {
#pragma unroll
    for (int o = 1; o < 64; o <<= 1) v += __shfl_xor(v, o);
    return v;
}
__device__ __forceinline__ void st16_wt(void* p, u32x4 v) { asm volatile("global_store_dwordx4 %0, %1, off sc1\n\ts_nop 1" :: "v"(p), "v"(v) : "memory"); }
__device__ __forceinline__ void st8_wt(void* p, u32x2 v) { asm volatile("global_store_dwordx2 %0, %1, off sc1\n\ts_nop 1" :: "v"(p), "v"(v) : "memory"); }
__device__ __forceinline__ float sigmoidf_(float t) { return __builtin_amdgcn_rcpf(1.0f + __builtin_amdgcn_exp2f(-1.4426950408889634f * t)); }

#define XB_TMO      128
#define XB_XCNT(j)  (256  + 64 * (j))
#define XB_XSUB(j)  (1280 + 64 * (j))
#define XB_XGEN(j)  (2304 + 64 * (j))
#define XB_TOP      3328
#define XB_TOPGEN   3392
#define XCD_BAR_WORDS 3456
#define XB_SPIN_CAP (1u << 20)

__device__ __forceinline__ unsigned xb_ld(unsigned* p)              { return __hip_atomic_load(p, __ATOMIC_RELAXED, __HIP_MEMORY_SCOPE_AGENT); }
__device__ __forceinline__ unsigned xb_add(unsigned* p, unsigned v) { return __hip_atomic_fetch_add(p, v, __ATOMIC_RELAXED, __HIP_MEMORY_SCOPE_AGENT); }
__device__ __forceinline__ unsigned xb_xcc_id() { return (unsigned)__builtin_amdgcn_s_getreg((3 << 11) | 20) & 0xFu; }
#define XB_SPIN(cond, bar) do { unsigned _sp = 0; while (cond) { __builtin_amdgcn_s_sleep(1); \
    if ((++_sp & 255u) == 0u) { if (xb_ld(&(bar)[XB_TMO])) break; if (_sp > XB_SPIN_CAP) { atomicAdd(&(bar)[XB_TMO], 1u); break; } } } } while (0)

struct XcdBarrier { unsigned* bar; unsigned x; volatile LAS unsigned* st; };

__device__ __forceinline__ XcdBarrier xcd_barrier_post(unsigned* bar, volatile LAS unsigned* st) {
    XcdBarrier b; b.bar = bar; b.x = xb_xcc_id(); b.st = st;
    if (threadIdx.x == 0) (void)xb_add(&bar[XB_XCNT(b.x)], 1u);
    return b;
}
__device__ __forceinline__ void xcd_barrier_complete(unsigned* bar, unsigned x, unsigned& nloc, unsigned& nx) {
    const unsigned G = gridDim.x * gridDim.y * gridDim.z;
    unsigned sum, cnt, mine, sp = 0u;
    for (;;) {
        sum = 0u; cnt = 0u; mine = 0u;
#pragma unroll
        for (unsigned j = 0; j < 16; ++j) { const unsigned c = xb_ld(&bar[XB_XCNT(j)]); sum += c; cnt += (c > 0u) ? 1u : 0u; mine = (j == x) ? c : mine; }
        if (sum == G) break;
        __builtin_amdgcn_s_sleep(1);
        if ((++sp & 255u) == 0u) { if (xb_ld(&bar[XB_TMO])) break; if (sp > XB_SPIN_CAP) { atomicAdd(&bar[XB_TMO], 1u); break; } }
    }
    nloc = mine > 0u ? mine : 1u; nx = cnt > 0u ? cnt : 1u;
}
__device__ __forceinline__ void xcd_barrier(const XcdBarrier& b) {
    asm volatile("s_waitcnt vmcnt(0)" ::: "memory");
    __syncthreads();
    if (threadIdx.x == 0) {
        unsigned* bar = b.bar;
        __builtin_amdgcn_s_waitcnt(0);
        unsigned nloc = b.st[0], nx = b.st[1];
        if (nloc == 0u) { xcd_barrier_complete(bar, b.x, nloc, nx); b.st[0] = nloc; b.st[1] = nx; }
        const unsigned old = xb_add(&bar[XB_XSUB(b.x)], 1u);
        const unsigned gen = old / nloc;
        asm volatile("buffer_inv sc1" ::: "memory");
        if (old + 1u == (gen + 1u) * nloc) {
            __builtin_amdgcn_fence(__ATOMIC_RELEASE, "agent");
            asm volatile("s_waitcnt vmcnt(0)" ::: "memory");
            const unsigned og = xb_add(&bar[XB_TOP], 1u);
            const unsigned tg = og / nx;
            if (og + 1u == (tg + 1u) * nx) xb_add(&bar[XB_TOPGEN], 1u);
            else XB_SPIN(xb_ld(&bar[XB_TOPGEN]) == tg, bar);
            xb_add(&bar[XB_XGEN(b.x)], 1u);
            asm volatile("s_waitcnt vmcnt(0)" ::: "memory");
        } else {
            XB_SPIN(xb_ld(&bar[XB_XGEN(b.x)]) == gen, bar);
            asm volatile("s_waitcnt vmcnt(0)" ::: "memory");
        }
    }
    __syncthreads();
}

struct Args {
    const float* in[26];
    float* out;
    unsigned char* ws;
    int seg_lo, seg_hi;
    int nhalf, dup;
};
typedef const Args __attribute__((address_space(4)))* ArgsP;
__device__ __forceinline__ ArgsP launder(ArgsP p) { asm volatile("" : "+s"(p)); return p; }
enum { IN_X = 0, IN_C, IN_CTX, IN_CCTX, IN_WADA, IN_BADA, IN_WIN, IN_WPOOL, IN_PSCALE, IN_ARE, IN_AIM, IN_LOGDT, IN_BRE, IN_BIM, IN_CRE, IN_CIM, IN_SSMD, IN_WGLU, IN_WOUT,
       IN_GPREMIX, IN_GPOSTMIX, IN_GPREFFN, IN_GPOSTFFN, IN_WUP, IN_WCONV, IN_WDOWN };

__device__ __forceinline__ void p0_mod_item(ArgsP a, LAS unsigned char* lds, int item, int tid) {
    const int l = item / 48, n0 = (item % 48) * 256;
    LAS float* sS = (LAS float*)lds;
    const float* c = a->in[IN_C]; const float* cc = a->in[IN_CCTX];
    for (int idx = tid; idx < 9 * DM; idx += NTHREADS) { const int j = idx >> 11, k = idx & (DM - 1); const float v = (j < 8) ? c[j * DM + k] : cc[k]; sS[idx] = v * sigmoidf_(v); }
    __syncthreads();
    const int q = tid & 63, ks = tid >> 6;
    f32x4 acc[9];
#pragma unroll
    for (int j = 0; j < 9; ++j) acc[j] = (f32x4){0.f, 0.f, 0.f, 0.f};
    const float* wp = a->in[IN_WADA] + ((size_t)l * DM + (size_t)ks * 256) * (6 * DM) + n0 + 4 * q;
#pragma unroll 2
    for (int kk = 0; kk < 256; kk += 4) {
        const f32x4 w0 = *(const f32x4*)(wp + (size_t)(kk + 0) * (6 * DM)), w1 = *(const f32x4*)(wp + (size_t)(kk + 1) * (6 * DM));
        const f32x4 w2 = *(const f32x4*)(wp + (size_t)(kk + 2) * (6 * DM)), w3 = *(const f32x4*)(wp + (size_t)(kk + 3) * (6 * DM));
#pragma unroll
        for (int j = 0; j < 9; ++j) { const f32x4 sv = *(const LAS f32x4*)(sS + j * DM + ks * 256 + kk);
            acc[j] += sv.x * w0 + sv.y * w1 + sv.z * w2 + sv.w * w3; }
    }
    __syncthreads();
    LAS float* red = (LAS float*)lds;
#pragma unroll
    for (int j = 0; j < 9; ++j) *(LAS f32x4*)(red + (ks * 9 + j) * 256 + 4 * q) = acc[j];
    __syncthreads();
    float* MOD = (float*)(a->ws + WS_MOD);
    const float* bada = a->in[IN_BADA];
    for (int o = tid; o < 9 * 256; o += NTHREADS) { const int j = o >> 8, col = o & 255; float s = bada[l * 6 * DM + n0 + col];
#pragma unroll
        for (int k2 = 0; k2 < 8; ++k2) s += red[(k2 * 9 + j) * 256 + col];
        MOD[((size_t)l * 9 + j) * (6 * DM) + n0 + col] = s; }
    __syncthreads();
}
__device__ __forceinline__ void p0_s5_item(ArgsP a, int e, int tid) {
    if (tid >= 64) return;
    const int p = tid, ldg = e;
    const int gp = ldg * 64 + p;
    const float a_re = a->in[IN_ARE][gp], a_im = a->in[IN_AIM][gp], dt = expf(a->in[IN_LOGDT][ldg]);
    const float mag = expf(a_re * dt), lam_re = mag * cosf(a_im * dt), lam_im = mag * sinf(a_im * dt);
    const float denom = a_re * a_re + a_im * a_im, nr = lam_re - 1.0f, ni = lam_im;
    const float f_re = (nr * a_re + ni * a_im) / denom, f_im = (ni * a_re - nr * a_im) / denom;
    float* LAM = (float*)(a->ws + WS_LAM); bf16* BB = (bf16*)(a->ws + WS_BB); bf16* CM = (bf16*)(a->ws + WS_CM);
    LAM[gp * 2 + 0] = lam_re; LAM[gp * 2 + 1] = lam_im;
    const float* bre = a->in[IN_BRE] + (size_t)gp * 16; const float* bim = a->in[IN_BIM] + (size_t)gp * 16;
#pragma unroll
    for (int h = 0; h < 16; h += 2) {
        const float r0 = f_re * bre[h] - f_im * bim[h], i0 = f_re * bim[h] + f_im * bre[h];
        const float r1 = f_re * bre[h + 1] - f_im * bim[h + 1], i1 = f_re * bim[h + 1] + f_im * bre[h + 1];
        *(unsigned*)(BB + ((size_t)ldg * 128 + p) * 16 + h) = pk2(r0, r1);
        *(unsigned*)(BB + ((size_t)ldg * 128 + 64 + p) * 16 + h) = pk2(i0, i1);
    }
    const float* cre = a->in[IN_CRE] + (size_t)ldg * 16 * 64; const float* cim = a->in[IN_CIM] + (size_t)ldg * 16 * 64;
#pragma unroll
    for (int h = 0; h < 16; ++h) *(unsigned*)(CM + ((size_t)ldg * 16 + h) * 128 + 2 * p) = pk2(cre[h * 64 + p], -cim[h * 64 + p]);
}
__device__ __forceinline__ void p0_fold_tile(ArgsP a, int l, int wt, int lane) {
    const int nb = wt / 48, cbk = wt % 48, g = cbk / 12, c0 = (cbk % 12) * 32, n0 = nb * 32;
    const float* wout = a->in[IN_WOUT] + (size_t)l * DM * DM + (size_t)(g * PGRP) * DM + n0 + (lane & 31);
    const float* wpool = a->in[IN_WPOOL] + ((size_t)(l * 4 + g) * PGRP + c0 + (lane & 31)) * PGRP;
    const float* ps = a->in[IN_PSCALE] + l * POOLW + g * PGRP;
    f32x16 acc;
#pragma unroll
    for (int r = 0; r < 16; ++r) acc[r] = 0.f;
    const int h8 = 8 * (lane >> 5);
    for (int d0 = 0; d0 < PGRP; d0 += 16) {
        float av[8];
#pragma unroll
        for (int j = 0; j < 8; ++j) av[j] = wout[(size_t)(d0 + h8 + j) * DM] * ps[d0 + h8 + j];
        const f32x4 b0 = *(const f32x4*)(wpool + d0 + h8), b1 = *(const f32x4*)(wpool + d0 + h8 + 4);
        u32x4 aw, bw;
        aw.x = pk2(av[0], av[1]); aw.y = pk2(av[2], av[3]); aw.z = pk2(av[4], av[5]); aw.w = pk2(av[6], av[7]);
        bw.x = pk2(b0.x, b0.y); bw.y = pk2(b0.z, b0.w); bw.z = pk2(b1.x, b1.y); bw.w = pk2(b1.z, b1.w);
        acc = __builtin_amdgcn_mfma_f32_32x32x16_bf16(__builtin_bit_cast(bf16x8, aw), __builtin_bit_cast(bf16x8, bw), acc, 0, 0, 0);
    }
    asm volatile("s_nop 15\n\ts_nop 15\n\ts_nop 15\n\ts_nop 15" : "+v"(acc));
    bf16* WT = (bf16*)(a->ws + WS_WT) + (size_t)l * WT_LAYER + WT_COMB;
#pragma unroll
    for (int r = 0; r < 16; ++r) { const int n = n0 + (r & 3) + 8 * (r >> 2) + 4 * (lane >> 5);
        WT[(size_t)n * DM + g * PGRP + c0 + (lane & 31)] = (bf16)(pk2(acc[r], 0.f) & 0xffffu); }
}
__device__ __forceinline__ void p0_transpose_tile(const float* W, int N, bf16* WT, int ldt, int kdst, LAS float* scr, int kb, int nb, int lane) {
    const int k0 = 64 * kb, n0 = 32 * nb;
#pragma unroll 8
    for (int i = 0; i < 32; ++i) { const int kk = 2 * i + (lane >> 5); scr[kk * 33 + (lane & 31)] = W[(size_t)(k0 + kk) * N + n0 + (lane & 31)]; }
    asm volatile("s_waitcnt lgkmcnt(0)" ::: "memory");
    const int c = lane & 7;
#pragma unroll
    for (int j = 0; j < 4; ++j) { const int n = (lane >> 3) + 8 * j; const LAS float* s = scr + (8 * c) * 33 + n;
        u32x4 o; o.x = pk2(s[0 * 33], s[1 * 33]); o.y = pk2(s[2 * 33], s[3 * 33]); o.z = pk2(s[4 * 33], s[5 * 33]); o.w = pk2(s[6 * 33], s[7 * 33]);
        *(u32x4*)(WT + (size_t)(n0 + n) * ldt + kdst + k0 + 8 * c) = o; }
    asm volatile("s_waitcnt lgkmcnt(0)" ::: "memory");
}
constexpr int Q_MOD = 192, Q_S5 = 256, Q_FOLD = 4 * 384;
constexpr int TI_IN = 32 * 8, TI_OUTS = 8 * 8, TI_UP = 32 * 44, TI_DOWN = 88 * 8, TI_GLU = 8 * 2, TI_LAYER = TI_IN + TI_OUTS + TI_UP + TI_DOWN + TI_GLU;
constexpr int Q_TOTAL = Q_MOD + Q_S5 + Q_FOLD + 4 * TI_LAYER;
__device__ __forceinline__ void p0_transpose_item(ArgsP a, LAS unsigned char* lds, int it, int wave, int lane) {
    const int l = it / TI_LAYER; int r = it % TI_LAYER;
    LAS float* scr = (LAS float*)(lds + wave * 16384);
    bf16* WTL = (bf16*)(a->ws + WS_WT) + (size_t)l * WT_LAYER;
    if (r < TI_IN) { p0_transpose_tile(a->in[IN_WIN] + (size_t)l * DM * DM, DM, WTL + WT_IN, DM, 0, scr, r / 8, (r % 8) * 8 + wave, lane); return; } r -= TI_IN;
    if (r < TI_OUTS) { p0_transpose_tile(a->in[IN_WOUT] + (size_t)l * DM * DM + (size_t)POOLW * DM, DM, WTL + WT_COMB, DM, POOLW, scr, r / 8, (r % 8) * 8 + wave, lane); return; } r -= TI_OUTS;
    if (r < TI_UP) { p0_transpose_tile(a->in[IN_WUP] + (size_t)l * DM * DFF2, DFF2, WTL + WT_UP, DM, 0, scr, r / 44, (r % 44) * 8 + wave, lane); return; } r -= TI_UP;
    if (r < TI_DOWN) { p0_transpose_tile(a->in[IN_WDOWN] + (size_t)l * DFF * DM, DM, WTL + WT_DOWN, DFF, 0, scr, r / 8, (r % 8) * 8 + wave, lane); return; } r -= TI_DOWN;
    p0_transpose_tile(a->in[IN_WGLU] + (size_t)l * SSMW * SSMW, SSMW, WTL + WT_GLU, SSMW, 0, scr, r / 2, (r % 2) * 8 + wave, lane);
}
__device__ __forceinline__ void phase_prologue(ArgsP a, LAS unsigned char* lds, int tid, int wave, int lane) {
    unsigned* qhead = (unsigned*)(a->ws + WS_CTL) + CW_QUEUE;
    volatile LAS unsigned* slot = (volatile LAS unsigned*)(lds + MISC_OFF + 64);
    for (;;) {
        if (tid == 0) slot[0] = __hip_atomic_fetch_add(qhead, 1u, __ATOMIC_RELAXED, __HIP_MEMORY_SCOPE_AGENT);
        __syncthreads();
        const int it = (int)slot[0];
        __syncthreads();
        if (it >= Q_TOTAL) break;
        if (it < Q_MOD) { p0_mod_item(a, lds, it, tid); continue; }
        if (it < Q_MOD + Q_S5) { p0_s5_item(a, it - Q_MOD, tid); continue; }
        if (it < Q_MOD + Q_S5 + Q_FOLD) { const int f = it - Q_MOD - Q_S5; p0_fold_tile(a, f / 384, (f % 384) * 8 + wave, lane); continue; }
        p0_transpose_item(a, lds, it - Q_MOD - Q_S5 - Q_FOLD, wave, lane);
    }
}

struct NormP {
    const bf16* y; int y_row0;
    const float* xin_lat; const float* xin_ctx;
    bf16* xb;
    float* out_f32;
    bf16* h;
    const float* gate; const float* g_post;
    const float* g_pre; const float* shift; const float* scale;
};
__device__ __forceinline__ void phase_norm(const NormP& P, int r0, int r1, int gw, int ngw, int lane) {
    const int nrows = r1 - r0, per = (nrows + ngw - 1) / ngw;
    int m = r0 + gw * per; const int mend = (m + per < r1) ? m + per : r1;
    int curj = -1;
    f32x4 A1[8], A2[8], SH[8];
#pragma unroll
    for (int i = 0; i < 8; ++i) { A1[i] = (f32x4){0.f, 0.f, 0.f, 0.f}; A2[i] = A1[i]; SH[i] = A1[i]; }
    for (; m < mend; ++m) {
        const int j = (m < MLAT) ? (m >> 12) : 8;
        if (j != curj) { curj = j;
#pragma unroll
            for (int jj = 0; jj < 4; ++jj)
#pragma unroll
                for (int hh = 0; hh < 2; ++hh) { const int e = 512 * jj + 8 * lane + 4 * hh;
                    if (P.y) A1[jj * 2 + hh] = *(const f32x4*)(P.gate + (size_t)j * 6 * DM + e) * *(const f32x4*)(P.g_post + e);
                    if (P.h) { A2[jj * 2 + hh] = *(const f32x4*)(P.g_pre + e) * (*(const f32x4*)(P.scale + (size_t)j * 6 * DM + e) + 1.0f); SH[jj * 2 + hh] = *(const f32x4*)(P.shift + (size_t)j * 6 * DM + e); } }
        }
        f32x4 xv[8];
        if (P.xin_lat) {
            const float* xs = (m < MLAT) ? P.xin_lat + (size_t)m * DM : P.xin_ctx + (size_t)(m - MLAT) * DM;
#pragma unroll
            for (int jj = 0; jj < 4; ++jj) { xv[2 * jj] = *(const f32x4*)(xs + 512 * jj + 8 * lane); xv[2 * jj + 1] = *(const f32x4*)(xs + 512 * jj + 8 * lane + 4); }
        } else {
            const bf16* xs = P.xb + (size_t)m * DM;
#pragma unroll
            for (int jj = 0; jj < 4; ++jj) { const u32x4 w = __builtin_nontemporal_load((const u32x4*)(xs + 512 * jj + 8 * lane));
                xv[2 * jj] = (f32x4){bflo(w.x), bfhi(w.x), bflo(w.y), bfhi(w.y)}; xv[2 * jj + 1] = (f32x4){bflo(w.z), bfhi(w.z), bflo(w.w), bfhi(w.w)}; }
        }
        if (P.y) {
            const bf16* yr = P.y + (size_t)(m - P.y_row0) * DM;
            f32x4 yv[8]; float ss = 0.f;
#pragma unroll
            for (int jj = 0; jj < 4; ++jj) { const u32x4 w = __builtin_nontemporal_load((const u32x4*)(yr + 512 * jj + 8 * lane));
                yv[2 * jj] = (f32x4){bflo(w.x), bfhi(w.x), bflo(w.y), bfhi(w.y)}; yv[2 * jj + 1] = (f32x4){bflo(w.z), bfhi(w.z), bflo(w.w), bfhi(w.w)}; }
#pragma unroll
            for (int i = 0; i < 8; ++i) ss += (yv[i].x * yv[i].x + yv[i].y * yv[i].y) + (yv[i].z * yv[i].z + yv[i].w * yv[i].w);
            const float rstd = 1.0f / sqrtf(wave_sum(ss) * (1.0f / DM) + EPSN);
#pragma unroll
            for (int i = 0; i < 8; ++i) xv[i] += A1[i] * (yv[i] * rstd);
        }
        if (P.out_f32) {
            float* xd = P.out_f32 + (size_t)m * DM;
#pragma unroll
            for (int jj = 0; jj < 4; ++jj) { *(f32x4*)(xd + 512 * jj + 8 * lane) = xv[2 * jj]; *(f32x4*)(xd + 512 * jj + 8 * lane + 4) = xv[2 * jj + 1]; }
        } else {
            bf16* xd = P.xb + (size_t)m * DM;
#pragma unroll
            for (int jj = 0; jj < 4; ++jj) { u32x4 w; w.x = pk2(xv[2 * jj].x, xv[2 * jj].y); w.y = pk2(xv[2 * jj].z, xv[2 * jj].w); w.z = pk2(xv[2 * jj + 1].x, xv[2 * jj + 1].y); w.w = pk2(xv[2 * jj + 1].z, xv[2 * jj + 1].w);
                st16_wt(xd + 512 * jj + 8 * lane, w); }
        }
        if (P.h) {
            float ss = 0.f;
#pragma unroll
            for (int i = 0; i < 8; ++i) ss += (xv[i].x * xv[i].x + xv[i].y * xv[i].y) + (xv[i].z * xv[i].z + xv[i].w * xv[i].w);
            const float rstd = 1.0f / sqrtf(wave_sum(ss) * (1.0f / DM) + EPSN);
            bf16* hr = P.h + (size_t)m * DM;
#pragma unroll
            for (int jj = 0; jj < 4; ++jj) { const f32x4 o0 = xv[2 * jj] * rstd * A2[2 * jj] + SH[2 * jj], o1 = xv[2 * jj + 1] * rstd * A2[2 * jj + 1] + SH[2 * jj + 1];
                u32x4 w; w.x = pk2(o0.x, o0.y); w.y = pk2(o0.z, o0.w); w.z = pk2(o1.x, o1.y); w.w = pk2(o1.z, o1.w);
                st16_wt(hr + 512 * jj + 8 * lane, w); }
        }
    }
}

#define POOL_ACC(sgn, VV) do { const u32x4 q_ = (VV); s[0] sgn bflo(q_.x); s[1] sgn bfhi(q_.x); s[2] sgn bflo(q_.y); s[3] sgn bfhi(q_.y); s[4] sgn bflo(q_.z); s[5] sgn bfhi(q_.z); s[6] sgn bflo(q_.w); s[7] sgn bfhi(q_.w); } while (0)
template <int H> __device__ __forceinline__ void pool_batch(const bf16* u, bf16* PA, int m0, int ch0) {
    constexpr int NR = 7 + 2 * H;
    int base, t0, n;
    if (m0 < MLAT) { base = m0 & ~(SEQ - 1); t0 = m0 & (SEQ - 1); n = SEQ; } else { const int mm = m0 - MLAT; base = MLAT + (mm & ~(CTXL - 1)); t0 = mm & (CTXL - 1); n = CTXL; }
    u32x4 v[NR];
#pragma unroll
    for (int k = 0; k < NR; ++k) { const int tt = t0 - H + k; v[k] = (u32x4){0u, 0u, 0u, 0u}; if (tt >= 0 && tt < n) v[k] = *(const u32x4*)(u + (size_t)(base + tt) * DM + ch0); }
    float s[8];
#pragma unroll
    for (int e = 0; e < 8; ++e) s[e] = 0.f;
#pragma unroll
    for (int k = 0; k < 2 * H; ++k) POOL_ACC(+=, v[k]);
#pragma unroll
    for (int i = 0; i < 8; ++i) {
        if (i > 0) { POOL_ACC(+=, v[i + 2 * H - 1]); POOL_ACC(-=, v[i - 1]); }
        const int t = t0 + i, lo = (t - H > 0) ? t - H : 0, hi = (t + H < n) ? t + H : n;
        const float inv = 1.0f / (float)(hi - lo);
        const u32x4 c = v[H + i];
        u32x4 o; o.x = pk2(s[0] * inv - bflo(c.x), s[1] * inv - bfhi(c.x)); o.y = pk2(s[2] * inv - bflo(c.y), s[3] * inv - bfhi(c.y));
        o.z = pk2(s[4] * inv - bflo(c.z), s[5] * inv - bfhi(c.z)); o.w = pk2(s[6] * inv - bflo(c.w), s[7] * inv - bfhi(c.w));
        st16_wt(PA + (size_t)(m0 + i) * DM + ch0, o);
    }
}
__device__ __forceinline__ void pool_rows(const bf16* u, bf16* PA, int row0, int nbatch, int pw  , int lane) {
    if (lane >= 48) return;
    for (int it = pw; it < nbatch * 4; it += 4) {
        const int batch = it >> 2, grp = (it + batch) & 3, m0 = row0 + 8 * batch, ch0 = grp * PGRP + 8 * lane;
        if (grp == 0) pool_batch<1>(u, PA, m0, ch0); else if (grp == 1) pool_batch<2>(u, PA, m0, ch0); else if (grp == 2) pool_batch<4>(u, PA, m0, ch0); else pool_batch<8>(u, PA, m0, ch0);
    }
}
__device__ __forceinline__ int chain_row(int q, int dir, int b) {
    if (q < CTXL) { const int tt = dir ? (CTXL - 1 - q) : q; return MLAT + b * CTXL + tt; }
    const int qq = q - CTXL; const int tt = dir ? (SEQ - 1 - qq) : qq; return b * SEQ + tt;
}
constexpr int STASH_KCB = 528, STASH_BUFB = 16 * STASH_KCB;
__device__ __forceinline__ void ssm_chain(LAS unsigned char* stash, const bf16* u, bf16* Y, const float* LAM, const bf16* BB, const bf16* CM, int l, int b, int g, int dir, int lane) {
    const int ldg = (l * 2 + dir) * NGRP + g;
    const float lr = LAM[(ldg * 64 + lane) * 2], li = LAM[(ldg * 64 + lane) * 2 + 1];
    bf16x8 Bf[4], Cf[4];
#pragma unroll
    for (int cb = 0; cb < 4; ++cb) Bf[cb] = *(const bf16x8*)(BB + ((size_t)ldg * 128 + cb * 32 + (lane & 31)) * 16 + 8 * (lane >> 5));
#pragma unroll
    for (int ks = 0; ks < 4; ++ks) Cf[ks] = *(const bf16x8*)(CM + ((size_t)ldg * 16 + (lane & 15)) * 128 + 32 * ks + 8 * (lane >> 4));
    float hr = 0.f, hi = 0.f;
    const int ucol = POOLW + SGRP * g + 8 * (lane >> 5);
    const int sgn = dir ? -1 : 1;
    const int uoff = sgn * (lane & 31) * DM + ucol;
    const int yo0 = sgn * (lane & 15) * SSMW + SGRP * g + 4 * (lane >> 4), yo1 = yo0 + sgn * 16 * SSMW;
    const unsigned wad = (unsigned)(size_t)(stash + (lane >> 2) * STASH_KCB + (lane & 3) * 4);
    bf16x8 cur[8], nxt[8];
#pragma unroll
    for (int c = 0; c < 8; ++c) cur[c] = *(const bf16x8*)(u + (ptrdiff_t)chain_row(32 * c, dir, b) * DM + uoff);
    for (int sc = 0; sc < 17; ++sc) {
        if (sc + 1 < 17) {
#pragma unroll
            for (int c = 0; c < 8; ++c) nxt[c] = *(const bf16x8*)(u + (ptrdiff_t)chain_row(256 * (sc + 1) + 32 * c, dir, b) * DM + uoff);
        }
#pragma unroll
        for (int c = 0; c < 8; ++c) {
            const int q0 = 256 * sc + 32 * c;
            const LAS unsigned char* stp = stash + ((c & 1) ^ 1) * STASH_BUFB;
            bf16x8 a0[4], a1[4];
#pragma unroll
            for (int ks = 0; ks < 4; ++ks) {
                a0[ks] = *(const LAS bf16x8*)(stp + (4 * ks + (lane >> 4)) * STASH_KCB + (lane & 15) * 16);
                a1[ks] = *(const LAS bf16x8*)(stp + (4 * ks + (lane >> 4)) * STASH_KCB + (16 + (lane & 15)) * 16);
            }
            f32x16 z16;
#pragma unroll
            for (int r = 0; r < 16; ++r) z16[r] = 0.f;
            f32x16 D0 = __builtin_amdgcn_mfma_f32_32x32x16_bf16(cur[c], Bf[0], z16, 0, 0, 0);
            f32x16 D1 = __builtin_amdgcn_mfma_f32_32x32x16_bf16(cur[c], Bf[1], z16, 0, 0, 0);
            f32x16 D2 = __builtin_amdgcn_mfma_f32_32x32x16_bf16(cur[c], Bf[2], z16, 0, 0, 0);
            f32x16 D3 = __builtin_amdgcn_mfma_f32_32x32x16_bf16(cur[c], Bf[3], z16, 0, 0, 0);
            f32x4 acc0 = (f32x4){0.f, 0.f, 0.f, 0.f}, acc1 = acc0;
            asm volatile("" : "+v"(D0), "+v"(D1), "+v"(D2), "+v"(D3), "+v"(acc0), "+v"(acc1) :: "memory");
#pragma unroll
            for (int ks = 0; ks < 4; ++ks) {
                acc0 = __builtin_amdgcn_mfma_f32_16x16x32_bf16(Cf[ks], a0[ks], acc0, 0, 0, 0);
                acc1 = __builtin_amdgcn_mfma_f32_16x16x32_bf16(Cf[ks], a1[ks], acc1, 0, 0, 0);
            }
            asm volatile("s_waitcnt lgkmcnt(0)\n\ts_nop 15\n\ts_nop 15" : "+v"(acc0), "+v"(acc1) :: "memory");
            if (q0 > 0) {
                bf16* yb = Y + (ptrdiff_t)chain_row(q0 - 32, dir, b) * SSMW;
                u32x2 w0, w1; w0.x = pk2(acc0[0], acc0[1]); w0.y = pk2(acc0[2], acc0[3]); w1.x = pk2(acc1[0], acc1[1]); w1.y = pk2(acc1[2], acc1[3]);
                *(u32x2*)(yb + yo0) = w0;
                *(u32x2*)(yb + yo1) = w1;
            }
            asm volatile("s_nop 3" : "+v"(D0), "+v"(D1), "+v"(D2), "+v"(D3));
            float bre[32], bim[32];
#pragma unroll
            for (int r = 0; r < 16; ++r) { const int p0 = (r & 3) + 8 * (r >> 2);
                auto rr = __builtin_amdgcn_permlane32_swap(__float_as_uint(D0[r]), __float_as_uint(D1[r]), false, false);
                bre[p0] = __uint_as_float(rr[0]); bre[p0 + 4] = __uint_as_float(rr[1]);
                auto ri = __builtin_amdgcn_permlane32_swap(__float_as_uint(D2[r]), __float_as_uint(D3[r]), false, false);
                bim[p0] = __uint_as_float(ri[0]); bim[p0 + 4] = __uint_as_float(ri[1]); }
#pragma unroll
            for (int pos = 0; pos < 32; pos += 2) {
                const float nr = fmaf(-li, hi, fmaf(lr, hr, bre[pos]));
                const float ni = fmaf(li, hr, fmaf(lr, hi, bim[pos]));
                const unsigned p0 = pk2(nr, ni);
                hr = fmaf(-li, ni, fmaf(lr, nr, bre[pos + 1]));
                hi = fmaf(li, nr, fmaf(lr, ni, bim[pos + 1]));
                const unsigned p1 = pk2(hr, hi);
                asm volatile("ds_write2_b32 %0, %1, %2 offset0:%3 offset1:%4" :: "v"(wad + (unsigned)((c & 1) * STASH_BUFB)), "v"(p0), "v"(p1), "n"(4 * pos), "n"(4 * pos + 4) : "memory");
            }
        }
#pragma unroll
        for (int c = 0; c < 8; ++c) cur[c] = nxt[c];
    }
    {
        const LAS unsigned char* stp = stash + 1 * STASH_BUFB;
        asm volatile("s_waitcnt lgkmcnt(0)" ::: "memory");
        f32x4 acc0 = (f32x4){0.f, 0.f, 0.f, 0.f}, acc1 = acc0;
#pragma unroll
        for (int ks = 0; ks < 4; ++ks) {
            const bf16x8 a0 = *(const LAS bf16x8*)(stp + (4 * ks + (lane >> 4)) * STASH_KCB + (lane & 15) * 16);
            const bf16x8 a1 = *(const LAS bf16x8*)(stp + (4 * ks + (lane >> 4)) * STASH_KCB + (16 + (lane & 15)) * 16);
            acc0 = __builtin_amdgcn_mfma_f32_16x16x32_bf16(Cf[ks], a0, acc0, 0, 0, 0);
            acc1 = __builtin_amdgcn_mfma_f32_16x16x32_bf16(Cf[ks], a1, acc1, 0, 0, 0);
        }
        asm volatile("s_waitcnt lgkmcnt(0)\n\ts_nop 15\n\ts_nop 15" : "+v"(acc0), "+v"(acc1) :: "memory");
        bf16* yb = Y + (ptrdiff_t)chain_row(256 * 16 + 32 * 7, dir, b) * SSMW;
        u32x2 w0, w1; w0.x = pk2(acc0[0], acc0[1]); w0.y = pk2(acc0[2], acc0[3]); w1.x = pk2(acc1[0], acc1[1]); w1.y = pk2(acc1[2], acc1[3]);
        *(u32x2*)(yb + yo0) = w0;
        *(u32x2*)(yb + yo1) = w1;
    }
}
__device__ __forceinline__ void phase_mix_a(ArgsP a, LAS unsigned char* lds, int l, int mrows, int wave, int lane, int tid) {
    const bf16* u = (const bf16*)(a->ws + WS_BUFB);
    if (wave < 2) {
        const int bx = blockIdx.x, xcd = bx & 7, jj = bx >> 3;
        for (int it = jj; it < 32; it += (int)(gridDim.x >> 3)) {
            const int g = 4 * xcd + (it & 3), b = it >> 2;
            bf16* Y = (bf16*)(a->ws + WS_BUFA) + (size_t)wave * MALL * SSMW;
            ssm_chain(lds + wave * 32768, u, Y, (const float*)(a->ws + WS_LAM), (const bf16*)(a->ws + WS_BB), (const bf16*)(a->ws + WS_CM), l, b, g, wave, lane);
        }
    } else if (wave != 4 && wave != 5) {
        const int per = mrows / 256;
        for (int wgi = blockIdx.x; wgi < 256; wgi += gridDim.x) pool_rows(u, (bf16*)(a->ws + WS_BUFC), wgi * per, per / 8, (wave < 4) ? wave - 2 : wave - 4, lane);
    }
}

__device__ __forceinline__ float gelu_tanh(float x) { const float z = 0.7978845608028654f * (x + 0.044715f * x * x * x); return x * sigmoidf_(2.0f * z); }
__device__ __forceinline__ int glu_lds_off(int row, int chunk) { return row * 1024 + ((chunk ^ (row & 15)) << 4); }
__device__ __forceinline__ void phase_mix_b(ArgsP a, LAS unsigned char* lds, int l, int mrows, int tid, int wave, int lane) {
    const bf16* Y0 = (const bf16*)(a->ws + WS_BUFA); const bf16* Y1 = Y0 + (size_t)MALL * SSMW;
    const bf16* u = (const bf16*)(a->ws + WS_BUFB);
    const float* Dv = a->in[IN_SSMD] + l * SSMW;
    const bf16* Wg = (const bf16*)(a->ws + WS_WT) + (size_t)l * WT_LAYER + WT_GLU;
    bf16* PA = (bf16*)(a->ws + WS_BUFC);
    const int RPW = mrows / 256;
    for (int wgi = blockIdx.x; wgi < 256; wgi += gridDim.x) {
        const int row0 = wgi * RPW;
        {
            const int c = lane, k0 = 8 * c;
            const f32x4 d0 = *(const f32x4*)(Dv + k0), d1 = *(const f32x4*)(Dv + k0 + 4);
#pragma unroll 4
            for (int i = 0; i < RPW / 8; ++i) {
                const int r = wave + 8 * i; const size_t mr = (size_t)(row0 + r);
                const u32x4 y0w = __builtin_nontemporal_load((const u32x4*)(Y0 + mr * SSMW + k0)), y1w = __builtin_nontemporal_load((const u32x4*)(Y1 + mr * SSMW + k0));
                const f32x4 y00 = (f32x4){bflo(y0w.x), bfhi(y0w.x), bflo(y0w.y), bfhi(y0w.y)}, y01 = (f32x4){bflo(y0w.z), bfhi(y0w.z), bflo(y0w.w), bfhi(y0w.w)};
                const f32x4 y10 = (f32x4){bflo(y1w.x), bfhi(y1w.x), bflo(y1w.y), bfhi(y1w.y)}, y11 = (f32x4){bflo(y1w.z), bfhi(y1w.z), bflo(y1w.w), bfhi(y1w.w)};
                const u32x4 uw = *(const u32x4*)(u + mr * DM + POOLW + k0);
                const f32x4 u0 = (f32x4){bflo(uw.x), bfhi(uw.x), bflo(uw.y), bfhi(uw.y)}, u1 = (f32x4){bflo(uw.z), bfhi(uw.z), bflo(uw.w), bfhi(uw.w)};
                const f32x4 v0 = y00 + y10 + d0 * u0, v1 = y01 + y11 + d1 * u1;
                u32x4 w; w.x = pk2(gelu_tanh(v0.x), gelu_tanh(v0.y)); w.y = pk2(gelu_tanh(v0.z), gelu_tanh(v0.w)); w.z = pk2(gelu_tanh(v1.x), gelu_tanh(v1.y)); w.w = pk2(gelu_tanh(v1.z), gelu_tanh(v1.w));
                *(LAS u32x4*)(lds + glu_lds_off(r, c)) = w;
            }
        }
        __syncthreads();
#pragma unroll 1
        for (int mh = 0; mh < 2; ++mh) {
            const int fr = lane & 15, kq = lane >> 4, nbase = 64 * wave, mb0 = 5 * mh;
            f32x4 acc[5][4];
#pragma unroll
            for (int mb = 0; mb < 5; ++mb)
#pragma unroll
                for (int nb = 0; nb < 4; ++nb) acc[mb][nb] = (f32x4){0.f, 0.f, 0.f, 0.f};
            const bf16* wrow = Wg + (size_t)(nbase + fr) * SSMW + 8 * kq;
            bf16x8 Wc[4], Wn[4];
#pragma unroll
            for (int nb = 0; nb < 4; ++nb) Wc[nb] = *(const bf16x8*)(wrow + (size_t)(16 * nb) * SSMW);
#pragma unroll 1
            for (int ks = 0; ks < 16; ++ks) {
                if (ks + 1 < 16) {
#pragma unroll
                    for (int nb = 0; nb < 4; ++nb) Wn[nb] = *(const bf16x8*)(wrow + (size_t)(16 * nb) * SSMW + 32 * (ks + 1));
                }
#pragma unroll
                for (int mb = 0; mb < 5; ++mb) {
                    int rr = 16 * (mb0 + mb) + fr; rr = rr < RPW ? rr : RPW - 1;
                    const bf16x8 af = *(const LAS bf16x8*)(lds + glu_lds_off(rr, 4 * ks + kq));
#pragma unroll
                    for (int nb = 0; nb < 4; ++nb) acc[mb][nb] = __builtin_amdgcn_mfma_f32_16x16x32_bf16(Wc[nb], af, acc[mb][nb], 0, 0, 0);
                }
#pragma unroll
                for (int nb = 0; nb < 4; ++nb) Wc[nb] = Wn[nb];
            }
#pragma unroll
            for (int mb = 0; mb < 5; ++mb) {
                const int tok = 16 * (mb0 + mb) + fr;
                if (tok < RPW) {
#pragma unroll
                    for (int nb = 0; nb < 4; ++nb) {
                        const int n = nbase + 16 * nb + 4 * kq;
                        const u32x2 yw = *(const LAS u32x2*)(lds + glu_lds_off(tok, n >> 3) + (n & 7) * 2);
                        const f32x4 g = acc[mb][nb];
                        u32x2 o; o.x = pk2(bflo(yw.x) * sigmoidf_(g.x), bfhi(yw.x) * sigmoidf_(g.y)); o.y = pk2(bflo(yw.y) * sigmoidf_(g.z), bfhi(yw.y) * sigmoidf_(g.w));
                        *(u32x2*)(PA + (size_t)(row0 + tok) * DM + POOLW + n) = o;
                    }
                }
            }
        }
        __syncthreads();
    }
}

struct ConvF { f32x4 v[3], g[3]; };
constexpr int CV_ROWB = 1024, CV_COLB = 10 * CV_ROWB, CV_PAIRB = 2 * CV_COLB, CV_DEPTH = 6;
__device__ __forceinline__ void conv_wg_item(LAS unsigned char* lds, const bf16* z  , bf16* aout  , const float* wc, int mloc0, int mglob0, int cg, int wave, int lane) {
    const bool ctx = mglob0 >= MLAT;
    const int gr0 = (mglob0 >> 6) & 63;
    const int f0c = cg * 256, f0 = f0c + 4 * lane;
    f32x4 wv[3][3], wg[3][3];
#pragma unroll
    for (int i = 0; i < 3; ++i)
#pragma unroll
        for (int j = 0; j < 3; ++j) { wv[i][j] = *(const f32x4*)(wc + (size_t)(i * 3 + j) * DFF2 + f0); wg[i][j] = *(const f32x4*)(wc + (size_t)(i * 3 + j) * DFF2 + DFF + f0); }
    asm volatile("s_waitcnt vmcnt(0)" : "+v"(wv[0][0]), "+v"(wv[0][1]), "+v"(wv[0][2]), "+v"(wv[1][0]), "+v"(wv[1][1]), "+v"(wv[1][2]), "+v"(wv[2][0]), "+v"(wv[2][1]), "+v"(wv[2][2]),
                 "+v"(wg[0][0]), "+v"(wg[0][1]), "+v"(wg[0][2]), "+v"(wg[1][0]), "+v"(wg[1][1]), "+v"(wg[1][2]), "+v"(wg[2][0]), "+v"(wg[2][1]), "+v"(wg[2][2]) :: "memory");
    const int mrun = mglob0 + 64 * wave;
    bool up, down, left, right;
    if (!ctx) { const int gr = (mrun >> 6) & 63; up = gr > 0; down = gr < 63; left = false; right = false; }
    else { const int seg = ((mrun - MLAT) >> 6) & 3; up = false; down = false; left = seg > 0; right = seg < 3; }
    bf16* ao = aout + (size_t)(mloc0 + 64 * wave) * DFF + f0;
    const int lane_off = (lane < 32) ? (f0c + 8 * lane) : (DFF + f0c + 8 * (lane - 32));
#define CV_DMA(hr, k, p, kc) do { int jj_ = (hr) - 1; bool rv_; \
        if (!ctx) { rv_ = (jj_ >= 0 && jj_ < 8) || (jj_ < 0 && gr0 > 0) || (jj_ == 8 && gr0 + 8 < 64); } else { rv_ = (jj_ >= 0 && jj_ < 8); } \
        if (!rv_) jj_ = jj_ < 0 ? 0 : 7; \
        int kk_ = (k); bool cv_ = (kk_ >= 0 && kk_ < GRIDW); \
        if (!cv_ && ctx && rv_) { const int sg_ = ((mglob0 + 64 * jj_ - MLAT) >> 6) & 3; cv_ = (kk_ < 0) ? (sg_ > 0) : (sg_ < 3); } \
        if (!cv_) kk_ = kk_ < 0 ? 0 : GRIDW - 1; \
        const bf16* src_ = z + (size_t)(mloc0 + 64 * jj_ + kk_) * DFF2 + lane_off; \
        __builtin_amdgcn_global_load_lds((const unsigned*)src_, (LAS unsigned*)(lds + ((p) % CV_DEPTH) * CV_PAIRB + (kc) * CV_COLB + (hr) * CV_ROWB), 16, 0, 2); } while (0)
#define CV_DMA_PAIR(p) do { const int pp_ = (p) > 32 ? 32 : (p);   \
        CV_DMA(wave, 2 * pp_ - 1, p, 0); CV_DMA(wave, 2 * pp_, p, 1); \
        if (wave < 2) { CV_DMA(8 + wave, 2 * pp_ - 1, p, 0); CV_DMA(8 + wave, 2 * pp_, p, 1); } } while (0)
#define CV_F4(w2) ((f32x4){bflo((w2).x), bfhi((w2).x), bflo((w2).y), bfhi((w2).y)})
    const f32x4 zero4 = (f32x4){0.f, 0.f, 0.f, 0.f};
#define CV_CVT(slot, p, kc, k) do { const bool cok_ = ((k) >= 0 && (k) < GRIDW) || ((k) < 0 && left) || ((k) >= GRIDW && right); \
        LAS const unsigned char* b_ = lds + ((p) % CV_DEPTH) * CV_PAIRB + (kc) * CV_COLB + wave * CV_ROWB + 8 * lane; \
        _Pragma("unroll") for (int i_ = 0; i_ < 3; ++i_) { const bool ok_ = cok_ && (i_ == 1 || (i_ == 0 && up) || (i_ == 2 && down)); \
            if (ok_) { const u32x2 a_ = *(LAS const u32x2*)(b_ + i_ * CV_ROWB), g_ = *(LAS const u32x2*)(b_ + i_ * CV_ROWB + 512); F[slot].v[i_] = CV_F4(a_); F[slot].g[i_] = CV_F4(g_); } \
            else { F[slot].v[i_] = zero4; F[slot].g[i_] = zero4; } } } while (0)
#define CV_OUT(c, sm, s0, sp) do { f32x4 ov = wv[0][0] * F[sm].v[0], og = wg[0][0] * F[sm].g[0]; \
        ov += wv[1][0] * F[sm].v[1]; og += wg[1][0] * F[sm].g[1]; ov += wv[2][0] * F[sm].v[2]; og += wg[2][0] * F[sm].g[2]; \
        _Pragma("unroll") for (int i_ = 0; i_ < 3; ++i_) { ov += wv[i_][1] * F[s0].v[i_]; og += wg[i_][1] * F[s0].g[i_]; ov += wv[i_][2] * F[sp].v[i_]; og += wg[i_][2] * F[sp].g[i_]; } \
        const f32x4 o_ = ov * og * (f32x4){sigmoidf_(og.x), sigmoidf_(og.y), sigmoidf_(og.z), sigmoidf_(og.w)}; \
        u32x2 w_; w_.x = pk2(o_.x, o_.y); w_.y = pk2(o_.z, o_.w); st8_wt(ao + (size_t)(c) * DFF, w_); } while (0)
#define CV_ARRIVE(p, EXACT) do { if (EXACT) { if (wave < 2) asm volatile("s_waitcnt vmcnt(26)" ::: "memory"); else asm volatile("s_waitcnt vmcnt(18)" ::: "memory"); } \
        else { if (wave < 2) asm volatile("s_waitcnt vmcnt(16)" ::: "memory"); else asm volatile("s_waitcnt vmcnt(8)" ::: "memory"); } \
        asm volatile("s_waitcnt lgkmcnt(0)" ::: "memory"); __builtin_amdgcn_s_barrier(); asm volatile("" ::: "memory"); CV_DMA_PAIR((p) + 5); } while (0)
    ConvF F[4];
    CV_DMA_PAIR(0); CV_DMA_PAIR(1); CV_DMA_PAIR(2); CV_DMA_PAIR(3); CV_DMA_PAIR(4);
    CV_ARRIVE(0, false); CV_CVT(0, 0, 0, -1); CV_CVT(1, 0, 1, 0);
#pragma unroll 1
    for (int q = 0; q < 16; ++q) {
        const int po = 2 * q + 1, pe = 2 * q + 2;
        const bool ex = q >= 3;
        CV_ARRIVE(po, ex); CV_CVT(2, po, 0, 2 * po - 1); CV_CVT(3, po, 1, 2 * po);
        CV_OUT(2 * po - 2, 0, 1, 2); CV_OUT(2 * po - 1, 1, 2, 3);
        CV_ARRIVE(pe, ex); CV_CVT(0, pe, 0, 2 * pe - 1); CV_CVT(1, pe, 1, 2 * pe);
        CV_OUT(2 * pe - 2, 2, 3, 0); CV_OUT(2 * pe - 1, 3, 0, 1);
    }
    asm volatile("s_waitcnt vmcnt(0) lgkmcnt(0)" ::: "memory"); __builtin_amdgcn_s_barrier(); asm volatile("" ::: "memory");
#undef CV_DMA
#undef CV_DMA_PAIR
#undef CV_F4
#undef CV_CVT
#undef CV_OUT
#undef CV_ARRIVE
}
__device__ __forceinline__ void phase_conv(ArgsP a, LAS unsigned char* lds, int l, int r0, int r1, const bf16* z, bf16* aout, int wave, int lane) {
    const float* wc = a->in[IN_WCONV] + (size_t)l * 9 * DFF2;
    const int nitems = ((r1 - r0) / (GRIDW * 8)) * 22;
    for (int it = blockIdx.x; it < nitems; it += gridDim.x) {
        const int rb = it / 22, cg = it % 22;
        conv_wg_item(lds, z, aout, wc, rb * 8 * GRIDW, r0 + rb * 8 * GRIDW, cg, wave, lane);
    }
}

constexpr int PH_PER_LAYER = 13;
constexpr int PH_TOTAL = 2 + DEPTH * PH_PER_LAYER;
constexpr int NORM_WGS = 64;

__global__ void __launch_bounds__(NTHREADS, 2) mk_fwd(Args args) {
    extern __shared__ __attribute__((aligned(16))) unsigned char lds_raw[];
    LAS unsigned char* lds = (LAS unsigned char*)lds_raw;
    const ArgsP kp = (ArgsP)__builtin_amdgcn_kernarg_segment_ptr();
    (void)args;
    volatile LAS unsigned* MISC = (volatile LAS unsigned*)(lds + MISC_OFF);
    if (threadIdx.x < 64) MISC[threadIdx.x] = 0u;
    __syncthreads();
    const int lo = kp->seg_lo, hi = kp->seg_hi;
    XcdBarrier bar; bar.bar = (unsigned*)(kp->ws + WS_CTL) + CW_BAR; bar.x = 0; bar.st = MISC + 8;
    if (hi - lo > 1) bar = xcd_barrier_post((unsigned*)(kp->ws + WS_CTL) + CW_BAR, MISC + 8);
#ifndef PHEN
#define PHEN 0xffff
#endif
#define IN(k) (lo <= (k) && (k) < hi)
#define SEAM(k) do { if ((k) + 1 < hi) xcd_barrier(bar); } while (0)
#define REP(bit) for (int rep_ = 0, nrep_ = ((kp->dup & (bit)) ? 2 : 1); rep_ < nrep_; ++rep_)
#define TIDV int tid_ = threadIdx.x; asm volatile("" : "+v"(tid_)); const int tid = tid_, lane = tid & 63, wave = __builtin_amdgcn_readfirstlane(tid >> 6); const int G = gridDim.x, gw = blockIdx.x * NWAVES + wave, ngw = G * NWAVES; (void)lane; (void)gw; (void)ngw; (void)G

    if ((PHEN & 1) && IN(0)) { TIDV; phase_prologue(launder(kp), lds, tid, wave, lane); SEAM(0); }
    if ((PHEN & 2) && IN(1)) {
        TIDV; const ArgsP a = launder(kp); float* MOD = (float*)(a->ws + WS_MOD);
        NormP P; P.y = nullptr; P.y_row0 = 0; P.xin_lat = a->in[IN_X]; P.xin_ctx = a->in[IN_CTX]; P.xb = (bf16*)(a->ws + WS_XB); P.out_f32 = nullptr; P.h = (bf16*)(a->ws + WS_BUFA);
        P.gate = nullptr; P.g_post = nullptr; P.g_pre = a->in[IN_GPREMIX]; P.shift = MOD + 0 * DM; P.scale = MOD + 1 * DM;
        phase_norm(P, 0, MALL, gw, ngw, lane);
        SEAM(1);
    }
    for (int l = 0; l < DEPTH; ++l) {
        const int pb = 2 + l * PH_PER_LAYER;
        if (pb + PH_PER_LAYER <= lo || pb >= hi) continue;
        const int mrows = (l == DEPTH - 1) ? MLAT : MALL;
        if ((PHEN & 4) && IN(pb + 0)) {
            const ArgsP a = launder(kp); const pg8::bf16_t* WTL = (const pg8::bf16_t*)(a->ws + WS_WT) + (size_t)l * WT_LAYER;
            pg8::Gemm g{(const bf16*)(a->ws + WS_BUFA), WTL + WT_IN, MALL, DM, DM}; pg8::StaticOrder S; S.init(MALL, DM, (int)gridDim.x, (int)blockIdx.x);
            pg8::EpiBf16 E{(bf16*)(a->ws + WS_BUFB), DM};
            REP(4) pg8::gemm_phase<pg8::EpiBf16, pg8::StaticOrder, true, true>(lds, g, S, E);
            SEAM(pb + 0);
        }
        if ((PHEN & 8) && IN(pb + 1)) { TIDV; REP(8) phase_mix_a(launder(kp), lds, l, mrows, wave, lane, tid); SEAM(pb + 1); }
        if ((PHEN & 16) && IN(pb + 2)) { TIDV; REP(16) phase_mix_b(launder(kp), lds, l, mrows, tid, wave, lane); SEAM(pb + 2); }
        if ((PHEN & 32) && IN(pb + 3)) {
            const ArgsP a = launder(kp); const pg8::bf16_t* WTL = (const pg8::bf16_t*)(a->ws + WS_WT) + (size_t)l * WT_LAYER;
            pg8::Gemm g{(const bf16*)(a->ws + WS_BUFC), WTL + WT_COMB, mrows, DM, DM}; pg8::StaticOrder S; S.init(mrows, DM, (int)gridDim.x, (int)blockIdx.x);
            pg8::EpiBf16 E{(bf16*)(a->ws + WS_BUFB), DM};
            REP(4) pg8::gemm_phase<pg8::EpiBf16, pg8::StaticOrder, true, true>(lds, g, S, E);
            SEAM(pb + 3);
        }
        if ((PHEN & 64) && IN(pb + 4)) {
            TIDV; const ArgsP a = launder(kp); const float* MODL = (const float*)(a->ws + WS_MOD) + (size_t)l * 9 * 6 * DM;
            NormP P; P.y = (const bf16*)(a->ws + WS_BUFB); P.y_row0 = 0; P.xin_lat = nullptr; P.xin_ctx = nullptr; P.xb = (bf16*)(a->ws + WS_XB); P.out_f32 = nullptr; P.h = (bf16*)(a->ws + WS_BUFA);
            P.gate = MODL + 2 * DM; P.g_post = a->in[IN_GPOSTMIX] + l * DM; P.g_pre = a->in[IN_GPREFFN] + l * DM; P.shift = MODL + 3 * DM; P.scale = MODL + 4 * DM;
            phase_norm(P, 0, mrows, gw, ngw, lane);
            SEAM(pb + 4);
        }
        for (int hf = 0; hf < 2; ++hf) {
            const int nhalf = kp->nhalf;
            if (hf >= nhalf) break;
            const int r0 = (nhalf == 1) ? 0 : (hf == 0 ? 0 : HALF1_ROW0), r1 = (nhalf == 1) ? mrows : (hf == 0 ? HALF1_ROW0 : mrows);
            const int ph = pb + 5 + 4 * hf;
            const size_t a_off = (nhalf == 1) ? WS_BUFA : WS_BUFB, f_off = (nhalf == 1) ? WS_Z : (hf == 0 ? WS_BUFB + A_HALF : WS_Z);
            const bool pair_norm0 = (nhalf == 2 && l < DEPTH - 1);
            if ((PHEN & 128) && IN(ph + 0)) {
                const ArgsP a = launder(kp); const pg8::bf16_t* WTL = (const pg8::bf16_t*)(a->ws + WS_WT) + (size_t)l * WT_LAYER;
                pg8::Gemm g{(const bf16*)(a->ws + WS_BUFA) + (size_t)r0 * DM, WTL + WT_UP, r1 - r0, DFF2, DM}; pg8::StaticOrder S; S.init(r1 - r0, DFF2, (int)gridDim.x, (int)blockIdx.x);
                pg8::EpiBf16 E{(bf16*)(a->ws + WS_Z), DFF2};
                REP(4) pg8::gemm_phase<pg8::EpiBf16, pg8::StaticOrder, true, true>(lds, g, S, E);
                SEAM(ph + 0);
            }
            if ((PHEN & 256) && IN(ph + 1)) { TIDV; const ArgsP a = launder(kp); REP(256) phase_conv(a, lds, l, r0, r1, (const bf16*)(a->ws + WS_Z), (bf16*)(a->ws + a_off), wave, lane); SEAM(ph + 1); }
            if ((PHEN & 512) && IN(ph + 2)) {
                const bool paired = pair_norm0 && hf == 1;
                const int gG = paired ? (int)gridDim.x - NORM_WGS : (int)gridDim.x;
                if ((int)blockIdx.x < gG) {
                    const ArgsP a = launder(kp); const pg8::bf16_t* WTL = (const pg8::bf16_t*)(a->ws + WS_WT) + (size_t)l * WT_LAYER;
                    pg8::Gemm g{(const bf16*)(a->ws + a_off), WTL + WT_DOWN, r1 - r0, DM, DFF}; pg8::StaticOrder S; S.init(r1 - r0, DM, gG, (int)blockIdx.x);
                    pg8::EpiBf16 E{(bf16*)(a->ws + f_off), DM};
                    REP(4) pg8::gemm_phase<pg8::EpiBf16, pg8::StaticOrder, true, true>(lds, g, S, E);
                } else {
                    TIDV; const ArgsP a = launder(kp);
                    const float* MODL = (const float*)(a->ws + WS_MOD) + (size_t)l * 9 * 6 * DM; const float* MODN = MODL + 9 * 6 * DM;
                    NormP P; P.y = (const bf16*)(a->ws + WS_BUFB + A_HALF); P.y_row0 = 0; P.xin_lat = nullptr; P.xin_ctx = nullptr; P.xb = (bf16*)(a->ws + WS_XB); P.out_f32 = nullptr;
                    P.h = (bf16*)(a->ws + WS_BUFA);
                    P.gate = MODL + 5 * DM; P.g_post = a->in[IN_GPOSTFFN] + l * DM;
                    P.g_pre = a->in[IN_GPREMIX] + (l + 1) * DM; P.shift = MODN + 0 * DM; P.scale = MODN + 1 * DM;
                    phase_norm(P, 0, HALF1_ROW0, ((int)blockIdx.x - gG) * NWAVES + wave, NORM_WGS * NWAVES, lane);
                }
                SEAM(ph + 2);
            }
            if ((PHEN & 1024) && IN(ph + 3) && !(pair_norm0 && hf == 0)) {
                TIDV; const ArgsP a = launder(kp); const bool lastl = (l == DEPTH - 1);
                const float* MODL = (const float*)(a->ws + WS_MOD) + (size_t)l * 9 * 6 * DM; const float* MODN = MODL + (lastl ? 0 : 9 * 6 * DM);
                NormP P; P.y = (const bf16*)(a->ws + f_off); P.y_row0 = r0; P.xin_lat = nullptr; P.xin_ctx = nullptr; P.xb = (bf16*)(a->ws + WS_XB); P.out_f32 = lastl ? a->out : nullptr;
                P.h = lastl ? nullptr : (bf16*)(a->ws + WS_BUFA);
                P.gate = MODL + 5 * DM; P.g_post = a->in[IN_GPOSTFFN] + l * DM;
                P.g_pre = a->in[IN_GPREMIX] + (lastl ? l : l + 1) * DM; P.shift = MODN + 0 * DM; P.scale = MODN + 1 * DM;
                phase_norm(P, r0, r1, gw, ngw, lane);
                SEAM(ph + 3);
            }
        }
    }
#undef IN
#undef SEAM
#undef TIDV
}

extern "C" void kernel_launch(void* const* d_in, const int* in_sizes, int n_in, void* d_out, int out_size, void* d_ws, size_t ws_size, hipStream_t stream) {
    static int grid = 0;
    if (grid == 0) {
        if (n_in != 26 || out_size != MLAT * DM || ws_size < WS_NEED_HALF) { fprintf(stderr, "kernel_launch: unexpected problem shape / workspace (n_in %d, out %d, ws %zu, need %zu)\n", n_in, out_size, ws_size, (size_t)WS_NEED_HALF); grid = -1; return; }
        int dev = 0, cus = 0, per_cu = 0;
        if (hipGetDevice(&dev) != hipSuccess || hipDeviceGetAttribute(&cus, hipDeviceAttributeMultiprocessorCount, dev) != hipSuccess) { grid = -1; return; }
        if (hipFuncSetAttribute((const void*)mk_fwd, hipFuncAttributeMaxDynamicSharedMemorySize, LDS_BYTES) != hipSuccess) { fprintf(stderr, "kernel_launch: hipFuncSetAttribute failed\n"); grid = -1; return; }
        if (hipOccupancyMaxActiveBlocksPerMultiprocessor(&per_cu, (const void*)mk_fwd, NTHREADS, LDS_BYTES) != hipSuccess || per_cu < 1)
            fprintf(stderr, "kernel_launch: note: occupancy query reports %d workgroups per CU\n", per_cu);
        (void)hipGetLastError();
        grid = cus;
        if (grid != 256) fprintf(stderr, "kernel_launch: note: %d CUs (built for 256)\n", grid);
    }
    if (grid < 0) return;
    if (hipMemsetAsync((char*)d_ws + WS_CTL, 0, CTL_BYTES, stream) != hipSuccess) { fprintf(stderr, "kernel_launch: memset failed\n"); return; }
    Args a{};
    for (int i = 0; i < 26; ++i) a.in[i] = (const float*)d_in[i];
    a.out = (float*)d_out; a.ws = (unsigned char*)d_ws;
    a.nhalf = 2;
    a.dup = MK_DUP;
#if MK_MULTI_LAUNCH
    for (int ph = 0; ph < PH_TOTAL; ++ph) {
        if (ph >= 2) { const int k = (ph - 2) % PH_PER_LAYER, ll = (ph - 2) / PH_PER_LAYER; if (a.nhalf == 1 && k >= 9) continue; if (a.nhalf == 2 && k == 8 && ll < DEPTH - 1) continue; }
        a.seg_lo = ph; a.seg_hi = ph + 1;
        hipLaunchKernelGGL(mk_fwd, dim3(grid), dim3(NTHREADS), LDS_BYTES, stream, a);
    }
#else
    a.seg_lo = 0; a.seg_hi = PH_TOTAL;
    hipLaunchKernelGGL(mk_fwd, dim3(grid), dim3(NTHREADS), LDS_BYTES, stream, a);
#endif
    const hipError_t le = hipPeekAtLastError();
    if (le != hipSuccess) fprintf(stderr, "kernel_launch: launch failed: %s\n", hipGetErrorName(le));
}
```

```cpp
#include <hip/hip_runtime.h>
#include <cstdio>
#include <cstdint>

#ifndef MK_DUP
#define MK_DUP 0
#endif
#ifndef MK_MULTI_LAUNCH
#define MK_MULTI_LAUNCH 0
#endif

namespace pg8 {
#define PG8_LAS __attribute__((address_space(3)))
typedef unsigned short bf16_t;
typedef short bf16x8 __attribute__((ext_vector_type(8)));
typedef float f32x4 __attribute__((ext_vector_type(4)));
typedef unsigned u32x4 __attribute__((ext_vector_type(4)));
constexpr int BM = 256, BK = 64, HALF = 128, HTB = HALF * BK * 2, STAGE_BYTES = 8 * HTB, NXCD = 8, WGM = 8;

__host__ __device__ __forceinline__ int lds_byte(int r, int c) { const int st = (r >> 4) * 2 + (c >> 5), rr = r & 15, cc = c & 31, ob = rr * 64 + cc * 2; return st * 1024 + (ob ^ (((ob >> 9) & 1) << 5)); }
__host__ __device__ __forceinline__ void stage_rc(int b, int& R, int& C) { const int st = b / 1024, sb = b % 1024, swz = sb ^ (((sb >> 9) & 1) << 5); R = (st >> 1) * 16 + swz / 64; C = (st & 1) * 32 + (swz % 64) / 2; }
__host__ __device__ __forceinline__ int perm32(int rho) { const int n = rho >> 4, i = rho & 15; return 8 * (i >> 2) + 4 * n + (i & 3); }

struct Unit { int pm, pn; };
struct Gemm { const bf16_t* A; const bf16_t* Bt; int M, N, K; };

struct StaticOrder {
    int nM, nN, nwg, G, c;
    __host__ __device__ void init(int M, int N, int G_, int c_) { nM = M / BM; nN = N / BM; nwg = nM * nN; G = G_; c = c_; }
    __host__ __device__ bool next(int i, Unit& u) const {
        const long L = (long)i * G + c; if (L >= nwg) return false;
        int wgid = (int)L; { const int q = nwg / NXCD, r = nwg % NXCD, xcd = wgid % NXCD, off = wgid / NXCD; wgid = (xcd < r ? xcd * (q + 1) : r * (q + 1) + (xcd - r) * q) + off; }
        const int nig = WGM * nN, gid = wgid / nig, fm = gid * WGM, gsz = (nM - fm) < WGM ? (nM - fm) : WGM;
        u.pm = fm + ((wgid % nig) % gsz); u.pn = (wgid % nig) / gsz; return true;
    }
    __device__ __forceinline__ void a_ready(const Unit&) const {}
    __device__ __forceinline__ void done(const Unit&) const {}
};

__device__ __forceinline__ unsigned cvt_pk_bf16(float lo, float hi) { unsigned r; asm volatile("v_cvt_pk_bf16_f32 %0, %1, %2" : "=v"(r) : "v"(lo), "v"(hi)); return r; }

struct EpiBf16 {
    static constexpr bool PERM = true, AFTER_DRAIN = false;
    bf16_t* O; int ldc;
    __device__ __forceinline__ void operator()(const f32x4 (&acc)[2][2][4][2], const Unit& u, int wr, int wc, int fr, int fq, bool last) const {
        const int row0 = u.pm * BM + wr * 64 + fr; const int col0 = u.pn * BM + wc * 32 + 8 * fq;
#pragma unroll
        for (int ai = 0; ai < 2; ++ai)
#pragma unroll
            for (int m = 0; m < 4; ++m) { bf16_t* rowp = O + (size_t)(row0 + ai * HALF + m * 16) * ldc + col0;
#pragma unroll
                for (int bj = 0; bj < 2; ++bj) { const f32x4 v0 = acc[ai][bj][m][0], v1 = acc[ai][bj][m][1];
                    u32x4 w; w.x = cvt_pk_bf16(v0[0], v0[1]); w.y = cvt_pk_bf16(v0[2], v0[3]); w.z = cvt_pk_bf16(v1[0], v1[1]); w.w = cvt_pk_bf16(v1[2], v1[3]);
                    if (last) asm volatile("global_store_dwordx4 %0, %1, off sc1\n\ts_nop 1" :: "v"(rowp + bj * HALF), "v"(w) : "memory"); else *(u32x4*)(rowp + bj * HALF) = w; } }
    }
};

template <class Epi, class Sched, bool ALIGN_EPI = false, bool SP2 = false>
__device__ __forceinline__ void gemm_phase(PG8_LAS unsigned char* lds, const Gemm g, const Sched& S, const Epi& E) {
    int tid_ = threadIdx.x; asm volatile("" : "+v"(tid_));
    const int tid = tid_, wid = __builtin_amdgcn_readfirstlane(tid >> 6), lane = tid & 63, wr = wid >> 2, wc = wid & 3, fr = lane & 15, fq = lane >> 4;
    const int K = g.K, nt = K / BK;
    unsigned voffA[2], voffB[2];
#pragma unroll
    for (int i = 0; i < 2; ++i) { int R, C; stage_rc(tid * 16 + i * 8192, R, C); const int Rb = Epi::PERM ? ((R & ~31) + perm32(R & 31)) : R;
        voffA[i] = (unsigned)(R * K + C) * 2u; voffB[i] = (unsigned)(Rb * K + C) * 2u; }
    const size_t kstep = (size_t)(BK * 2);
    const size_t hstep = (size_t)HALF * K * 2;
    const size_t tstep = 2 * hstep;
    const unsigned ldsw = (unsigned)wid * 1024u;
    const int aoff = lds_byte(wr * 64 + fr, fq * 8), boff = lds_byte(wc * 32 + fr, fq * 8);
#define PG8_SA(b, h) (((b) * 2 + (h)) * HTB)
#define PG8_SB(b, h) ((4 + (b) * 2 + (h)) * HTB)
#define PG8_STAGE(bufoff, gbase, voff) do { _Pragma("unroll") for (int _i = 0; _i < 2; ++_i) \
        __builtin_amdgcn_global_load_lds((const unsigned*)((const char*)(gbase) + (voff)[_i]), (PG8_LAS unsigned*)(lds + (bufoff) + ldsw + _i * 8192), 16, 0, 0); } while (0)
#define PG8_LDA(dst, b, h) do { _Pragma("unroll") for (int m = 0; m < 4; ++m) _Pragma("unroll") for (int k = 0; k < 2; ++k) dst[m][k] = *(const PG8_LAS bf16x8*)(lds + PG8_SA(b, h) + aoff + m * 2048 + k * 1024); } while (0)
#define PG8_LDB(dst, b, h) do { _Pragma("unroll") for (int n = 0; n < 2; ++n) _Pragma("unroll") for (int k = 0; k < 2; ++k) dst[n][k] = *(const PG8_LAS bf16x8*)(lds + PG8_SB(b, h) + boff + n * 2048 + k * 1024); } while (0)
#define PG8_MMA(ai, bj, At, Bt) do { __builtin_amdgcn_s_setprio(1); _Pragma("unroll") for (int m = 0; m < 4; ++m) _Pragma("unroll") for (int n = 0; n < 2; ++n) _Pragma("unroll") for (int k = 0; k < 2; ++k) \
        acc[ai][bj][m][n] = __builtin_amdgcn_mfma_f32_16x16x32_bf16(Bt[n][k], At[m][k], acc[ai][bj][m][n], 0, 0, 0); __builtin_amdgcn_s_setprio(0); } while (0)
#define PG8_WAIT_V(n) asm volatile("s_waitcnt vmcnt(" #n ")" ::: "memory")
#define PG8_WAIT_L(n) asm volatile("s_waitcnt lgkmcnt(" #n ")" ::: "memory")
#define PG8_BAR __builtin_amdgcn_s_barrier()
#define PG8_SCHED __builtin_amdgcn_sched_barrier(0)
    Unit cur, nxt; int ui = 0;
    if (!S.next(0, cur)) return;
    f32x4 acc[2][2][4][2];
#pragma unroll
    for (int a = 0; a < 2; ++a)
#pragma unroll
        for (int b = 0; b < 2; ++b)
#pragma unroll
            for (int m = 0; m < 4; ++m)
#pragma unroll
                for (int n = 0; n < 2; ++n) acc[a][b][m][n] = (f32x4){0.f, 0.f, 0.f, 0.f};
    bf16x8 At[4][2], B0[2][2], B1[2][2];
    const char* cA = (const char*)g.A + (size_t)cur.pm * tstep; const char* cB = (const char*)g.Bt + (size_t)cur.pn * tstep;
    S.a_ready(cur);
    if constexpr (SP2) {
        PG8_STAGE(PG8_SB(0, 0), cB, voffB); PG8_STAGE(PG8_SB(0, 1), cB + hstep, voffB); PG8_STAGE(PG8_SA(0, 0), cA, voffA); PG8_STAGE(PG8_SA(0, 1), cA + hstep, voffA);
        if (wr == 1) PG8_BAR;
        PG8_WAIT_V(2); PG8_BAR;
        PG8_STAGE(PG8_SB(1, 0), cB + kstep, voffB); PG8_STAGE(PG8_SA(1, 0), cA + kstep, voffA); PG8_STAGE(PG8_SB(1, 1), cB + hstep + kstep, voffB);
        PG8_WAIT_V(6); PG8_BAR;
    } else {
        PG8_STAGE(PG8_SB(0, 0), cB, voffB); PG8_STAGE(PG8_SA(0, 0), cA, voffA); PG8_STAGE(PG8_SB(0, 1), cB + hstep, voffB); PG8_STAGE(PG8_SA(0, 1), cA + hstep, voffA);
        if (wr == 1) PG8_BAR;
        PG8_WAIT_V(4); PG8_BAR;
        PG8_STAGE(PG8_SB(1, 0), cB + kstep, voffB); PG8_STAGE(PG8_SA(1, 0), cA + kstep, voffA); PG8_STAGE(PG8_SB(1, 1), cB + hstep + kstep, voffB);
        PG8_WAIT_V(6); PG8_BAR;
    }
    for (;;) {
        const bool has_next = S.next(ui + 1, nxt);
        const char* nA = has_next ? (const char*)g.A + (size_t)nxt.pm * tstep : cA; const char* nB = has_next ? (const char*)g.Bt + (size_t)nxt.pn * tstep : cB;
        for (int t = 0; t < nt; t += 2) {
            const bool last = (t == nt - 2);
            const char* a1 = cA + (size_t)(t + 1) * kstep;
            const char* a2 = last ? nA : cA + (size_t)(t + 2) * kstep; const char* b2 = last ? nB : cB + (size_t)(t + 2) * kstep;
            const char* a3 = a2 + kstep; const char* b3 = b2 + kstep;
            if (last && has_next) S.a_ready(nxt);
            if constexpr (SP2) {
            PG8_LDB(B0, 0, 0); PG8_LDB(B1, 0, 1); PG8_SCHED; PG8_LDA(At, 0, 0); PG8_STAGE(PG8_SA(1, 1), a1 + hstep, voffA);
            PG8_WAIT_V(8); PG8_WAIT_L(0); PG8_BAR; PG8_MMA(0, 0, At, B0); PG8_MMA(0, 1, At, B1); PG8_BAR; PG8_SCHED;
            PG8_LDA(At, 0, 1); PG8_STAGE(PG8_SB(0, 0), b2, voffB); PG8_STAGE(PG8_SB(0, 1), b2 + hstep, voffB); PG8_STAGE(PG8_SA(0, 0), a2, voffA);
            PG8_WAIT_V(8); PG8_WAIT_L(0); PG8_BAR; PG8_MMA(1, 0, At, B0); PG8_MMA(1, 1, At, B1); PG8_BAR; PG8_SCHED;
            PG8_LDB(B0, 1, 0); PG8_LDB(B1, 1, 1); PG8_SCHED; PG8_LDA(At, 1, 0); PG8_STAGE(PG8_SA(0, 1), a2 + hstep, voffA);
            PG8_WAIT_V(8); PG8_WAIT_L(0); PG8_BAR; PG8_MMA(0, 0, At, B0); PG8_MMA(0, 1, At, B1); PG8_BAR; PG8_SCHED;
            PG8_LDA(At, 1, 1); PG8_STAGE(PG8_SB(1, 0), b3, voffB); PG8_STAGE(PG8_SB(1, 1), b3 + hstep, voffB); PG8_STAGE(PG8_SA(1, 0), a3, voffA);
            PG8_WAIT_V(8); PG8_WAIT_L(0); PG8_BAR; PG8_MMA(1, 0, At, B0); PG8_MMA(1, 1, At, B1); PG8_BAR; PG8_SCHED;
            } else {
            PG8_LDB(B0, 0, 0); PG8_SCHED; PG8_LDA(At, 0, 0); PG8_STAGE(PG8_SA(1, 1), a1 + hstep, voffA);
            PG8_WAIT_L(8); PG8_BAR; PG8_WAIT_L(0); PG8_MMA(0, 0, At, B0); PG8_BAR; PG8_SCHED;
            PG8_LDB(B1, 0, 1); PG8_STAGE(PG8_SB(0, 0), b2, voffB);
            PG8_BAR; PG8_WAIT_L(0); PG8_MMA(0, 1, At, B1); PG8_BAR;
            PG8_LDA(At, 0, 1); PG8_STAGE(PG8_SA(0, 0), a2, voffA);
            PG8_BAR; PG8_WAIT_L(0); PG8_MMA(1, 0, At, B0); PG8_BAR; PG8_SCHED;
            PG8_STAGE(PG8_SB(0, 1), b2 + hstep, voffB);
            PG8_WAIT_V(6); PG8_BAR; PG8_MMA(1, 1, At, B1); PG8_BAR;
            PG8_LDB(B0, 1, 0); PG8_SCHED; PG8_LDA(At, 1, 0); PG8_STAGE(PG8_SA(0, 1), a2 + hstep, voffA);
            PG8_WAIT_L(8); PG8_BAR; PG8_WAIT_L(0); PG8_MMA(0, 0, At, B0); PG8_BAR; PG8_SCHED;
            PG8_LDB(B1, 1, 1); PG8_STAGE(PG8_SB(1, 0), b3, voffB);
            PG8_BAR; PG8_WAIT_L(0); PG8_MMA(0, 1, At, B1); PG8_BAR;
            PG8_LDA(At, 1, 1); PG8_STAGE(PG8_SA(1, 0), a3, voffA);
            PG8_BAR; PG8_WAIT_L(0); PG8_MMA(1, 0, At, B0); PG8_BAR; PG8_SCHED;
            PG8_STAGE(PG8_SB(1, 1), b3 + hstep, voffB);
            PG8_WAIT_V(6); PG8_BAR; PG8_MMA(1, 1, At, B1); PG8_BAR;
            }
        }
        if constexpr (ALIGN_EPI) { if (wr == 0) PG8_BAR; }
        if constexpr (!Epi::AFTER_DRAIN) { E(acc, cur, wr, wc, fr, fq, !has_next); S.done(cur); }
        if (!has_next) break;
#pragma unroll
        for (int a = 0; a < 2; ++a)
#pragma unroll
            for (int b = 0; b < 2; ++b)
#pragma unroll
                for (int m = 0; m < 4; ++m)
#pragma unroll
                    for (int n = 0; n < 2; ++n) acc[a][b][m][n] = (f32x4){0.f, 0.f, 0.f, 0.f};
        cur = nxt; cA = nA; cB = nB; ++ui;
        if constexpr (ALIGN_EPI) { if (wr == 1) PG8_BAR; }
    }
    PG8_WAIT_V(0);
    if constexpr (!ALIGN_EPI) { if (wr == 0) PG8_BAR; }
    PG8_BAR;
#undef PG8_SA
#undef PG8_SB
#undef PG8_STAGE
#undef PG8_LDA
#undef PG8_LDB
#undef PG8_MMA
#undef PG8_WAIT_V
#undef PG8_WAIT_L
#undef PG8_BAR
#undef PG8_SCHED
}
}

constexpr int DM = 2048, NBATCH = 8, SEQ = 4096, DEPTH = 4, CTXL = 256, GRIDW = 64;
constexpr int MLAT = NBATCH * SEQ, MCTX = NBATCH * CTXL, MALL = MLAT + MCTX;
constexpr int POOLW = 1536, SSMW = 512, NGRP = 32, SGRP = 16, NSTATE = 64, PGRP = 384;
constexpr int DFF = 5632, DFF2 = 11264;
constexpr float EPSN = 1e-6f;
constexpr int NWAVES = 8, NTHREADS = 512;

constexpr size_t MiB = 1u << 20;
constexpr size_t WS_CTL = 0, CTL_BYTES = 1 * MiB;
constexpr size_t WS_MOD = 1 * MiB;
constexpr size_t WS_LAM = 3 * MiB;
constexpr size_t WS_BB = 4 * MiB;
constexpr size_t WS_CM = 6 * MiB;
constexpr size_t WS_WT = 8 * MiB;
constexpr size_t WT_IN = 0, WT_COMB = (size_t)DM * DM, WT_UP = 2 * (size_t)DM * DM, WT_DOWN = WT_UP + (size_t)DFF2 * DM, WT_GLU = WT_DOWN + (size_t)DM * DFF, WT_LAYER = WT_GLU + (size_t)SSMW * SSMW;
constexpr size_t WS_XB = WS_WT + 4 * WT_LAYER * 2;
constexpr size_t WS_BUFA = WS_XB + (size_t)MALL * DM * 2;
constexpr size_t BUF_BYTES = (size_t)MALL * DM * 2;
constexpr size_t WS_BUFB = WS_BUFA + BUF_BYTES, WS_BUFC = WS_BUFB + BUF_BYTES, WS_Z = WS_BUFC + BUF_BYTES;
constexpr int HALF1_ROW0 = 4 * SEQ;
constexpr size_t Z_FULL = (size_t)MALL * DFF2 * 2, Z_HALF = (size_t)(MALL - HALF1_ROW0) * DFF2 * 2;
constexpr size_t A_HALF = (size_t)(MALL - HALF1_ROW0) * DFF * 2;
constexpr size_t WS_NEED_FULL = WS_Z + Z_FULL, WS_NEED_HALF = WS_Z + Z_HALF;
static_assert(A_HALF + (size_t)(MALL - HALF1_ROW0) * DM * 2 <= 2 * BUF_BYTES, "half-mode a + f fit in bufB|bufC");
static_assert((size_t)MALL * DFF * 2 <= 3 * BUF_BYTES, "full-mode a fits in bufA|bufB|bufC");
static_assert(WS_XB % 256 == 0 && WS_BUFA % 256 == 0 && WS_Z % 256 == 0, "alignment");
constexpr int CW_QUEUE = 64;
constexpr int CW_BAR = 4096;

constexpr int SCRATCH_BYTES = 139264;
constexpr int MISC_OFF = SCRATCH_BYTES;
constexpr int LDS_BYTES = 147456;

#define LAS __attribute__((address_space(3)))
typedef unsigned short bf16;
typedef short bf16x8 __attribute__((ext_vector_type(8)));
typedef float f32x4 __attribute__((ext_vector_type(4)));
typedef float f32x16 __attribute__((ext_vector_type(16)));
typedef unsigned u32x4 __attribute__((ext_vector_type(4)));
typedef unsigned u32x2 __attribute__((ext_vector_type(2)));

__device__ __forceinline__ float bf2f(unsigned short b) { return __uint_as_float(((unsigned)b) << 16); }
__device__ __forceinline__ float bflo(unsigned w) { return __uint_as_float(w << 16); }
__device__ __forceinline__ float bfhi(unsigned w) { return __uint_as_float(w & 0xffff0000u); }
__device__ __forceinline__ unsigned pk2(float lo, float hi) { return pg8::cvt_pk_bf16(lo, hi); }
__device__ __forceinline__ float wave_sum(float v) {
#pragma unroll
    for (int o = 1; o < 64; o <<= 1) v += __shfl_xor(v, o);
    return v;
}
__device__ __forceinline__ void st16_wt(void* p, u32x4 v) { asm volatile("global_store_dwordx4 %0, %1, off sc1\n\ts_nop 1" :: "v"(p), "v"(v) : "memory"); }
__device__ __forceinline__ void st8_wt(void* p, u32x2 v) { asm volatile("global_store_dwordx2 %0, %1, off sc1\n\ts_nop 1" :: "v"(p), "v"(v) : "memory"); }
__device__ __forceinline__ float sigmoidf_(float t) { return __builtin_amdgcn_rcpf(1.0f + __builtin_amdgcn_exp2f(-1.4426950408889634f * t)); }

#define XB_TMO      128
#define XB_XCNT(j)  (256  + 64 * (j))
#define XB_XSUB(j)  (1280 + 64 * (j))
#define XB_XGEN(j)  (2304 + 64 * (j))
#define XB_TOP      3328
#define XB_TOPGEN   3392
#define XCD_BAR_WORDS 3456
#define XB_SPIN_CAP (1u << 20)

__device__ __forceinline__ unsigned xb_ld(unsigned* p)              { return __hip_atomic_load(p, __ATOMIC_RELAXED, __HIP_MEMORY_SCOPE_AGENT); }
__device__ __forceinline__ unsigned xb_add(unsigned* p, unsigned v) { return __hip_atomic_fetch_add(p, v, __ATOMIC_RELAXED, __HIP_MEMORY_SCOPE_AGENT); }
__device__ __forceinline__ unsigned xb_xcc_id() { return (unsigned)__builtin_amdgcn_s_getreg((3 << 11) | 20) & 0xFu; }
#define XB_SPIN(cond, bar) do { unsigned _sp = 0; while (cond) { __builtin_amdgcn_s_sleep(1); \
    if ((++_sp & 255u) == 0u) { if (xb_ld(&(bar)[XB_TMO])) break; if (_sp > XB_SPIN_CAP) { atomicAdd(&(bar)[XB_TMO], 1u); break; } } } } while (0)

struct XcdBarrier { unsigned* bar; unsigned x; volatile LAS unsigned* st; };

__device__ __forceinline__ XcdBarrier xcd_barrier_post(unsigned* bar, volatile LAS unsigned* st) {
    XcdBarrier b; b.bar = bar; b.x = xb_xcc_id(); b.st = st;
    if (threadIdx.x == 0) (void)xb_add(&bar[XB_XCNT(b.x)], 1u);
    return b;
}
__device__ __forceinline__ void xcd_barrier_complete(unsigned* bar, unsigned x, unsigned& nloc, unsigned& nx) {
    const unsigned G = gridDim.x * gridDim.y * gridDim.z;
    unsigned sum, cnt, mine, sp = 0u;
    for (;;) {
        sum = 0u; cnt = 0u; mine = 0u;
#pragma unroll
        for (unsigned j = 0; j < 16; ++j) { const unsigned c = xb_ld(&bar[XB_XCNT(j)]); sum += c; cnt += (c > 0u) ? 1u : 0u; mine = (j == x) ? c : mine; }
        if (sum == G) break;
        __builtin_amdgcn_s_sleep(1);
        if ((++sp & 255u) == 0u) { if (xb_ld(&bar[XB_TMO])) break; if (sp > XB_SPIN_CAP) { atomicAdd(&bar[XB_TMO], 1u); break; } }
    }
    nloc = mine > 0u ? mine : 1u; nx = cnt > 0u ? cnt : 1u;
}
__device__ __forceinline__ void xcd_barrier(const XcdBarrier& b) {
    asm volatile("s_waitcnt vmcnt(0)" ::: "memory");
    __syncthreads();
    if (threadIdx.x == 0) {
        unsigned* bar = b.bar;
        __builtin_amdgcn_s_waitcnt(0);
        unsigned nloc = b.st[0], nx = b.st[1];
        if (nloc == 0u) { xcd_barrier_complete(bar, b.x, nloc, nx); b.st[0] = nloc; b.st[1] = nx; }
        const unsigned old = xb_add(&bar[XB_XSUB(b.x)], 1u);
        const unsigned gen = old / nloc;
        asm volatile("buffer_inv sc1" ::: "memory");
        if (old + 1u == (gen + 1u) * nloc) {
            __builtin_amdgcn_fence(__ATOMIC_RELEASE, "agent");
            asm volatile("s_waitcnt vmcnt(0)" ::: "memory");
            const unsigned og = xb_add(&bar[XB_TOP], 1u);
            const unsigned tg = og / nx;
            if (og + 1u == (tg + 1u) * nx) xb_add(&bar[XB_TOPGEN], 1u);
            else XB_SPIN(xb_ld(&bar[XB_TOPGEN]) == tg, bar);
            xb_add(&bar[XB_XGEN(b.x)], 1u);
            asm volatile("s_waitcnt vmcnt(0)" ::: "memory");
        } else {
            XB_SPIN(xb_ld(&bar[XB_XGEN(b.x)]) == gen, bar);
            asm volatile("s_waitcnt vmcnt(0)" ::: "memory");
        }
    }
    __syncthreads();
}

struct Args {
    const float* in[26];
    float* out;
    unsigned char* ws;
    int seg_lo, seg_hi;
    int nhalf, dup;
};
typedef const Args __attribute__((address_space(4)))* ArgsP;
__device__ __forceinline__ ArgsP launder(ArgsP p) { asm volatile("" : "+s"(p)); return p; }
enum { IN_X = 0, IN_C, IN_CTX, IN_CCTX, IN_WADA, IN_BADA, IN_WIN, IN_WPOOL, IN_PSCALE, IN_ARE, IN_AIM, IN_LOGDT, IN_BRE, IN_BIM, IN_CRE, IN_CIM, IN_SSMD, IN_WGLU, IN_WOUT,
       IN_GPREMIX, IN_GPOSTMIX, IN_GPREFFN, IN_GPOSTFFN, IN_WUP, IN_WCONV, IN_WDOWN };

__device__ __forceinline__ void p0_mod_item(ArgsP a, LAS unsigned char* lds, int item, int tid) {
    const int l = item / 48, n0 = (item % 48) * 256;
    LAS float* sS = (LAS float*)lds;
    const float* c = a->in[IN_C]; const float* cc = a->in[IN_CCTX];
    for (int idx = tid; idx < 9 * DM; idx += NTHREADS) { const int j = idx >> 11, k = idx & (DM - 1); const float v = (j < 8) ? c[j * DM + k] : cc[k]; sS[idx] = v * sigmoidf_(v); }
    __syncthreads();
    const int q = tid & 63, ks = tid >> 6;
    f32x4 acc[9];
#pragma unroll
    for (int j = 0; j < 9; ++j) acc[j] = (f32x4){0.f, 0.f, 0.f, 0.f};
    const float* wp = a->in[IN_WADA] + ((size_t)l * DM + (size_t)ks * 256) * (6 * DM) + n0 + 4 * q;
#pragma unroll 2
    for (int kk = 0; kk < 256; kk += 4) {
        const f32x4 w0 = *(const f32x4*)(wp + (size_t)(kk + 0) * (6 * DM)), w1 = *(const f32x4*)(wp + (size_t)(kk + 1) * (6 * DM));
        const f32x4 w2 = *(const f32x4*)(wp + (size_t)(kk + 2) * (6 * DM)), w3 = *(const f32x4*)(wp + (size_t)(kk + 3) * (6 * DM));
#pragma unroll
        for (int j = 0; j < 9; ++j) { const f32x4 sv = *(const LAS f32x4*)(sS + j * DM + ks * 256 + kk);
            acc[j] += sv.x * w0 + sv.y * w1 + sv.z * w2 + sv.w * w3; }
    }
    __syncthreads();
    LAS float* red = (LAS float*)lds;
#pragma unroll
    for (int j = 0; j < 9; ++j) *(LAS f32x4*)(red + (ks * 9 + j) * 256 + 4 * q) = acc[j];
    __syncthreads();
    float* MOD = (float*)(a->ws + WS_MOD);
    const float* bada = a->in[IN_BADA];
    for (int o = tid; o < 9 * 256; o += NTHREADS) { const int j = o >> 8, col = o & 255; float s = bada[l * 6 * DM + n0 + col];
#pragma unroll
        for (int k2 = 0; k2 < 8; ++k2) s += red[(k2 * 9 + j) * 256 + col];
        MOD[((size_t)l * 9 + j) * (6 * DM) + n0 + col] = s; }
    __syncthreads();
}
__device__ __forceinline__ void p0_s5_item(ArgsP a, int e, int tid) {
    if (tid >= 64) return;
    const int p = tid, ldg = e;
    const int gp = ldg * 64 + p;
    const float a_re = a->in[IN_ARE][gp], a_im = a->in[IN_AIM][gp], dt = expf(a->in[IN_LOGDT][ldg]);
    const float mag = expf(a_re * dt), lam_re = mag * cosf(a_im * dt), lam_im = mag * sinf(a_im * dt);
    const float denom = a_re * a_re + a_im * a_im, nr = lam_re - 1.0f, ni = lam_im;
    const float f_re = (nr * a_re + ni * a_im) / denom, f_im = (ni * a_re - nr * a_im) / denom;
    float* LAM = (float*)(a->ws + WS_LAM); bf16* BB = (bf16*)(a->ws + WS_BB); bf16* CM = (bf16*)(a->ws + WS_CM);
    LAM[gp * 2 + 0] = lam_re; LAM[gp * 2 + 1] = lam_im;
    const float* bre = a->in[IN_BRE] + (size_t)gp * 16; const float* bim = a->in[IN_BIM] + (size_t)gp * 16;
#pragma unroll
    for (int h = 0; h < 16; h += 2) {
        const float r0 = f_re * bre[h] - f_im * bim[h], i0 = f_re * bim[h] + f_im * bre[h];
        const float r1 = f_re * bre[h + 1] - f_im * bim[h + 1], i1 = f_re * bim[h + 1] + f_im * bre[h + 1];
        *(unsigned*)(BB + ((size_t)ldg * 128 + p) * 16 + h) = pk2(r0, r1);
        *(unsigned*)(BB + ((size_t)ldg * 128 + 64 + p) * 16 + h) = pk2(i0, i1);
    }
    const float* cre = a->in[IN_CRE] + (size_t)ldg * 16 * 64; const float* cim = a->in[IN_CIM] + (size_t)ldg * 16 * 64;
#pragma unroll
    for (int h = 0; h < 16; ++h) *(unsigned*)(CM + ((size_t)ldg * 16 + h) * 128 + 2 * p) = pk2(cre[h * 64 + p], -cim[h * 64 + p]);
}
__device__ __forceinline__ void p0_fold_tile(ArgsP a, int l, int wt, int lane) {
    const int nb = wt / 48, cbk = wt % 48, g = cbk / 12, c0 = (cbk % 12) * 32, n0 = nb * 32;
    const float* wout = a->in[IN_WOUT] + (size_t)l * DM * DM + (size_t)(g * PGRP) * DM + n0 + (lane & 31);
    const float* wpool = a->in[IN_WPOOL] + ((size_t)(l * 4 + g) * PGRP + c0 + (lane & 31)) * PGRP;
    const float* ps = a->in[IN_PSCALE] + l * POOLW + g * PGRP;
    f32x16 acc;
#pragma unroll
    for (int r = 0; r < 16; ++r) acc[r] = 0.f;
    const int h8 = 8 * (lane >> 5);
    for (int d0 = 0; d0 < PGRP; d0 += 16) {
        float av[8];
#pragma unroll
        for (int j = 0; j < 8; ++j) av[j] = wout[(size_t)(d0 + h8 + j) * DM] * ps[d0 + h8 + j];
        const f32x4 b0 = *(const f32x4*)(wpool + d0 + h8), b1 = *(const f32x4*)(wpool + d0 + h8 + 4);
        u32x4 aw, bw;
        aw.x = pk2(av[0], av[1]); aw.y = pk2(av[2], av[3]); aw.z = pk2(av[4], av[5]); aw.w = pk2(av[6], av[7]);
        bw.x = pk2(b0.x, b0.y); bw.y = pk2(b0.z, b0.w); bw.z = pk2(b1.x, b1.y); bw.w = pk2(b1.z, b1.w);
        acc = __builtin_amdgcn_mfma_f32_32x32x16_bf16(__builtin_bit_cast(bf16x8, aw), __builtin_bit_cast(bf16x8, bw), acc, 0, 0, 0);
    }
    asm volatile("s_nop 15\n\ts_nop 15\n\ts_nop 15\n\ts_nop 15" : "+v"(acc));
    bf16* WT = (bf16*)(a->ws + WS_WT) + (size_t)l * WT_LAYER + WT_COMB;
#pragma unroll
    for (int r = 0; r < 16; ++r) { const int n = n0 + (r & 3) + 8 * (r >> 2) + 4 * (lane >> 5);
        WT[(size_t)n * DM + g * PGRP + c0 + (lane & 31)] = (bf16)(pk2(acc[r], 0.f) & 0xffffu); }
}
__device__ __forceinline__ void p0_transpose_tile(const float* W, int N, bf16* WT, int ldt, int kdst, LAS float* scr, int kb, int nb, int lane) {
    const int k0 = 64 * kb, n0 = 32 * nb;
#pragma unroll 8
    for (int i = 0; i < 32; ++i) { const int kk = 2 * i + (lane >> 5); scr[kk * 33 + (lane & 31)] = __builtin_nontemporal_load(W + (size_t)(k0 + kk) * N + n0 + (lane & 31)); }
    asm volatile("s_waitcnt lgkmcnt(0)" ::: "memory");
    const int c = lane & 7;
#pragma unroll
    for (int j = 0; j < 4; ++j) { const int n = (lane >> 3) + 8 * j; const LAS float* s = scr + (8 * c) * 33 + n;
        u32x4 o; o.x = pk2(s[0 * 33], s[1 * 33]); o.y = pk2(s[2 * 33], s[3 * 33]); o.z = pk2(s[4 * 33], s[5 * 33]); o.w = pk2(s[6 * 33], s[7 * 33]);
        *(u32x4*)(WT + (size_t)(n0 + n) * ldt + kdst + k0 + 8 * c) = o; }
    asm volatile("s_waitcnt lgkmcnt(0)" ::: "memory");
}
constexpr int Q_MOD = 192, Q_S5 = 256, Q_FOLD = 4 * 384;
constexpr int TI_IN = 32 * 8, TI_OUTS = 8 * 8, TI_UP = 32 * 44, TI_DOWN = 88 * 8, TI_GLU = 8 * 2, TI_LAYER = TI_IN + TI_OUTS + TI_UP + TI_DOWN + TI_GLU;
constexpr int Q_TOTAL = Q_MOD + Q_S5 + Q_FOLD + 4 * TI_LAYER;
__device__ __forceinline__ void p0_transpose_item(ArgsP a, LAS unsigned char* lds, int it, int wave, int lane) {
    const int l = it / TI_LAYER; int r = it % TI_LAYER;
    LAS float* scr = (LAS float*)(lds + wave * 16384);
    bf16* WTL = (bf16*)(a->ws + WS_WT) + (size_t)l * WT_LAYER;
    if (r < TI_IN) { p0_transpose_tile(a->in[IN_WIN] + (size_t)l * DM * DM, DM, WTL + WT_IN, DM, 0, scr, r / 8, (r % 8) * 8 + wave, lane); return; } r -= TI_IN;
    if (r < TI_OUTS) { p0_transpose_tile(a->in[IN_WOUT] + (size_t)l * DM * DM + (size_t)POOLW * DM, DM, WTL + WT_COMB, DM, POOLW, scr, r / 8, (r % 8) * 8 + wave, lane); return; } r -= TI_OUTS;
    if (r < TI_UP) { p0_transpose_tile(a->in[IN_WUP] + (size_t)l * DM * DFF2, DFF2, WTL + WT_UP, DM, 0, scr, r / 44, (r % 44) * 8 + wave, lane); return; } r -= TI_UP;
    if (r < TI_DOWN) { p0_transpose_tile(a->in[IN_WDOWN] + (size_t)l * DFF * DM, DM, WTL + WT_DOWN, DFF, 0, scr, r / 8, (r % 8) * 8 + wave, lane); return; } r -= TI_DOWN;
    p0_transpose_tile(a->in[IN_WGLU] + (size_t)l * SSMW * SSMW, SSMW, WTL + WT_GLU, SSMW, 0, scr, r / 2, (r % 2) * 8 + wave, lane);
}
__device__ __forceinline__ void phase_prologue(ArgsP a, LAS unsigned char* lds, int tid, int wave, int lane) {
    unsigned* qhead = (unsigned*)(a->ws + WS_CTL) + CW_QUEUE;
    volatile LAS unsigned* slot = (volatile LAS unsigned*)(lds + MISC_OFF + 64);
    for (;;) {
        if (tid == 0) slot[0] = __hip_atomic_fetch_add(qhead, 1u, __ATOMIC_RELAXED, __HIP_MEMORY_SCOPE_AGENT);
        __syncthreads();
        const int it = (int)slot[0];
        __syncthreads();
        if (it >= Q_TOTAL) break;
        if (it < Q_MOD) { p0_mod_item(a, lds, it, tid); continue; }
        if (it < Q_MOD + Q_S5) { p0_s5_item(a, it - Q_MOD, tid); continue; }
        if (it < Q_MOD + Q_S5 + Q_FOLD) { const int f = it - Q_MOD - Q_S5; p0_fold_tile(a, f / 384, (f % 384) * 8 + wave, lane); continue; }
        p0_transpose_item(a, lds, it - Q_MOD - Q_S5 - Q_FOLD, wave, lane);
    }
}

struct NormP {
    const bf16* y; int y_row0;
    const float* xin_lat; const float* xin_ctx;
    bf16* xb;
    float* out_f32;
    bf16* h;
    const float* gate; const float* g_post;
    const float* g_pre; const float* shift; const float* scale;
};
__device__ __forceinline__ void phase_norm(const NormP& P, int r0, int r1, int gw, int ngw, int lane) {
    const int nrows = r1 - r0, per = (nrows + ngw - 1) / ngw;
    int m = r0 + gw * per; const int mend = (m + per < r1) ? m + per : r1;
    int curj = -1;
    f32x4 A1[8], A2[8], SH[8];
#pragma unroll
    for (int i = 0; i < 8; ++i) { A1[i] = (f32x4){0.f, 0.f, 0.f, 0.f}; A2[i] = A1[i]; SH[i] = A1[i]; }
    for (; m < mend; ++m) {
        const int j = (m < MLAT) ? (m >> 12) : 8;
        if (j != curj) { curj = j;
#pragma unroll
            for (int jj = 0; jj < 4; ++jj)
#pragma unroll
                for (int hh = 0; hh < 2; ++hh) { const int e = 512 * jj + 8 * lane + 4 * hh;
                    if (P.y) A1[jj * 2 + hh] = *(const f32x4*)(P.gate + (size_t)j * 6 * DM + e) * *(const f32x4*)(P.g_post + e);
                    if (P.h) { A2[jj * 2 + hh] = *(const f32x4*)(P.g_pre + e) * (*(const f32x4*)(P.scale + (size_t)j * 6 * DM + e) + 1.0f); SH[jj * 2 + hh] = *(const f32x4*)(P.shift + (size_t)j * 6 * DM + e); } }
        }
        f32x4 xv[8];
        if (P.xin_lat) {
            const float* xs = (m < MLAT) ? P.xin_lat + (size_t)m * DM : P.xin_ctx + (size_t)(m - MLAT) * DM;
#pragma unroll
            for (int jj = 0; jj < 4; ++jj) { xv[2 * jj] = __builtin_nontemporal_load((const f32x4*)(xs + 512 * jj + 8 * lane)); xv[2 * jj + 1] = __builtin_nontemporal_load((const f32x4*)(xs + 512 * jj + 8 * lane + 4)); }
        } else {
            const bf16* xs = P.xb + (size_t)m * DM;
#pragma unroll
            for (int jj = 0; jj < 4; ++jj) { const u32x4 w = __builtin_nontemporal_load((const u32x4*)(xs + 512 * jj + 8 * lane));
                xv[2 * jj] = (f32x4){bflo(w.x), bfhi(w.x), bflo(w.y), bfhi(w.y)}; xv[2 * jj + 1] = (f32x4){bflo(w.z), bfhi(w.z), bflo(w.w), bfhi(w.w)}; }
        }
        if (P.y) {
            const bf16* yr = P.y + (size_t)(m - P.y_row0) * DM;
            f32x4 yv[8]; float ss = 0.f;
#pragma unroll
            for (int jj = 0; jj < 4; ++jj) { const u32x4 w = __builtin_nontemporal_load((const u32x4*)(yr + 512 * jj + 8 * lane));
                yv[2 * jj] = (f32x4){bflo(w.x), bfhi(w.x), bflo(w.y), bfhi(w.y)}; yv[2 * jj + 1] = (f32x4){bflo(w.z), bfhi(w.z), bflo(w.w), bfhi(w.w)}; }
#pragma unroll
            for (int i = 0; i < 8; ++i) ss += (yv[i].x * yv[i].x + yv[i].y * yv[i].y) + (yv[i].z * yv[i].z + yv[i].w * yv[i].w);
            const float rstd = 1.0f / sqrtf(wave_sum(ss) * (1.0f / DM) + EPSN);
#pragma unroll
            for (int i = 0; i < 8; ++i) xv[i] += A1[i] * (yv[i] * rstd);
        }
        if (P.out_f32) {
            float* xd = P.out_f32 + (size_t)m * DM;
#pragma unroll
            for (int jj = 0; jj < 4; ++jj) { *(f32x4*)(xd + 512 * jj + 8 * lane) = xv[2 * jj]; *(f32x4*)(xd + 512 * jj + 8 * lane + 4) = xv[2 * jj + 1]; }
        } else {
            bf16* xd = P.xb + (size_t)m * DM;
#pragma unroll
            for (int jj = 0; jj < 4; ++jj) { u32x4 w; w.x = pk2(xv[2 * jj].x, xv[2 * jj].y); w.y = pk2(xv[2 * jj].z, xv[2 * jj].w); w.z = pk2(xv[2 * jj + 1].x, xv[2 * jj + 1].y); w.w = pk2(xv[2 * jj + 1].z, xv[2 * jj + 1].w);
                st16_wt(xd + 512 * jj + 8 * lane, w); }
        }
        if (P.h) {
            float ss = 0.f;
#pragma unroll
            for (int i = 0; i < 8; ++i) ss += (xv[i].x * xv[i].x + xv[i].y * xv[i].y) + (xv[i].z * xv[i].z + xv[i].w * xv[i].w);
            const float rstd = 1.0f / sqrtf(wave_sum(ss) * (1.0f / DM) + EPSN);
            bf16* hr = P.h + (size_t)m * DM;
#pragma unroll
            for (int jj = 0; jj < 4; ++jj) { const f32x4 o0 = xv[2 * jj] * rstd * A2[2 * jj] + SH[2 * jj], o1 = xv[2 * jj + 1] * rstd * A2[2 * jj + 1] + SH[2 * jj + 1];
                u32x4 w; w.x = pk2(o0.x, o0.y); w.y = pk2(o0.z, o0.w); w.z = pk2(o1.x, o1.y); w.w = pk2(o1.z, o1.w);
                st16_wt(hr + 512 * jj + 8 * lane, w); }
        }
    }
}

#define POOL_ACC(sgn, VV) do { const u32x4 q_ = (VV); s[0] sgn bflo(q_.x); s[1] sgn bfhi(q_.x); s[2] sgn bflo(q_.y); s[3] sgn bfhi(q_.y); s[4] sgn bflo(q_.z); s[5] sgn bfhi(q_.z); s[6] sgn bflo(q_.w); s[7] sgn bfhi(q_.w); } while (0)
template <int H> __device__ __forceinline__ void pool_batch(const bf16* u, bf16* PA, int m0, int ch0) {
    constexpr int NR = 7 + 2 * H;
    int base, t0, n;
    if (m0 < MLAT) { base = m0 & ~(SEQ - 1); t0 = m0 & (SEQ - 1); n = SEQ; } else { const int mm = m0 - MLAT; base = MLAT + (mm & ~(CTXL - 1)); t0 = mm & (CTXL - 1); n = CTXL; }
    u32x4 v[NR];
#pragma unroll
    for (int k = 0; k < NR; ++k) { const int tt = t0 - H + k; v[k] = (u32x4){0u, 0u, 0u, 0u}; if (tt >= 0 && tt < n) v[k] = *(const u32x4*)(u + (size_t)(base + tt) * DM + ch0); }
    float s[8];
#pragma unroll
    for (int e = 0; e < 8; ++e) s[e] = 0.f;
#pragma unroll
    for (int k = 0; k < 2 * H; ++k) POOL_ACC(+=, v[k]);
#pragma unroll
    for (int i = 0; i < 8; ++i) {
        if (i > 0) { POOL_ACC(+=, v[i + 2 * H - 1]); POOL_ACC(-=, v[i - 1]); }
        const int t = t0 + i, lo = (t - H > 0) ? t - H : 0, hi = (t + H < n) ? t + H : n;
        const float inv = 1.0f / (float)(hi - lo);
        const u32x4 c = v[H + i];
        u32x4 o; o.x = pk2(s[0] * inv - bflo(c.x), s[1] * inv - bfhi(c.x)); o.y = pk2(s[2] * inv - bflo(c.y), s[3] * inv - bfhi(c.y));
        o.z = pk2(s[4] * inv - bflo(c.z), s[5] * inv - bfhi(c.z)); o.w = pk2(s[6] * inv - bflo(c.w), s[7] * inv - bfhi(c.w));
        st16_wt(PA + (size_t)(m0 + i) * DM + ch0, o);
    }
}
__device__ __forceinline__ void pool_rows(const bf16* u, bf16* PA, int row0, int nbatch, int pw  , int lane) {
    if (lane >= 48) return;
    for (int it = pw; it < nbatch * 4; it += 4) {
        const int batch = it >> 2, grp = (it + batch) & 3, m0 = row0 + 8 * batch, ch0 = grp * PGRP + 8 * lane;
        if (grp == 0) pool_batch<1>(u, PA, m0, ch0); else if (grp == 1) pool_batch<2>(u, PA, m0, ch0); else if (grp == 2) pool_batch<4>(u, PA, m0, ch0); else pool_batch<8>(u, PA, m0, ch0);
    }
}
__device__ __forceinline__ int chain_row(int q, int dir, int b) {
    if (q < CTXL) { const int tt = dir ? (CTXL - 1 - q) : q; return MLAT + b * CTXL + tt; }
    const int qq = q - CTXL; const int tt = dir ? (SEQ - 1 - qq) : qq; return b * SEQ + tt;
}
constexpr int STASH_KCB = 528, STASH_BUFB = 16 * STASH_KCB;
__device__ __forceinline__ void ssm_chain(LAS unsigned char* stash, const bf16* u, bf16* Y, const float* LAM, const bf16* BB, const bf16* CM, int l, int b, int g, int dir, int lane) {
    const int ldg = (l * 2 + dir) * NGRP + g;
    const float lr = LAM[(ldg * 64 + lane) * 2], li = LAM[(ldg * 64 + lane) * 2 + 1];
    bf16x8 Bf[4], Cf[4];
#pragma unroll
    for (int cb = 0; cb < 4; ++cb) Bf[cb] = *(const bf16x8*)(BB + ((size_t)ldg * 128 + cb * 32 + (lane & 31)) * 16 + 8 * (lane >> 5));
#pragma unroll
    for (int ks = 0; ks < 4; ++ks) Cf[ks] = *(const bf16x8*)(CM + ((size_t)ldg * 16 + (lane & 15)) * 128 + 32 * ks + 8 * (lane >> 4));
    float hr = 0.f, hi = 0.f;
    const int ucol = POOLW + SGRP * g + 8 * (lane >> 5);
    const int sgn = dir ? -1 : 1;
    const int uoff = sgn * (lane & 31) * DM + ucol;
    const int yo0 = sgn * (lane & 15) * SSMW + SGRP * g + 4 * (lane >> 4), yo1 = yo0 + sgn * 16 * SSMW;
    const unsigned wad = (unsigned)(size_t)(stash + (lane >> 2) * STASH_KCB + (lane & 3) * 4);
    bf16x8 cur[8], nxt[8];
#pragma unroll
    for (int c = 0; c < 8; ++c) cur[c] = *(const bf16x8*)(u + (ptrdiff_t)chain_row(32 * c, dir, b) * DM + uoff);
    for (int sc = 0; sc < 17; ++sc) {
        if (sc + 1 < 17) {
#pragma unroll
            for (int c = 0; c < 8; ++c) nxt[c] = *(const bf16x8*)(u + (ptrdiff_t)chain_row(256 * (sc + 1) + 32 * c, dir, b) * DM + uoff);
        }
#pragma unroll
        for (int c = 0; c < 8; ++c) {
            const int q0 = 256 * sc + 32 * c;
            const LAS unsigned char* stp = stash + ((c & 1) ^ 1) * STASH_BUFB;
            bf16x8 a0[4], a1[4];
#pragma unroll
            for (int ks = 0; ks < 4; ++ks) {
                a0[ks] = *(const LAS bf16x8*)(stp + (4 * ks + (lane >> 4)) * STASH_KCB + (lane & 15) * 16);
                a1[ks] = *(const LAS bf16x8*)(stp + (4 * ks + (lane >> 4)) * STASH_KCB + (16 + (lane & 15)) * 16);
            }
            f32x16 z16;
#pragma unroll
            for (int r = 0; r < 16; ++r) z16[r] = 0.f;
            f32x16 D0 = __builtin_amdgcn_mfma_f32_32x32x16_bf16(cur[c], Bf[0], z16, 0, 0, 0);
            f32x16 D1 = __builtin_amdgcn_mfma_f32_32x32x16_bf16(cur[c], Bf[1], z16, 0, 0, 0);
            f32x16 D2 = __builtin_amdgcn_mfma_f32_32x32x16_bf16(cur[c], Bf[2], z16, 0, 0, 0);
            f32x16 D3 = __builtin_amdgcn_mfma_f32_32x32x16_bf16(cur[c], Bf[3], z16, 0, 0, 0);
            f32x4 acc0 = (f32x4){0.f, 0.f, 0.f, 0.f}, acc1 = acc0;
            asm volatile("" : "+v"(D0), "+v"(D1), "+v"(D2), "+v"(D3), "+v"(acc0), "+v"(acc1) :: "memory");
#pragma unroll
            for (int ks = 0; ks < 4; ++ks) {
                acc0 = __builtin_amdgcn_mfma_f32_16x16x32_bf16(Cf[ks], a0[ks], acc0, 0, 0, 0);
                acc1 = __builtin_amdgcn_mfma_f32_16x16x32_bf16(Cf[ks], a1[ks], acc1, 0, 0, 0);
            }
            asm volatile("s_waitcnt lgkmcnt(0)\n\ts_nop 15\n\ts_nop 15" : "+v"(acc0), "+v"(acc1) :: "memory");
            if (q0 > 0) {
                bf16* yb = Y + (ptrdiff_t)chain_row(q0 - 32, dir, b) * SSMW;
                u32x2 w0, w1; w0.x = pk2(acc0[0], acc0[1]); w0.y = pk2(acc0[2], acc0[3]); w1.x = pk2(acc1[0], acc1[1]); w1.y = pk2(acc1[2], acc1[3]);
                *(u32x2*)(yb + yo0) = w0;
                *(u32x2*)(yb + yo1) = w1;
            }
            asm volatile("s_nop 3" : "+v"(D0), "+v"(D1), "+v"(D2), "+v"(D3));
            float bre[32], bim[32];
#pragma unroll
            for (int r = 0; r < 16; ++r) { const int p0 = (r & 3) + 8 * (r >> 2);
                auto rr = __builtin_amdgcn_permlane32_swap(__float_as_uint(D0[r]), __float_as_uint(D1[r]), false, false);
                bre[p0] = __uint_as_float(rr[0]); bre[p0 + 4] = __uint_as_float(rr[1]);
                auto ri = __builtin_amdgcn_permlane32_swap(__float_as_uint(D2[r]), __float_as_uint(D3[r]), false, false);
                bim[p0] = __uint_as_float(ri[0]); bim[p0 + 4] = __uint_as_float(ri[1]); }
#pragma unroll
            for (int pos = 0; pos < 32; pos += 2) {
                const float nr = fmaf(-li, hi, fmaf(lr, hr, bre[pos]));
                const float ni = fmaf(li, hr, fmaf(lr, hi, bim[pos]));
                const unsigned p0 = pk2(nr, ni);
                hr = fmaf(-li, ni, fmaf(lr, nr, bre[pos + 1]));
                hi = fmaf(li, nr, fmaf(lr, ni, bim[pos + 1]));
                const unsigned p1 = pk2(hr, hi);
                asm volatile("ds_write2_b32 %0, %1, %2 offset0:%3 offset1:%4" :: "v"(wad + (unsigned)((c & 1) * STASH_BUFB)), "v"(p0), "v"(p1), "n"(4 * pos), "n"(4 * pos + 4) : "memory");
            }
        }
#pragma unroll
        for (int c = 0; c < 8; ++c) cur[c] = nxt[c];
    }
    {
        const LAS unsigned char* stp = stash + 1 * STASH_BUFB;
        asm volatile("s_waitcnt lgkmcnt(0)" ::: "memory");
        f32x4 acc0 = (f32x4){0.f, 0.f, 0.f, 0.f}, acc1 = acc0;
#pragma unroll
        for (int ks = 0; ks < 4; ++ks) {
            const bf16x8 a0 = *(const LAS bf16x8*)(stp + (4 * ks + (lane >> 4)) * STASH_KCB + (lane & 15) * 16);
            const bf16x8 a1 = *(const LAS bf16x8*)(stp + (4 * ks + (lane >> 4)) * STASH_KCB + (16 + (lane & 15)) * 16);
            acc0 = __builtin_amdgcn_mfma_f32_16x16x32_bf16(Cf[ks], a0, acc0, 0, 0, 0);
            acc1 = __builtin_amdgcn_mfma_f32_16x16x32_bf16(Cf[ks], a1, acc1, 0, 0, 0);
        }
        asm volatile("s_waitcnt lgkmcnt(0)\n\ts_nop 15\n\ts_nop 15" : "+v"(acc0), "+v"(acc1) :: "memory");
        bf16* yb = Y + (ptrdiff_t)chain_row(256 * 16 + 32 * 7, dir, b) * SSMW;
        u32x2 w0, w1; w0.x = pk2(acc0[0], acc0[1]); w0.y = pk2(acc0[2], acc0[3]); w1.x = pk2(acc1[0], acc1[1]); w1.y = pk2(acc1[2], acc1[3]);
        *(u32x2*)(yb + yo0) = w0;
        *(u32x2*)(yb + yo1) = w1;
    }
}
__device__ __forceinline__ void phase_mix_a(ArgsP a, LAS unsigned char* lds, int l, int mrows, int wave, int lane, int tid) {
    const bf16* u = (const bf16*)(a->ws + WS_BUFB);
    if (wave < 2) {
        const int bx = blockIdx.x, xcd = bx & 7, jj = bx >> 3;
        for (int it = jj; it < 32; it += (int)(gridDim.x >> 3)) {
            const int g = 4 * xcd + (it & 3), b = it >> 2;
            bf16* Y = (bf16*)(a->ws + WS_BUFA) + (size_t)wave * MALL * SSMW;
            ssm_chain(lds + wave * 32768, u, Y, (const float*)(a->ws + WS_LAM), (const bf16*)(a->ws + WS_BB), (const bf16*)(a->ws + WS_CM), l, b, g, wave, lane);
        }
    } else if (wave != 4 && wave != 5) {
        const int per = mrows / 256;
        for (int wgi = blockIdx.x; wgi < 256; wgi += gridDim.x) pool_rows(u, (bf16*)(a->ws + WS_BUFC), wgi * per, per / 8, (wave < 4) ? wave - 2 : wave - 4, lane);
    }
}

__device__ __forceinline__ float gelu_tanh(float x) { const float z = 0.7978845608028654f * (x + 0.044715f * x * x * x); return x * sigmoidf_(2.0f * z); }
__device__ __forceinline__ int glu_lds_off(int row, int chunk) { return row * 1024 + ((chunk ^ (row & 15)) << 4); }
__device__ __forceinline__ void phase_mix_b(ArgsP a, LAS unsigned char* lds, int l, int mrows, int tid, int wave, int lane) {
    const bf16* Y0 = (const bf16*)(a->ws + WS_BUFA); const bf16* Y1 = Y0 + (size_t)MALL * SSMW;
    const bf16* u = (const bf16*)(a->ws + WS_BUFB);
    const float* Dv = a->in[IN_SSMD] + l * SSMW;
    const bf16* Wg = (const bf16*)(a->ws + WS_WT) + (size_t)l * WT_LAYER + WT_GLU;
    bf16* PA = (bf16*)(a->ws + WS_BUFC);
    const int RPW = mrows / 256;
    for (int wgi = blockIdx.x; wgi < 256; wgi += gridDim.x) {
        const int row0 = wgi * RPW;
        {
            const int c = lane, k0 = 8 * c;
            const f32x4 d0 = *(const f32x4*)(Dv + k0), d1 = *(const f32x4*)(Dv + k0 + 4);
            const int NI = RPW / 8;
#pragma unroll 1
            for (int ib = 0; ib < NI; ib += 9) {
                u32x4 y0w[9], y1w[9], uw[9];
#pragma unroll
                for (int i = 0; i < 9; ++i) { int ii = ib + i; ii = ii < NI ? ii : NI - 1; const size_t mr = (size_t)(row0 + wave + 8 * ii);
                    y0w[i] = __builtin_nontemporal_load((const u32x4*)(Y0 + mr * SSMW + k0)); y1w[i] = __builtin_nontemporal_load((const u32x4*)(Y1 + mr * SSMW + k0)); uw[i] = *(const u32x4*)(u + mr * DM + POOLW + k0); }
#pragma unroll
                for (int i = 0; i < 9; ++i) {
                    if (ib + i < NI) {
                        const int r = wave + 8 * (ib + i);
                        const f32x4 y00 = (f32x4){bflo(y0w[i].x), bfhi(y0w[i].x), bflo(y0w[i].y), bfhi(y0w[i].y)}, y01 = (f32x4){bflo(y0w[i].z), bfhi(y0w[i].z), bflo(y0w[i].w), bfhi(y0w[i].w)};
                        const f32x4 y10 = (f32x4){bflo(y1w[i].x), bfhi(y1w[i].x), bflo(y1w[i].y), bfhi(y1w[i].y)}, y11 = (f32x4){bflo(y1w[i].z), bfhi(y1w[i].z), bflo(y1w[i].w), bfhi(y1w[i].w)};
                        const f32x4 u0 = (f32x4){bflo(uw[i].x), bfhi(uw[i].x), bflo(uw[i].y), bfhi(uw[i].y)}, u1 = (f32x4){bflo(uw[i].z), bfhi(uw[i].z), bflo(uw[i].w), bfhi(uw[i].w)};
                        const f32x4 v0 = y00 + y10 + d0 * u0, v1 = y01 + y11 + d1 * u1;
                        u32x4 w; w.x = pk2(gelu_tanh(v0.x), gelu_tanh(v0.y)); w.y = pk2(gelu_tanh(v0.z), gelu_tanh(v0.w)); w.z = pk2(gelu_tanh(v1.x), gelu_tanh(v1.y)); w.w = pk2(gelu_tanh(v1.z), gelu_tanh(v1.w));
                        *(LAS u32x4*)(lds + glu_lds_off(r, c)) = w;
                    }
                }
            }
        }
        __syncthreads();
#pragma unroll 1
        for (int mh = 0; mh < 2; ++mh) {
            const int fr = lane & 15, kq = lane >> 4, nbase = 64 * wave, mb0 = 5 * mh;
            f32x4 acc[5][4];
#pragma unroll
            for (int mb = 0; mb < 5; ++mb)
#pragma unroll
                for (int nb = 0; nb < 4; ++nb) acc[mb][nb] = (f32x4){0.f, 0.f, 0.f, 0.f};
            const bf16* wrow = Wg + (size_t)(nbase + 16 * (fr >> 2) + (fr & 3)) * SSMW + 8 * kq;
            bf16x8 W[4][4];
#pragma unroll
            for (int j = 0; j < 4; ++j)
#pragma unroll
                for (int nb = 0; nb < 4; ++nb) W[j][nb] = *(const bf16x8*)(wrow + (size_t)(4 * nb) * SSMW + 32 * j);
#pragma unroll 1
            for (int kg = 0; kg < 4; ++kg) {
#pragma unroll
                for (int j = 0; j < 4; ++j) {
                    const int ks = 4 * kg + j;
#pragma unroll
                    for (int mb = 0; mb < 5; ++mb) {
                        if (mb < 4 || mh == 0) {
                            int rr = 16 * (mb0 + mb) + fr; rr = rr < RPW ? rr : RPW - 1;
                            const bf16x8 af = *(const LAS bf16x8*)(lds + glu_lds_off(rr, 4 * ks + kq));
#pragma unroll
                            for (int nb = 0; nb < 4; ++nb) acc[mb][nb] = __builtin_amdgcn_mfma_f32_16x16x32_bf16(W[j][nb], af, acc[mb][nb], 0, 0, 0);
                        }
                    }
                    if (kg < 3) {
#pragma unroll
                        for (int nb = 0; nb < 4; ++nb) W[j][nb] = *(const bf16x8*)(wrow + (size_t)(4 * nb) * SSMW + 32 * (ks + 4));
                    }
                }
            }
#pragma unroll
            for (int mb = 0; mb < 5; ++mb) {
                const int tok = 16 * (mb0 + mb) + fr;
                if (tok < RPW) {
                    const int n = nbase + 16 * kq;
#pragma unroll
                    for (int hh = 0; hh < 2; ++hh) {
                        const u32x4 yw = *(const LAS u32x4*)(lds + glu_lds_off(tok, (n >> 3) + hh));
                        const f32x4 g0 = acc[mb][2 * hh], g1 = acc[mb][2 * hh + 1];
                        u32x4 o; o.x = pk2(bflo(yw.x) * sigmoidf_(g0.x), bfhi(yw.x) * sigmoidf_(g0.y)); o.y = pk2(bflo(yw.y) * sigmoidf_(g0.z), bfhi(yw.y) * sigmoidf_(g0.w));
                        o.z = pk2(bflo(yw.z) * sigmoidf_(g1.x), bfhi(yw.z) * sigmoidf_(g1.y)); o.w = pk2(bflo(yw.w) * sigmoidf_(g1.z), bfhi(yw.w) * sigmoidf_(g1.w));
                        *(u32x4*)(PA + (size_t)(row0 + tok) * DM + POOLW + n + 8 * hh) = o;
                    }
                }
            }
        }
        __syncthreads();
    }
}

struct ConvF { f32x4 v[3], g[3]; };
constexpr int CV_ROWB = 1024, CV_COLB = 10 * CV_ROWB, CV_PAIRB = 2 * CV_COLB, CV_DEPTH = 6;
__device__ __forceinline__ void conv_wg_item(LAS unsigned char* lds, const bf16* z  , bf16* aout  , const float* wc, int mloc0, int mglob0, int cg, int wave, int lane) {
    const bool ctx = mglob0 >= MLAT;
    const int gr0 = (mglob0 >> 6) & 63;
    const int f0c = cg * 256, f0 = f0c + 4 * lane;
    f32x4 wv[3][3], wg[3][3];
#pragma unroll
    for (int i = 0; i < 3; ++i)
#pragma unroll
        for (int j = 0; j < 3; ++j) { wv[i][j] = *(const f32x4*)(wc + (size_t)(i * 3 + j) * DFF2 + f0); wg[i][j] = *(const f32x4*)(wc + (size_t)(i * 3 + j) * DFF2 + DFF + f0); }
    asm volatile("s_waitcnt vmcnt(0)" : "+v"(wv[0][0]), "+v"(wv[0][1]), "+v"(wv[0][2]), "+v"(wv[1][0]), "+v"(wv[1][1]), "+v"(wv[1][2]), "+v"(wv[2][0]), "+v"(wv[2][1]), "+v"(wv[2][2]),
                 "+v"(wg[0][0]), "+v"(wg[0][1]), "+v"(wg[0][2]), "+v"(wg[1][0]), "+v"(wg[1][1]), "+v"(wg[1][2]), "+v"(wg[2][0]), "+v"(wg[2][1]), "+v"(wg[2][2]) :: "memory");
    const int mrun = mglob0 + 64 * wave;
    bool up, down, left, right;
    if (!ctx) { const int gr = (mrun >> 6) & 63; up = gr > 0; down = gr < 63; left = false; right = false; }
    else { const int seg = ((mrun - MLAT) >> 6) & 3; up = false; down = false; left = seg > 0; right = seg < 3; }
    bf16* ao = aout + (size_t)(mloc0 + 64 * wave) * DFF + f0;
    const int lane_off = (lane < 32) ? (f0c + 8 * lane) : (DFF + f0c + 8 * (lane - 32));
#define CV_DMA(hr, k, p, kc) do { int jj_ = (hr) - 1; bool rv_; \
        if (!ctx) { rv_ = (jj_ >= 0 && jj_ < 8) || (jj_ < 0 && gr0 > 0) || (jj_ == 8 && gr0 + 8 < 64); } else { rv_ = (jj_ >= 0 && jj_ < 8); } \
        if (!rv_) jj_ = jj_ < 0 ? 0 : 7; \
        int kk_ = (k); bool cv_ = (kk_ >= 0 && kk_ < GRIDW); \
        if (!cv_ && ctx && rv_) { const int sg_ = ((mglob0 + 64 * jj_ - MLAT) >> 6) & 3; cv_ = (kk_ < 0) ? (sg_ > 0) : (sg_ < 3); } \
        if (!cv_) kk_ = kk_ < 0 ? 0 : GRIDW - 1; \
        const bf16* src_ = z + (size_t)(mloc0 + 64 * jj_ + kk_) * DFF2 + lane_off; \
        __builtin_amdgcn_global_load_lds((const unsigned*)src_, (LAS unsigned*)(lds + ((p) % CV_DEPTH) * CV_PAIRB + (kc) * CV_COLB + (hr) * CV_ROWB), 16, 0, 2); } while (0)
#define CV_DMA_PAIR(p) do { const int pp_ = (p) > 32 ? 32 : (p);   \
        CV_DMA(wave, 2 * pp_ - 1, p, 0); CV_DMA(wave, 2 * pp_, p, 1); \
        if (wave < 2) { CV_DMA(8 + wave, 2 * pp_ - 1, p, 0); CV_DMA(8 + wave, 2 * pp_, p, 1); } } while (0)
#define CV_F4(w2) ((f32x4){bflo((w2).x), bfhi((w2).x), bflo((w2).y), bfhi((w2).y)})
    const f32x4 zero4 = (f32x4){0.f, 0.f, 0.f, 0.f};
#define CV_CVT(slot, p, kc, k) do { const bool cok_ = ((k) >= 0 && (k) < GRIDW) || ((k) < 0 && left) || ((k) >= GRIDW && right); \
        LAS const unsigned char* b_ = lds + ((p) % CV_DEPTH) * CV_PAIRB + (kc) * CV_COLB + wave * CV_ROWB + 8 * lane; \
        _Pragma("unroll") for (int i_ = 0; i_ < 3; ++i_) { const bool ok_ = cok_ && (i_ == 1 || (i_ == 0 && up) || (i_ == 2 && down)); \
            if (ok_) { const u32x2 a_ = *(LAS const u32x2*)(b_ + i_ * CV_ROWB), g_ = *(LAS const u32x2*)(b_ + i_ * CV_ROWB + 512); F[slot].v[i_] = CV_F4(a_); F[slot].g[i_] = CV_F4(g_); } \
            else { F[slot].v[i_] = zero4; F[slot].g[i_] = zero4; } } } while (0)
#define CV_OUT(c, sm, s0, sp) do { f32x4 ov = wv[0][0] * F[sm].v[0], og = wg[0][0] * F[sm].g[0]; \
        ov += wv[1][0] * F[sm].v[1]; og += wg[1][0] * F[sm].g[1]; ov += wv[2][0] * F[sm].v[2]; og += wg[2][0] * F[sm].g[2]; \
        _Pragma("unroll") for (int i_ = 0; i_ < 3; ++i_) { ov += wv[i_][1] * F[s0].v[i_]; og += wg[i_][1] * F[s0].g[i_]; ov += wv[i_][2] * F[sp].v[i_]; og += wg[i_][2] * F[sp].g[i_]; } \
        const f32x4 o_ = ov * og * (f32x4){sigmoidf_(og.x), sigmoidf_(og.y), sigmoidf_(og.z), sigmoidf_(og.w)}; \
        u32x2 w_; w_.x = pk2(o_.x, o_.y); w_.y = pk2(o_.z, o_.w); st8_wt(ao + (size_t)(c) * DFF, w_); } while (0)
#define CV_ARRIVE(p, EXACT) do { if (EXACT) { if (wave < 2) asm volatile("s_waitcnt vmcnt(26)" ::: "memory"); else asm volatile("s_waitcnt vmcnt(18)" ::: "memory"); } \
        else { if (wave < 2) asm volatile("s_waitcnt vmcnt(16)" ::: "memory"); else asm volatile("s_waitcnt vmcnt(8)" ::: "memory"); } \
        asm volatile("s_waitcnt lgkmcnt(0)" ::: "memory"); __builtin_amdgcn_s_barrier(); asm volatile("" ::: "memory"); CV_DMA_PAIR((p) + 5); } while (0)
    ConvF F[4];
    CV_DMA_PAIR(0); CV_DMA_PAIR(1); CV_DMA_PAIR(2); CV_DMA_PAIR(3); CV_DMA_PAIR(4);
    CV_ARRIVE(0, false); CV_CVT(0, 0, 0, -1); CV_CVT(1, 0, 1, 0);
#pragma unroll 1
    for (int q = 0; q < 16; ++q) {
        const int po = 2 * q + 1, pe = 2 * q + 2;
        const bool ex = q >= 3;
        CV_ARRIVE(po, ex); CV_CVT(2, po, 0, 2 * po - 1); CV_CVT(3, po, 1, 2 * po);
        CV_OUT(2 * po - 2, 0, 1, 2); CV_OUT(2 * po - 1, 1, 2, 3);
        CV_ARRIVE(pe, ex); CV_CVT(0, pe, 0, 2 * pe - 1); CV_CVT(1, pe, 1, 2 * pe);
        CV_OUT(2 * pe - 2, 2, 3, 0); CV_OUT(2 * pe - 1, 3, 0, 1);
    }
    asm volatile("s_waitcnt vmcnt(0) lgkmcnt(0)" ::: "memory"); __builtin_amdgcn_s_barrier(); asm volatile("" ::: "memory");
#undef CV_DMA
#undef CV_DMA_PAIR
#undef CV_F4
#undef CV_CVT
#undef CV_OUT
#undef CV_ARRIVE
}
__device__ __forceinline__ void phase_conv(ArgsP a, LAS unsigned char* lds, int l, int r0, int r1, const bf16* z, bf16* aout, int wave, int lane) {
    const float* wc = a->in[IN_WCONV] + (size_t)l * 9 * DFF2;
    const int nitems = ((r1 - r0) / (GRIDW * 8)) * 22;
    for (int it = blockIdx.x; it < nitems; it += gridDim.x) {
        const int rb = it / 22, cg = it % 22;
        conv_wg_item(lds, z, aout, wc, rb * 8 * GRIDW, r0 + rb * 8 * GRIDW, cg, wave, lane);
    }
}

constexpr int PH_PER_LAYER = 13;
constexpr int PH_TOTAL = 2 + DEPTH * PH_PER_LAYER;
constexpr int NORM_WGS = 64;

__global__ void __launch_bounds__(NTHREADS, 2) mk_fwd(Args args) {
    extern __shared__ __attribute__((aligned(16))) unsigned char lds_raw[];
    LAS unsigned char* lds = (LAS unsigned char*)lds_raw;
    const ArgsP kp = (ArgsP)__builtin_amdgcn_kernarg_segment_ptr();
    (void)args;
    volatile LAS unsigned* MISC = (volatile LAS unsigned*)(lds + MISC_OFF);
    if (threadIdx.x < 64) MISC[threadIdx.x] = 0u;
    __syncthreads();
    const int lo = kp->seg_lo, hi = kp->seg_hi;
    XcdBarrier bar; bar.bar = (unsigned*)(kp->ws + WS_CTL) + CW_BAR; bar.x = 0; bar.st = MISC + 8;
    if (hi - lo > 1) bar = xcd_barrier_post((unsigned*)(kp->ws + WS_CTL) + CW_BAR, MISC + 8);
#ifndef PHEN
#define PHEN 0xffff
#endif
#define IN(k) (lo <= (k) && (k) < hi)
#define SEAM(k) do { if ((k) + 1 < hi) xcd_barrier(bar); } while (0)
#define REP(bit) for (int rep_ = 0, nrep_ = ((kp->dup & (bit)) ? 2 : 1); rep_ < nrep_; ++rep_)
#define TIDV int tid_ = threadIdx.x; asm volatile("" : "+v"(tid_)); const int tid = tid_, lane = tid & 63, wave = __builtin_amdgcn_readfirstlane(tid >> 6); const int G = gridDim.x, gw = blockIdx.x * NWAVES + wave, ngw = G * NWAVES; (void)lane; (void)gw; (void)ngw; (void)G

    if ((PHEN & 1) && IN(0)) { TIDV; phase_prologue(launder(kp), lds, tid, wave, lane); SEAM(0); }
    if ((PHEN & 2) && IN(1)) {
        TIDV; const ArgsP a = launder(kp); float* MOD = (float*)(a->ws + WS_MOD);
        NormP P; P.y = nullptr; P.y_row0 = 0; P.xin_lat = a->in[IN_X]; P.xin_ctx = a->in[IN_CTX]; P.xb = (bf16*)(a->ws + WS_XB); P.out_f32 = nullptr; P.h = (bf16*)(a->ws + WS_BUFA);
        P.gate = nullptr; P.g_post = nullptr; P.g_pre = a->in[IN_GPREMIX]; P.shift = MOD + 0 * DM; P.scale = MOD + 1 * DM;
        phase_norm(P, 0, MALL, gw, ngw, lane);
        SEAM(1);
    }
    for (int l = 0; l < DEPTH; ++l) {
        const int pb = 2 + l * PH_PER_LAYER;
        if (pb + PH_PER_LAYER <= lo || pb >= hi) continue;
        const int mrows = (l == DEPTH - 1) ? MLAT : MALL;
        if ((PHEN & 4) && IN(pb + 0)) {
            const ArgsP a = launder(kp); const pg8::bf16_t* WTL = (const pg8::bf16_t*)(a->ws + WS_WT) + (size_t)l * WT_LAYER;
            pg8::Gemm g{(const bf16*)(a->ws + WS_BUFA), WTL + WT_IN, MALL, DM, DM}; pg8::StaticOrder S; S.init(MALL, DM, (int)gridDim.x, (int)blockIdx.x);
            pg8::EpiBf16 E{(bf16*)(a->ws + WS_BUFB), DM};
            REP(4) pg8::gemm_phase<pg8::EpiBf16, pg8::StaticOrder, true, true>(lds, g, S, E);
            SEAM(pb + 0);
        }
        if ((PHEN & 8) && IN(pb + 1)) { TIDV; REP(8) phase_mix_a(launder(kp), lds, l, mrows, wave, lane, tid); SEAM(pb + 1); }
        if ((PHEN & 16) && IN(pb + 2)) { TIDV; REP(16) phase_mix_b(launder(kp), lds, l, mrows, tid, wave, lane); SEAM(pb + 2); }
        if ((PHEN & 32) && IN(pb + 3)) {
            const ArgsP a = launder(kp); const pg8::bf16_t* WTL = (const pg8::bf16_t*)(a->ws + WS_WT) + (size_t)l * WT_LAYER;
            pg8::Gemm g{(const bf16*)(a->ws + WS_BUFC), WTL + WT_COMB, mrows, DM, DM}; pg8::StaticOrder S; S.init(mrows, DM, (int)gridDim.x, (int)blockIdx.x);
            pg8::EpiBf16 E{(bf16*)(a->ws + WS_BUFB), DM};
            REP(4) pg8::gemm_phase<pg8::EpiBf16, pg8::StaticOrder, true, true>(lds, g, S, E);
            SEAM(pb + 3);
        }
        if ((PHEN & 64) && IN(pb + 4)) {
            TIDV; const ArgsP a = launder(kp); const float* MODL = (const float*)(a->ws + WS_MOD) + (size_t)l * 9 * 6 * DM;
            NormP P; P.y = (const bf16*)(a->ws + WS_BUFB); P.y_row0 = 0; P.xin_lat = nullptr; P.xin_ctx = nullptr; P.xb = (bf16*)(a->ws + WS_XB); P.out_f32 = nullptr; P.h = (bf16*)(a->ws + WS_BUFA);
            P.gate = MODL + 2 * DM; P.g_post = a->in[IN_GPOSTMIX] + l * DM; P.g_pre = a->in[IN_GPREFFN] + l * DM; P.shift = MODL + 3 * DM; P.scale = MODL + 4 * DM;
            phase_norm(P, 0, mrows, gw, ngw, lane);
            SEAM(pb + 4);
        }
        for (int hf = 0; hf < 2; ++hf) {
            const int nhalf = kp->nhalf;
            if (hf >= nhalf) break;
            const int r0 = (nhalf == 1) ? 0 : (hf == 0 ? 0 : HALF1_ROW0), r1 = (nhalf == 1) ? mrows : (hf == 0 ? HALF1_ROW0 : mrows);
            const int ph = pb + 5 + 4 * hf;
            const size_t a_off = (nhalf == 1) ? WS_BUFA : WS_BUFB, f_off = (nhalf == 1) ? WS_Z : (hf == 0 ? WS_BUFB + A_HALF : WS_Z);
            const bool pair_norm0 = (nhalf == 2 && l < DEPTH - 1);
            if ((PHEN & 128) && IN(ph + 0)) {
                const ArgsP a = launder(kp); const pg8::bf16_t* WTL = (const pg8::bf16_t*)(a->ws + WS_WT) + (size_t)l * WT_LAYER;
                pg8::Gemm g{(const bf16*)(a->ws + WS_BUFA) + (size_t)r0 * DM, WTL + WT_UP, r1 - r0, DFF2, DM}; pg8::StaticOrder S; S.init(r1 - r0, DFF2, (int)gridDim.x, (int)blockIdx.x);
                pg8::EpiBf16 E{(bf16*)(a->ws + WS_Z), DFF2};
                REP(4) pg8::gemm_phase<pg8::EpiBf16, pg8::StaticOrder, true, true>(lds, g, S, E);
                SEAM(ph + 0);
            }
            if ((PHEN & 256) && IN(ph + 1)) { TIDV; const ArgsP a = launder(kp); REP(256) phase_conv(a, lds, l, r0, r1, (const bf16*)(a->ws + WS_Z), (bf16*)(a->ws + a_off), wave, lane); SEAM(ph + 1); }
            if ((PHEN & 512) && IN(ph + 2)) {
                const bool paired = pair_norm0 && hf == 1;
                const int gG = paired ? (int)gridDim.x - NORM_WGS : (int)gridDim.x;
                if ((int)blockIdx.x < gG) {
                    const ArgsP a = launder(kp); const pg8::bf16_t* WTL = (const pg8::bf16_t*)(a->ws + WS_WT) + (size_t)l * WT_LAYER;
                    pg8::Gemm g{(const bf16*)(a->ws + a_off), WTL + WT_DOWN, r1 - r0, DM, DFF}; pg8::StaticOrder S; S.init(r1 - r0, DM, gG, (int)blockIdx.x);
                    pg8::EpiBf16 E{(bf16*)(a->ws + f_off), DM};
                    REP(4) pg8::gemm_phase<pg8::EpiBf16, pg8::StaticOrder, true, true>(lds, g, S, E);
                } else {
                    TIDV; const ArgsP a = launder(kp);
                    const float* MODL = (const float*)(a->ws + WS_MOD) + (size_t)l * 9 * 6 * DM; const float* MODN = MODL + 9 * 6 * DM;
                    NormP P; P.y = (const bf16*)(a->ws + WS_BUFB + A_HALF); P.y_row0 = 0; P.xin_lat = nullptr; P.xin_ctx = nullptr; P.xb = (bf16*)(a->ws + WS_XB); P.out_f32 = nullptr;
                    P.h = (bf16*)(a->ws + WS_BUFA);
                    P.gate = MODL + 5 * DM; P.g_post = a->in[IN_GPOSTFFN] + l * DM;
                    P.g_pre = a->in[IN_GPREMIX] + (l + 1) * DM; P.shift = MODN + 0 * DM; P.scale = MODN + 1 * DM;
                    phase_norm(P, 0, HALF1_ROW0, ((int)blockIdx.x - gG) * NWAVES + wave, NORM_WGS * NWAVES, lane);
                }
                SEAM(ph + 2);
            }
            if ((PHEN & 1024) && IN(ph + 3) && !(pair_norm0 && hf == 0)) {
                TIDV; const ArgsP a = launder(kp); const bool lastl = (l == DEPTH - 1);
                const float* MODL = (const float*)(a->ws + WS_MOD) + (size_t)l * 9 * 6 * DM; const float* MODN = MODL + (lastl ? 0 : 9 * 6 * DM);
                NormP P; P.y = (const bf16*)(a->ws + f_off); P.y_row0 = r0; P.xin_lat = nullptr; P.xin_ctx = nullptr; P.xb = (bf16*)(a->ws + WS_XB); P.out_f32 = lastl ? a->out : nullptr;
                P.h = lastl ? nullptr : (bf16*)(a->ws + WS_BUFA);
                P.gate = MODL + 5 * DM; P.g_post = a->in[IN_GPOSTFFN] + l * DM;
                P.g_pre = a->in[IN_GPREMIX] + (lastl ? l : l + 1) * DM; P.shift = MODN + 0 * DM; P.scale = MODN + 1 * DM;
                phase_norm(P, r0, r1, gw, ngw, lane);
                SEAM(ph + 3);
            }
        }
    }
#undef IN
#undef SEAM
#undef TIDV
}

extern "C" void kernel_launch(void* const* d_in, const int* in_sizes, int n_in, void* d_out, int out_size, void* d_ws, size_t ws_size, hipStream_t stream) {
    static int grid = 0;
    if (grid == 0) {
        if (n_in != 26 || out_size != MLAT * DM || ws_size < WS_NEED_HALF) { fprintf(stderr, "kernel_launch: unexpected problem shape / workspace (n_in %d, out %d, ws %zu, need %zu)\n", n_in, out_size, ws_size, (size_t)WS_NEED_HALF); grid = -1; return; }
        int dev = 0, cus = 0, per_cu = 0;
        if (hipGetDevice(&dev) != hipSuccess || hipDeviceGetAttribute(&cus, hipDeviceAttributeMultiprocessorCount, dev) != hipSuccess) { grid = -1; return; }
        if (hipFuncSetAttribute((const void*)mk_fwd, hipFuncAttributeMaxDynamicSharedMemorySize, LDS_BYTES) != hipSuccess) { fprintf(stderr, "kernel_launch: hipFuncSetAttribute failed\n"); grid = -1; return; }
        if (hipOccupancyMaxActiveBlocksPerMultiprocessor(&per_cu, (const void*)mk_fwd, NTHREADS, LDS_BYTES) != hipSuccess || per_cu < 1)
            fprintf(stderr, "kernel_launch: note: occupancy query reports %d workgroups per CU\n", per_cu);
        (void)hipGetLastError();
        grid = cus;
        if (grid != 256) fprintf(stderr, "kernel_launch: note: %d CUs (built for 256)\n", grid);
    }
    if (grid < 0) return;
    if (hipMemsetAsync((char*)d_ws + WS_CTL, 0, CTL_BYTES, stream) != hipSuccess) { fprintf(stderr, "kernel_launch: memset failed\n"); return; }
    Args a{};
    for (int i = 0; i < 26; ++i) a.in[i] = (const float*)d_in[i];
    a.out = (float*)d_out; a.ws = (unsigned char*)d_ws;
    a.nhalf = 2;
    a.dup = MK_DUP;
#if MK_MULTI_LAUNCH
    for (int ph = 0; ph < PH_TOTAL; ++ph) {
        if (ph >= 2) { const int k = (ph - 2) % PH_PER_LAYER, ll = (ph - 2) / PH_PER_LAYER; if (a.nhalf == 1 && k >= 9) continue; if (a.nhalf == 2 && k == 8 && ll < DEPTH - 1) continue; }
        a.seg_lo = ph; a.seg_hi = ph + 1;
        hipLaunchKernelGGL(mk_fwd, dim3(grid), dim3(NTHREADS), LDS_BYTES, stream, a);
    }
#else
    a.seg_lo = 0; a.seg_hi = PH_TOTAL;
    hipLaunchKernelGGL(mk_fwd, dim3(grid), dim3(NTHREADS), LDS_BYTES, stream, a);
#endif
    const hipError_t le = hipPeekAtLastError();
    if (le != hipSuccess) fprintf(stderr, "kernel_launch: launch failed: %s\n", hipGetErrorName(le));
}
```

```cpp
#include <hip/hip_runtime.h>
#include <cstdio>
#include <cstdint>

#ifndef MK_DUP
#define MK_DUP 0
#endif
#ifndef MK_MULTI_LAUNCH
#define MK_MULTI_LAUNCH 0
#endif

namespace pg8 {
#define PG8_LAS __attribute__((address_space(3)))
typedef unsigned short bf16_t;
typedef short bf16x8 __attribute__((ext_vector_type(8)));
typedef float f32x4 __attribute__((ext_vector_type(4)));
typedef unsigned u32x4 __attribute__((ext_vector_type(4)));
constexpr int BM = 256, BK = 64, HALF = 128, HTB = HALF * BK * 2, STAGE_BYTES = 8 * HTB, NXCD = 8, WGM = 8;

__host__ __device__ __forceinline__ int lds_byte(int r, int c) { const int st = (r >> 4) * 2 + (c >> 5), rr = r & 15, cc = c & 31, ob = rr * 64 + cc * 2; return st * 1024 + (ob ^ (((ob >> 9) & 1) << 5)); }
__host__ __device__ __forceinline__ void stage_rc(int b, int& R, int& C) { const int st = b / 1024, sb = b % 1024, swz = sb ^ (((sb >> 9) & 1) << 5); R = (st >> 1) * 16 + swz / 64; C = (st & 1) * 32 + (swz % 64) / 2; }
__host__ __device__ __forceinline__ int perm32(int rho) { const int n = rho >> 4, i = rho & 15; return 8 * (i >> 2) + 4 * n + (i & 3); }

struct Unit { int pm, pn; };
struct Gemm { const bf16_t* A; const bf16_t* Bt; int M, N, K; };

struct StaticOrder {
    int nM, nN, nwg, G, c;
    __host__ __device__ void init(int M, int N, int G_, int c_) { nM = M / BM; nN = N / BM; nwg = nM * nN; G = G_; c = c_; }
    __host__ __device__ bool next(int i, Unit& u) const {
        const long L = (long)i * G + c; if (L >= nwg) return false;
        int wgid = (int)L; { const int q = nwg / NXCD, r = nwg % NXCD, xcd = wgid % NXCD, off = wgid / NXCD; wgid = (xcd < r ? xcd * (q + 1) : r * (q + 1) + (xcd - r) * q) + off; }
        const int nig = WGM * nN, gid = wgid / nig, fm = gid * WGM, gsz = (nM - fm) < WGM ? (nM - fm) : WGM;
        u.pm = fm + ((wgid % nig) % gsz); u.pn = (wgid % nig) / gsz; return true;
    }
    __device__ __forceinline__ void a_ready(const Unit&) const {}
    __device__ __forceinline__ void done(const Unit&) const {}
};

__device__ __forceinline__ unsigned cvt_pk_bf16(float lo, float hi) { unsigned r; asm volatile("v_cvt_pk_bf16_f32 %0, %1, %2" : "=v"(r) : "v"(lo), "v"(hi)); return r; }

struct EpiBf16 {
    static constexpr bool PERM = true, AFTER_DRAIN = false;
    bf16_t* O; int ldc;
    __device__ __forceinline__ void operator()(const f32x4 (&acc)[2][2][4][2], const Unit& u, int wr, int wc, int fr, int fq, bool last) const {
        const int row0 = u.pm * BM + wr * 64 + fr; const int col0 = u.pn * BM + wc * 32 + 8 * fq;
#pragma unroll
        for (int ai = 0; ai < 2; ++ai)
#pragma unroll
            for (int m = 0; m < 4; ++m) { bf16_t* rowp = O + (size_t)(row0 + ai * HALF + m * 16) * ldc + col0;
#pragma unroll
                for (int bj = 0; bj < 2; ++bj) { const f32x4 v0 = acc[ai][bj][m][0], v1 = acc[ai][bj][m][1];
                    u32x4 w; w.x = cvt_pk_bf16(v0[0], v0[1]); w.y = cvt_pk_bf16(v0[2], v0[3]); w.z = cvt_pk_bf16(v1[0], v1[1]); w.w = cvt_pk_bf16(v1[2], v1[3]);
                    if (last) asm volatile("global_store_dwordx4 %0, %1, off sc1\n\ts_nop 1" :: "v"(rowp + bj * HALF), "v"(w) : "memory"); else *(u32x4*)(rowp + bj * HALF) = w; } }
    }
};

template <class Epi, class Sched, bool ALIGN_EPI = false, bool SP2 = false>
__device__ __forceinline__ void gemm_phase(PG8_LAS unsigned char* lds, const Gemm g, const Sched& S, const Epi& E) {
    int tid_ = threadIdx.x; asm volatile("" : "+v"(tid_));
    const int tid = tid_, wid = __builtin_amdgcn_readfirstlane(tid >> 6), lane = tid & 63, wr = wid >> 2, wc = wid & 3, fr = lane & 15, fq = lane >> 4;
    const int K = g.K, nt = K / BK;
    unsigned voffA[2], voffB[2];
#pragma unroll
    for (int i = 0; i < 2; ++i) { int R, C; stage_rc(tid * 16 + i * 8192, R, C); const int Rb = Epi::PERM ? ((R & ~31) + perm32(R & 31)) : R;
        voffA[i] = (unsigned)(R * K + C) * 2u; voffB[i] = (unsigned)(Rb * K + C) * 2u; }
    const size_t kstep = (size_t)(BK * 2);
    const size_t hstep = (size_t)HALF * K * 2;
    const size_t tstep = 2 * hstep;
    const unsigned ldsw = (unsigned)wid * 1024u;
    const int aoff = lds_byte(wr * 64 + fr, fq * 8), boff = lds_byte(wc * 32 + fr, fq * 8);
#define PG8_SA(b, h) (((b) * 2 + (h)) * HTB)
#define PG8_SB(b, h) ((4 + (b) * 2 + (h)) * HTB)
#define PG8_STAGE(bufoff, gbase, voff) do { _Pragma("unroll") for (int _i = 0; _i < 2; ++_i) \
        __builtin_amdgcn_global_load_lds((const unsigned*)((const char*)(gbase) + (voff)[_i]), (PG8_LAS unsigned*)(lds + (bufoff) + ldsw + _i * 8192), 16, 0, 0); } while (0)
#define PG8_LDA(dst, b, h) do { _Pragma("unroll") for (int m = 0; m < 4; ++m) _Pragma("unroll") for (int k = 0; k < 2; ++k) dst[m][k] = *(const PG8_LAS bf16x8*)(lds + PG8_SA(b, h) + aoff + m * 2048 + k * 1024); } while (0)
#define PG8_LDB(dst, b, h) do { _Pragma("unroll") for (int n = 0; n < 2; ++n) _Pragma("unroll") for (int k = 0; k < 2; ++k) dst[n][k] = *(const PG8_LAS bf16x8*)(lds + PG8_SB(b, h) + boff + n * 2048 + k * 1024); } while (0)
#define PG8_MMA(ai, bj, At, Bt) do { __builtin_amdgcn_s_setprio(1); _Pragma("unroll") for (int m = 0; m < 4; ++m) _Pragma("unroll") for (int n = 0; n < 2; ++n) _Pragma("unroll") for (int k = 0; k < 2; ++k) \
        acc[ai][bj][m][n] = __builtin_amdgcn_mfma_f32_16x16x32_bf16(Bt[n][k], At[m][k], acc[ai][bj][m][n], 0, 0, 0); __builtin_amdgcn_s_setprio(0); } while (0)
#define PG8_WAIT_V(n) asm volatile("s_waitcnt vmcnt(" #n ")" ::: "memory")
#define PG8_WAIT_L(n) asm volatile("s_waitcnt lgkmcnt(" #n ")" ::: "memory")
#define PG8_BAR __builtin_amdgcn_s_barrier()
#define PG8_SCHED __builtin_amdgcn_sched_barrier(0)
    Unit cur, nxt; int ui = 0;
    if (!S.next(0, cur)) return;
    f32x4 acc[2][2][4][2];
#pragma unroll
    for (int a = 0; a < 2; ++a)
#pragma unroll
        for (int b = 0; b < 2; ++b)
#pragma unroll
            for (int m = 0; m < 4; ++m)
#pragma unroll
                for (int n = 0; n < 2; ++n) acc[a][b][m][n] = (f32x4){0.f, 0.f, 0.f, 0.f};
    bf16x8 At[4][2], B0[2][2], B1[2][2];
    const char* cA = (const char*)g.A + (size_t)cur.pm * tstep; const char* cB = (const char*)g.Bt + (size_t)cur.pn * tstep;
    S.a_ready(cur);
    if constexpr (SP2) {
        PG8_STAGE(PG8_SB(0, 0), cB, voffB); PG8_STAGE(PG8_SB(0, 1), cB + hstep, voffB); PG8_STAGE(PG8_SA(0, 0), cA, voffA); PG8_STAGE(PG8_SA(0, 1), cA + hstep, voffA);
        if (wr == 1) PG8_BAR;
        PG8_WAIT_V(2); PG8_BAR;
        PG8_STAGE(PG8_SB(1, 0), cB + kstep, voffB); PG8_STAGE(PG8_SA(1, 0), cA + kstep, voffA); PG8_STAGE(PG8_SB(1, 1), cB + hstep + kstep, voffB);
        PG8_WAIT_V(6); PG8_BAR;
    } else {
        PG8_STAGE(PG8_SB(0, 0), cB, voffB); PG8_STAGE(PG8_SA(0, 0), cA, voffA); PG8_STAGE(PG8_SB(0, 1), cB + hstep, voffB); PG8_STAGE(PG8_SA(0, 1), cA + hstep, voffA);
        if (wr == 1) PG8_BAR;
        PG8_WAIT_V(4); PG8_BAR;
        PG8_STAGE(PG8_SB(1, 0), cB + kstep, voffB); PG8_STAGE(PG8_SA(1, 0), cA + kstep, voffA); PG8_STAGE(PG8_SB(1, 1), cB + hstep + kstep, voffB);
        PG8_WAIT_V(6); PG8_BAR;
    }
    for (;;) {
        const bool has_next = S.next(ui + 1, nxt);
        const char* nA = has_next ? (const char*)g.A + (size_t)nxt.pm * tstep : cA; const char* nB = has_next ? (const char*)g.Bt + (size_t)nxt.pn * tstep : cB;
        for (int t = 0; t < nt; t += 2) {
            const bool last = (t == nt - 2);
            const char* a1 = cA + (size_t)(t + 1) * kstep;
            const char* a2 = last ? nA : cA + (size_t)(t + 2) * kstep; const char* b2 = last ? nB : cB + (size_t)(t + 2) * kstep;
            const char* a3 = a2 + kstep; const char* b3 = b2 + kstep;
            if (last && has_next) S.a_ready(nxt);
            if constexpr (SP2) {
            PG8_LDB(B0, 0, 0); PG8_LDB(B1, 0, 1); PG8_SCHED; PG8_LDA(At, 0, 0); PG8_STAGE(PG8_SA(1, 1), a1 + hstep, voffA);
            PG8_WAIT_V(8); PG8_WAIT_L(0); PG8_BAR; PG8_MMA(0, 0, At, B0); PG8_MMA(0, 1, At, B1); PG8_BAR; PG8_SCHED;
            PG8_LDA(At, 0, 1); PG8_STAGE(PG8_SB(0, 0), b2, voffB); PG8_STAGE(PG8_SB(0, 1), b2 + hstep, voffB); PG8_STAGE(PG8_SA(0, 0), a2, voffA);
            PG8_WAIT_V(8); PG8_WAIT_L(0); PG8_BAR; PG8_MMA(1, 0, At, B0); PG8_MMA(1, 1, At, B1); PG8_BAR; PG8_SCHED;
            PG8_LDB(B0, 1, 0); PG8_LDB(B1, 1, 1); PG8_SCHED; PG8_LDA(At, 1, 0); PG8_STAGE(PG8_SA(0, 1), a2 + hstep, voffA);
            PG8_WAIT_V(8); PG8_WAIT_L(0); PG8_BAR; PG8_MMA(0, 0, At, B0); PG8_MMA(0, 1, At, B1); PG8_BAR; PG8_SCHED;
            PG8_LDA(At, 1, 1); PG8_STAGE(PG8_SB(1, 0), b3, voffB); PG8_STAGE(PG8_SB(1, 1), b3 + hstep, voffB); PG8_STAGE(PG8_SA(1, 0), a3, voffA);
            PG8_WAIT_V(8); PG8_WAIT_L(0); PG8_BAR; PG8_MMA(1, 0, At, B0); PG8_MMA(1, 1, At, B1); PG8_BAR; PG8_SCHED;
            } else {
            PG8_LDB(B0, 0, 0); PG8_SCHED; PG8_LDA(At, 0, 0); PG8_STAGE(PG8_SA(1, 1), a1 + hstep, voffA);
            PG8_WAIT_L(8); PG8_BAR; PG8_WAIT_L(0); PG8_MMA(0, 0, At, B0); PG8_BAR; PG8_SCHED;
            PG8_LDB(B1, 0, 1); PG8_STAGE(PG8_SB(0, 0), b2, voffB);
            PG8_BAR; PG8_WAIT_L(0); PG8_MMA(0, 1, At, B1); PG8_BAR;
            PG8_LDA(At, 0, 1); PG8_STAGE(PG8_SA(0, 0), a2, voffA);
            PG8_BAR; PG8_WAIT_L(0); PG8_MMA(1, 0, At, B0); PG8_BAR; PG8_SCHED;
            PG8_STAGE(PG8_SB(0, 1), b2 + hstep, voffB);
            PG8_WAIT_V(6); PG8_BAR; PG8_MMA(1, 1, At, B1); PG8_BAR;
            PG8_LDB(B0, 1, 0); PG8_SCHED; PG8_LDA(At, 1, 0); PG8_STAGE(PG8_SA(0, 1), a2 + hstep, voffA);
            PG8_WAIT_L(8); PG8_BAR; PG8_WAIT_L(0); PG8_MMA(0, 0, At, B0); PG8_BAR; PG8_SCHED;
            PG8_LDB(B1, 1, 1); PG8_STAGE(PG8_SB(1, 0), b3, voffB);
            PG8_BAR; PG8_WAIT_L(0); PG8_MMA(0, 1, At, B1); PG8_BAR;
            PG8_LDA(At, 1, 1); PG8_STAGE(PG8_SA(1, 0), a3, voffA);
            PG8_BAR; PG8_WAIT_L(0); PG8_MMA(1, 0, At, B0); PG8_BAR; PG8_SCHED;
            PG8_STAGE(PG8_SB(1, 1), b3 + hstep, voffB);
            PG8_WAIT_V(6); PG8_BAR; PG8_MMA(1, 1, At, B1); PG8_BAR;
            }
        }
        if constexpr (ALIGN_EPI) { if (wr == 0) PG8_BAR; }
        if constexpr (!Epi::AFTER_DRAIN) { E(acc, cur, wr, wc, fr, fq, !has_next); S.done(cur); }
        if (!has_next) break;
#pragma unroll
        for (int a = 0; a < 2; ++a)
#pragma unroll
            for (int b = 0; b < 2; ++b)
#pragma unroll
                for (int m = 0; m < 4; ++m)
#pragma unroll
                    for (int n = 0; n < 2; ++n) acc[a][b][m][n] = (f32x4){0.f, 0.f, 0.f, 0.f};
        cur = nxt; cA = nA; cB = nB; ++ui;
        if constexpr (ALIGN_EPI) { if (wr == 1) PG8_BAR; }
    }
    PG8_WAIT_V(0);
    if constexpr (!ALIGN_EPI) { if (wr == 0) PG8_BAR; }
    PG8_BAR;
#undef PG8_SA
#undef PG8_SB
#undef PG8_STAGE
#undef PG8_LDA
#undef PG8_LDB
#undef PG8_MMA
#undef PG8_WAIT_V
#undef PG8_WAIT_L
#undef PG8_BAR
#undef PG8_SCHED
}
}

constexpr int DM = 2048, NBATCH = 8, SEQ = 4096, DEPTH = 4, CTXL = 256, GRIDW = 64;
constexpr int MLAT = NBATCH * SEQ, MCTX = NBATCH * CTXL, MALL = MLAT + MCTX;
constexpr int POOLW = 1536, SSMW = 512, NGRP = 32, SGRP = 16, NSTATE = 64, PGRP = 384;
constexpr int DFF = 5632, DFF2 = 11264;
constexpr float EPSN = 1e-6f;
constexpr int NWAVES = 8, NTHREADS = 512;

constexpr size_t MiB = 1u << 20;
constexpr size_t WS_CTL = 0, CTL_BYTES = 1 * MiB;
constexpr size_t WS_MOD = 1 * MiB;
constexpr size_t WS_LAM = 3 * MiB;
constexpr size_t WS_BB = 4 * MiB;
constexpr size_t WS_CM = 6 * MiB;
constexpr size_t WS_WT = 8 * MiB;
constexpr size_t WT_IN = 0, WT_COMB = (size_t)DM * DM, WT_UP = 2 * (size_t)DM * DM, WT_DOWN = WT_UP + (size_t)DFF2 * DM, WT_GLU = WT_DOWN + (size_t)DM * DFF, WT_LAYER = WT_GLU + (size_t)SSMW * SSMW;
constexpr size_t WS_XB = WS_WT + 4 * WT_LAYER * 2;
constexpr size_t WS_BUFA = WS_XB + (size_t)MALL * DM * 2;
constexpr size_t BUF_BYTES = (size_t)MALL * DM * 2;
constexpr size_t WS_BUFB = WS_BUFA + BUF_BYTES, WS_BUFC = WS_BUFB + BUF_BYTES, WS_Z = WS_BUFC + BUF_BYTES;
constexpr int HALF1_ROW0 = 4 * SEQ;
constexpr size_t Z_FULL = (size_t)MALL * DFF2 * 2, Z_HALF = (size_t)(MALL - HALF1_ROW0) * DFF2 * 2;
constexpr size_t A_HALF = (size_t)(MALL - HALF1_ROW0) * DFF * 2;
constexpr size_t WS_NEED_FULL = WS_Z + Z_FULL, WS_NEED_HALF = WS_Z + Z_HALF;
static_assert(A_HALF + (size_t)(MALL - HALF1_ROW0) * DM * 2 <= 2 * BUF_BYTES, "half-mode a + f fit in bufB|bufC");
static_assert((size_t)MALL * DFF * 2 <= 3 * BUF_BYTES, "full-mode a fits in bufA|bufB|bufC");
static_assert(WS_XB % 256 == 0 && WS_BUFA % 256 == 0 && WS_Z % 256 == 0, "alignment");
constexpr int CW_QUEUE = 64;
constexpr int CW_BAR = 4096;

constexpr int SCRATCH_BYTES = 139264;
constexpr int MISC_OFF = SCRATCH_BYTES;
constexpr int LDS_BYTES = 147456;

#define LAS __attribute__((address_space(3)))
typedef unsigned short bf16;
typedef short bf16x8 __attribute__((ext_vector_type(8)));
typedef float f32x4 __attribute__((ext_vector_type(4)));
typedef float f32x16 __attribute__((ext_vector_type(16)));
typedef unsigned u32x4 __attribute__((ext_vector_type(4)));
typedef unsigned u32x2 __attribute__((ext_vector_type(2)));

__device__ __forceinline__ float bf2f(unsigned short b) { return __uint_as_float(((unsigned)b) << 16); }
__device__ __forceinline__ float bflo(unsigned w) { return __uint_as_float(w << 16); }
__device__ __forceinline__ float bfhi(unsigned w) { return __uint_as_float(w & 0xffff0000u); }
__device__ __forceinline__ unsigned pk2(float lo, float hi) { return pg8::cvt_pk_bf16(lo, hi); }
__device__ __forceinline__ float wave_sum(float v) {
#pragma unroll
    for (int o = 1; o < 64; o <<= 1) v += __shfl_xor(v, o);
    return v;
}
__device__ __forceinline__ void st16_wt(void* p, u32x4 v) { asm volatile("global_store_dwordx4 %0, %1, off sc1\n\ts_nop 1" :: "v"(p), "v"(v) : "memory"); }
__device__ __forceinline__ void st8_wt(void* p, u32x2 v) { asm volatile("global_store_dwordx2 %0, %1, off sc1\n\ts_nop 1" :: "v"(p), "v"(v) : "memory"); }
__device__ __forceinline__ float sigmoidf_(float t) { return __builtin_amdgcn_rcpf(1.0f + __builtin_amdgcn_exp2f(-1.4426950408889634f * t)); }

#define XB_TMO      128
#define XB_XCNT(j)  (256  + 64 * (j))
#define XB_XSUB(j)  (1280 + 64 * (j))
#define XB_XGEN(j)  (2304 + 64 * (j))
#define XB_TOP      3328
#define XB_TOPGEN   3392
#define XCD_BAR_WORDS 3456
#define XB_SPIN_CAP (1u << 20)

__device__ __forceinline__ unsigned xb_ld(unsigned* p)              { return __hip_atomic_load(p, __ATOMIC_RELAXED, __HIP_MEMORY_SCOPE_AGENT); }
__device__ __forceinline__ unsigned xb_add(unsigned* p, unsigned v) { return __hip_atomic_fetch_add(p, v, __ATOMIC_RELAXED, __HIP_MEMORY_SCOPE_AGENT); }
__device__ __forceinline__ unsigned xb_xcc_id() { return (unsigned)__builtin_amdgcn_s_getreg((3 << 11) | 20) & 0xFu; }
#define XB_SPIN(cond, bar) do { unsigned _sp = 0; while (cond) { __builtin_amdgcn_s_sleep(1); \
    if ((++_sp & 255u) == 0u) { if (xb_ld(&(bar)[XB_TMO])) break; if (_sp > XB_SPIN_CAP) { atomicAdd(&(bar)[XB_TMO], 1u); break; } } } } while (0)

struct XcdBarrier { unsigned* bar; unsigned x; volatile LAS unsigned* st; };

__device__ __forceinline__ XcdBarrier xcd_barrier_post(unsigned* bar, volatile LAS unsigned* st) {
    XcdBarrier b; b.bar = bar; b.x = xb_xcc_id(); b.st = st;
    if (threadIdx.x == 0) (void)xb_add(&bar[XB_XCNT(b.x)], 1u);
    return b;
}
__device__ __forceinline__ void xcd_barrier_complete(unsigned* bar, unsigned x, unsigned& nloc, unsigned& nx) {
    const unsigned G = gridDim.x * gridDim.y * gridDim.z;
    unsigned sum, cnt, mine, sp = 0u;
    for (;;) {
        sum = 0u; cnt = 0u; mine = 0u;
#pragma unroll
        for (unsigned j = 0; j < 16; ++j) { const unsigned c = xb_ld(&bar[XB_XCNT(j)]); sum += c; cnt += (c > 0u) ? 1u : 0u; mine = (j == x) ? c : mine; }
        if (sum == G) break;
        __builtin_amdgcn_s_sleep(1);
        if ((++sp & 255u) == 0u) { if (xb_ld(&bar[XB_TMO])) break; if (sp > XB_SPIN_CAP) { atomicAdd(&bar[XB_TMO], 1u); break; } }
    }
    nloc = mine > 0u ? mine : 1u; nx = cnt > 0u ? cnt : 1u;
}
__device__ __forceinline__ void xcd_barrier(const XcdBarrier& b, bool wb = true) {
    asm volatile("s_waitcnt vmcnt(0)" ::: "memory");
    __syncthreads();
    if (threadIdx.x == 0) {
        unsigned* bar = b.bar;
        __builtin_amdgcn_s_waitcnt(0);
        unsigned nloc = b.st[0], nx = b.st[1];
        if (nloc == 0u) { xcd_barrier_complete(bar, b.x, nloc, nx); b.st[0] = nloc; b.st[1] = nx; }
        const unsigned old = xb_add(&bar[XB_XSUB(b.x)], 1u);
        const unsigned gen = old / nloc;
        asm volatile("buffer_inv sc1" ::: "memory");
        if (old + 1u == (gen + 1u) * nloc) {
            if (wb) __builtin_amdgcn_fence(__ATOMIC_RELEASE, "agent");
            asm volatile("s_waitcnt vmcnt(0)" ::: "memory");
            const unsigned og = xb_add(&bar[XB_TOP], 1u);
            const unsigned tg = og / nx;
            if (og + 1u == (tg + 1u) * nx) xb_add(&bar[XB_TOPGEN], 1u);
            else XB_SPIN(xb_ld(&bar[XB_TOPGEN]) == tg, bar);
            xb_add(&bar[XB_XGEN(b.x)], 1u);
            asm volatile("s_waitcnt vmcnt(0)" ::: "memory");
        } else {
            XB_SPIN(xb_ld(&bar[XB_XGEN(b.x)]) == gen, bar);
            asm volatile("s_waitcnt vmcnt(0)" ::: "memory");
        }
    }
    __syncthreads();
}

struct Args {
    const float* in[26];
    float* out;
    unsigned char* ws;
    int seg_lo, seg_hi;
    int nhalf, dup;
};
typedef const Args __attribute__((address_space(4)))* ArgsP;
__device__ __forceinline__ ArgsP launder(ArgsP p) { asm volatile("" : "+s"(p)); return p; }
enum { IN_X = 0, IN_C, IN_CTX, IN_CCTX, IN_WADA, IN_BADA, IN_WIN, IN_WPOOL, IN_PSCALE, IN_ARE, IN_AIM, IN_LOGDT, IN_BRE, IN_BIM, IN_CRE, IN_CIM, IN_SSMD, IN_WGLU, IN_WOUT,
       IN_GPREMIX, IN_GPOSTMIX, IN_GPREFFN, IN_GPOSTFFN, IN_WUP, IN_WCONV, IN_WDOWN };

__device__ __forceinline__ void p0_mod_item(ArgsP a, LAS unsigned char* lds, int item, int tid) {
    const int l = item / 48, n0 = (item % 48) * 256;
    LAS float* sS = (LAS float*)lds;
    const float* c = a->in[IN_C]; const float* cc = a->in[IN_CCTX];
    for (int idx = tid; idx < 9 * DM; idx += NTHREADS) { const int j = idx >> 11, k = idx & (DM - 1); const float v = (j < 8) ? c[j * DM + k] : cc[k]; sS[idx] = v * sigmoidf_(v); }
    __syncthreads();
    const int q = tid & 63, ks = tid >> 6;
    f32x4 acc[9];
#pragma unroll
    for (int j = 0; j < 9; ++j) acc[j] = (f32x4){0.f, 0.f, 0.f, 0.f};
    const float* wp = a->in[IN_WADA] + ((size_t)l * DM + (size_t)ks * 256) * (6 * DM) + n0 + 4 * q;
#pragma unroll 2
    for (int kk = 0; kk < 256; kk += 4) {
        const f32x4 w0 = *(const f32x4*)(wp + (size_t)(kk + 0) * (6 * DM)), w1 = *(const f32x4*)(wp + (size_t)(kk + 1) * (6 * DM));
        const f32x4 w2 = *(const f32x4*)(wp + (size_t)(kk + 2) * (6 * DM)), w3 = *(const f32x4*)(wp + (size_t)(kk + 3) * (6 * DM));
#pragma unroll
        for (int j = 0; j < 9; ++j) { const f32x4 sv = *(const LAS f32x4*)(sS + j * DM + ks * 256 + kk);
            acc[j] += sv.x * w0 + sv.y * w1 + sv.z * w2 + sv.w * w3; }
    }
    __syncthreads();
    LAS float* red = (LAS float*)lds;
#pragma unroll
    for (int j = 0; j < 9; ++j) *(LAS f32x4*)(red + (ks * 9 + j) * 256 + 4 * q) = acc[j];
    __syncthreads();
    float* MOD = (float*)(a->ws + WS_MOD);
    const float* bada = a->in[IN_BADA];
    for (int o = tid; o < 9 * 256; o += NTHREADS) { const int j = o >> 8, col = o & 255; float s = bada[l * 6 * DM + n0 + col];
#pragma unroll
        for (int k2 = 0; k2 < 8; ++k2) s += red[(k2 * 9 + j) * 256 + col];
        MOD[((size_t)l * 9 + j) * (6 * DM) + n0 + col] = s; }
    __syncthreads();
}
__device__ __forceinline__ void p0_s5_item(ArgsP a, int e, int tid) {
    if (tid >= 64) return;
    const int p = tid, ldg = e;
    const int gp = ldg * 64 + p;
    const float a_re = a->in[IN_ARE][gp], a_im = a->in[IN_AIM][gp], dt = expf(a->in[IN_LOGDT][ldg]);
    const float mag = expf(a_re * dt), lam_re = mag * cosf(a_im * dt), lam_im = mag * sinf(a_im * dt);
    const float denom = a_re * a_re + a_im * a_im, nr = lam_re - 1.0f, ni = lam_im;
    const float f_re = (nr * a_re + ni * a_im) / denom, f_im = (ni * a_re - nr * a_im) / denom;
    float* LAM = (float*)(a->ws + WS_LAM); bf16* BB = (bf16*)(a->ws + WS_BB); bf16* CM = (bf16*)(a->ws + WS_CM);
    LAM[gp * 2 + 0] = lam_re; LAM[gp * 2 + 1] = lam_im;
    const float* bre = a->in[IN_BRE] + (size_t)gp * 16; const float* bim = a->in[IN_BIM] + (size_t)gp * 16;
#pragma unroll
    for (int h = 0; h < 16; h += 2) {
        const float r0 = f_re * bre[h] - f_im * bim[h], i0 = f_re * bim[h] + f_im * bre[h];
        const float r1 = f_re * bre[h + 1] - f_im * bim[h + 1], i1 = f_re * bim[h + 1] + f_im * bre[h + 1];
        *(unsigned*)(BB + ((size_t)ldg * 128 + p) * 16 + h) = pk2(r0, r1);
        *(unsigned*)(BB + ((size_t)ldg * 128 + 64 + p) * 16 + h) = pk2(i0, i1);
    }
    const float* cre = a->in[IN_CRE] + (size_t)ldg * 16 * 64; const float* cim = a->in[IN_CIM] + (size_t)ldg * 16 * 64;
#pragma unroll
    for (int h = 0; h < 16; ++h) *(unsigned*)(CM + ((size_t)ldg * 16 + h) * 128 + 2 * p) = pk2(cre[h * 64 + p], -cim[h * 64 + p]);
}
__device__ __forceinline__ void p0_fold_tile(ArgsP a, int l, int wt, int lane) {
    const int nb = wt / 48, cbk = wt % 48, g = cbk / 12, c0 = (cbk % 12) * 32, n0 = nb * 32;
    const float* wout = a->in[IN_WOUT] + (size_t)l * DM * DM + (size_t)(g * PGRP) * DM + n0 + (lane & 31);
    const float* wpool = a->in[IN_WPOOL] + ((size_t)(l * 4 + g) * PGRP + c0 + (lane & 31)) * PGRP;
    const float* ps = a->in[IN_PSCALE] + l * POOLW + g * PGRP;
    f32x16 acc;
#pragma unroll
    for (int r = 0; r < 16; ++r) acc[r] = 0.f;
    const int h8 = 8 * (lane >> 5);
    for (int d0 = 0; d0 < PGRP; d0 += 16) {
        float av[8];
#pragma unroll
        for (int j = 0; j < 8; ++j) av[j] = wout[(size_t)(d0 + h8 + j) * DM] * ps[d0 + h8 + j];
        const f32x4 b0 = *(const f32x4*)(wpool + d0 + h8), b1 = *(const f32x4*)(wpool + d0 + h8 + 4);
        u32x4 aw, bw;
        aw.x = pk2(av[0], av[1]); aw.y = pk2(av[2], av[3]); aw.z = pk2(av[4], av[5]); aw.w = pk2(av[6], av[7]);
        bw.x = pk2(b0.x, b0.y); bw.y = pk2(b0.z, b0.w); bw.z = pk2(b1.x, b1.y); bw.w = pk2(b1.z, b1.w);
        acc = __builtin_amdgcn_mfma_f32_32x32x16_bf16(__builtin_bit_cast(bf16x8, aw), __builtin_bit_cast(bf16x8, bw), acc, 0, 0, 0);
    }
    asm volatile("s_nop 15\n\ts_nop 15\n\ts_nop 15\n\ts_nop 15" : "+v"(acc));
    bf16* WT = (bf16*)(a->ws + WS_WT) + (size_t)l * WT_LAYER + WT_COMB;
#pragma unroll
    for (int r = 0; r < 16; ++r) { const int n = n0 + (r & 3) + 8 * (r >> 2) + 4 * (lane >> 5);
        WT[(size_t)n * DM + g * PGRP + c0 + (lane & 31)] = (bf16)(pk2(acc[r], 0.f) & 0xffffu); }
}
__device__ __forceinline__ void p0_transpose_tile(const float* W, int N, bf16* WT, int ldt, int kdst, LAS float* scr, int kb, int nb, int lane) {
    const int k0 = 64 * kb, n0 = 32 * nb;
#pragma unroll 8
    for (int i = 0; i < 32; ++i) { const int kk = 2 * i + (lane >> 5); scr[kk * 33 + (lane & 31)] = __builtin_nontemporal_load(W + (size_t)(k0 + kk) * N + n0 + (lane & 31)); }
    asm volatile("s_waitcnt lgkmcnt(0)" ::: "memory");
    const int c = lane & 7;
#pragma unroll
    for (int j = 0; j < 4; ++j) { const int n = (lane >> 3) + 8 * j; const LAS float* s = scr + (8 * c) * 33 + n;
        u32x4 o; o.x = pk2(s[0 * 33], s[1 * 33]); o.y = pk2(s[2 * 33], s[3 * 33]); o.z = pk2(s[4 * 33], s[5 * 33]); o.w = pk2(s[6 * 33], s[7 * 33]);
        *(u32x4*)(WT + (size_t)(n0 + n) * ldt + kdst + k0 + 8 * c) = o; }
    asm volatile("s_waitcnt lgkmcnt(0)" ::: "memory");
}
constexpr int Q_MOD = 192, Q_S5 = 256, Q_FOLD = 4 * 384;
constexpr int TI_IN = 32 * 8, TI_OUTS = 8 * 8, TI_UP = 32 * 44, TI_DOWN = 88 * 8, TI_GLU = 8 * 2, TI_LAYER = TI_IN + TI_OUTS + TI_UP + TI_DOWN + TI_GLU;
constexpr int Q_TOTAL = Q_MOD + Q_S5 + Q_FOLD + 4 * TI_LAYER / 2;
__device__ __forceinline__ void p0_transpose_item(ArgsP a, LAS unsigned char* lds, int it, int wave, int lane) {
    const int l = it / TI_LAYER; int r = it % TI_LAYER;
    LAS float* scr = (LAS float*)(lds + wave * 16384);
    bf16* WTL = (bf16*)(a->ws + WS_WT) + (size_t)l * WT_LAYER;
    if (r < TI_IN) { p0_transpose_tile(a->in[IN_WIN] + (size_t)l * DM * DM, DM, WTL + WT_IN, DM, 0, scr, r / 8, (r % 8) * 8 + wave, lane); return; } r -= TI_IN;
    if (r < TI_OUTS) { p0_transpose_tile(a->in[IN_WOUT] + (size_t)l * DM * DM + (size_t)POOLW * DM, DM, WTL + WT_COMB, DM, POOLW, scr, r / 8, (r % 8) * 8 + wave, lane); return; } r -= TI_OUTS;
    if (r < TI_UP) { p0_transpose_tile(a->in[IN_WUP] + (size_t)l * DM * DFF2, DFF2, WTL + WT_UP, DM, 0, scr, r / 44, (r % 44) * 8 + wave, lane); return; } r -= TI_UP;
    if (r < TI_DOWN) { p0_transpose_tile(a->in[IN_WDOWN] + (size_t)l * DFF * DM, DM, WTL + WT_DOWN, DFF, 0, scr, r / 8, (r % 8) * 8 + wave, lane); return; } r -= TI_DOWN;
    p0_transpose_tile(a->in[IN_WGLU] + (size_t)l * SSMW * SSMW, SSMW, WTL + WT_GLU, SSMW, 0, scr, r / 2, (r % 2) * 8 + wave, lane);
}
__device__ __forceinline__ void phase_prologue(ArgsP a, LAS unsigned char* lds, int tid, int wave, int lane) {
    unsigned* qhead = (unsigned*)(a->ws + WS_CTL) + CW_QUEUE;
    volatile LAS unsigned* slot = (volatile LAS unsigned*)(lds + MISC_OFF + 64);
    for (;;) {
        if (tid == 0) slot[0] = __hip_atomic_fetch_add(qhead, 1u, __ATOMIC_RELAXED, __HIP_MEMORY_SCOPE_AGENT);
        __syncthreads();
        const int it = (int)slot[0];
        __syncthreads();
        if (it >= Q_TOTAL) break;
        if (it < Q_MOD) { p0_mod_item(a, lds, it, tid); continue; }
        if (it < Q_MOD + Q_S5) { p0_s5_item(a, it - Q_MOD, tid); continue; }
        if (it < Q_MOD + Q_S5 + Q_FOLD) { const int f = it - Q_MOD - Q_S5; p0_fold_tile(a, f / 384, (f % 384) * 8 + wave, lane); continue; }
        { const int t2 = 2 * (it - Q_MOD - Q_S5 - Q_FOLD); p0_transpose_item(a, lds, t2, wave, lane); p0_transpose_item(a, lds, t2 + 1, wave, lane); }
    }
}

struct NormP {
    const bf16* y; int y_row0;
    const float* xin_lat; const float* xin_ctx;
    bf16* xb;
    float* out_f32;
    bf16* h;
    const float* gate; const float* g_post;
    const float* g_pre; const float* shift; const float* scale;
};
__device__ __forceinline__ void phase_norm(const NormP& P, int r0, int r1, int gw, int ngw, int lane) {
    const int nrows = r1 - r0, per = (nrows + ngw - 1) / ngw;
    int m = r0 + gw * per; const int mend = (m + per < r1) ? m + per : r1;
    int curj = -1;
    f32x4 A1[8], A2[8], SH[8];
#pragma unroll
    for (int i = 0; i < 8; ++i) { A1[i] = (f32x4){0.f, 0.f, 0.f, 0.f}; A2[i] = A1[i]; SH[i] = A1[i]; }
    for (; m < mend; ++m) {
        const int j = (m < MLAT) ? (m >> 12) : 8;
        if (j != curj) { curj = j;
#pragma unroll
            for (int jj = 0; jj < 4; ++jj)
#pragma unroll
                for (int hh = 0; hh < 2; ++hh) { const int e = 512 * jj + 8 * lane + 4 * hh;
                    if (P.y) A1[jj * 2 + hh] = *(const f32x4*)(P.gate + (size_t)j * 6 * DM + e) * *(const f32x4*)(P.g_post + e);
                    if (P.h) { A2[jj * 2 + hh] = *(const f32x4*)(P.g_pre + e) * (*(const f32x4*)(P.scale + (size_t)j * 6 * DM + e) + 1.0f); SH[jj * 2 + hh] = *(const f32x4*)(P.shift + (size_t)j * 6 * DM + e); } }
        }
        f32x4 xv[8];
        if (P.xin_lat) {
            const float* xs = (m < MLAT) ? P.xin_lat + (size_t)m * DM : P.xin_ctx + (size_t)(m - MLAT) * DM;
#pragma unroll
            for (int jj = 0; jj < 4; ++jj) { xv[2 * jj] = __builtin_nontemporal_load((const f32x4*)(xs + 512 * jj + 8 * lane)); xv[2 * jj + 1] = __builtin_nontemporal_load((const f32x4*)(xs + 512 * jj + 8 * lane + 4)); }
        } else {
            const bf16* xs = P.xb + (size_t)m * DM;
#pragma unroll
            for (int jj = 0; jj < 4; ++jj) { const u32x4 w = __builtin_nontemporal_load((const u32x4*)(xs + 512 * jj + 8 * lane));
                xv[2 * jj] = (f32x4){bflo(w.x), bfhi(w.x), bflo(w.y), bfhi(w.y)}; xv[2 * jj + 1] = (f32x4){bflo(w.z), bfhi(w.z), bflo(w.w), bfhi(w.w)}; }
        }
        if (P.y) {
            const bf16* yr = P.y + (size_t)(m - P.y_row0) * DM;
            f32x4 yv[8]; float ss = 0.f;
#pragma unroll
            for (int jj = 0; jj < 4; ++jj) { const u32x4 w = __builtin_nontemporal_load((const u32x4*)(yr + 512 * jj + 8 * lane));
                yv[2 * jj] = (f32x4){bflo(w.x), bfhi(w.x), bflo(w.y), bfhi(w.y)}; yv[2 * jj + 1] = (f32x4){bflo(w.z), bfhi(w.z), bflo(w.w), bfhi(w.w)}; }
#pragma unroll
            for (int i = 0; i < 8; ++i) ss += (yv[i].x * yv[i].x + yv[i].y * yv[i].y) + (yv[i].z * yv[i].z + yv[i].w * yv[i].w);
            const float rstd = 1.0f / sqrtf(wave_sum(ss) * (1.0f / DM) + EPSN);
#pragma unroll
            for (int i = 0; i < 8; ++i) xv[i] += A1[i] * (yv[i] * rstd);
        }
        if (P.out_f32) {
            float* xd = P.out_f32 + (size_t)m * DM;
#pragma unroll
            for (int jj = 0; jj < 4; ++jj) { *(f32x4*)(xd + 512 * jj + 8 * lane) = xv[2 * jj]; *(f32x4*)(xd + 512 * jj + 8 * lane + 4) = xv[2 * jj + 1]; }
        } else {
            bf16* xd = P.xb + (size_t)m * DM;
#pragma unroll
            for (int jj = 0; jj < 4; ++jj) { u32x4 w; w.x = pk2(xv[2 * jj].x, xv[2 * jj].y); w.y = pk2(xv[2 * jj].z, xv[2 * jj].w); w.z = pk2(xv[2 * jj + 1].x, xv[2 * jj + 1].y); w.w = pk2(xv[2 * jj + 1].z, xv[2 * jj + 1].w);
                st16_wt(xd + 512 * jj + 8 * lane, w); }
        }
        if (P.h) {
            float ss = 0.f;
#pragma unroll
            for (int i = 0; i < 8; ++i) ss += (xv[i].x * xv[i].x + xv[i].y * xv[i].y) + (xv[i].z * xv[i].z + xv[i].w * xv[i].w);
            const float rstd = 1.0f / sqrtf(wave_sum(ss) * (1.0f / DM) + EPSN);
            bf16* hr = P.h + (size_t)m * DM;
#pragma unroll
            for (int jj = 0; jj < 4; ++jj) { const f32x4 o0 = xv[2 * jj] * rstd * A2[2 * jj] + SH[2 * jj], o1 = xv[2 * jj + 1] * rstd * A2[2 * jj + 1] + SH[2 * jj + 1];
                u32x4 w; w.x = pk2(o0.x, o0.y); w.y = pk2(o0.z, o0.w); w.z = pk2(o1.x, o1.y); w.w = pk2(o1.z, o1.w);
                st16_wt(hr + 512 * jj + 8 * lane, w); }
        }
    }
}

#define POOL_ACC(sgn, VV) do { const u32x4 q_ = (VV); s[0] sgn bflo(q_.x); s[1] sgn bfhi(q_.x); s[2] sgn bflo(q_.y); s[3] sgn bfhi(q_.y); s[4] sgn bflo(q_.z); s[5] sgn bfhi(q_.z); s[6] sgn bflo(q_.w); s[7] sgn bfhi(q_.w); } while (0)
template <int H> __device__ __forceinline__ void pool_batch(const bf16* u, bf16* PA, int m0, int ch0) {
    constexpr int NR = 7 + 2 * H;
    int base, t0, n;
    if (m0 < MLAT) { base = m0 & ~(SEQ - 1); t0 = m0 & (SEQ - 1); n = SEQ; } else { const int mm = m0 - MLAT; base = MLAT + (mm & ~(CTXL - 1)); t0 = mm & (CTXL - 1); n = CTXL; }
    u32x4 v[NR];
#pragma unroll
    for (int k = 0; k < NR; ++k) { const int tt = t0 - H + k; v[k] = (u32x4){0u, 0u, 0u, 0u}; if (tt >= 0 && tt < n) v[k] = *(const u32x4*)(u + (size_t)(base + tt) * DM + ch0); }
    float s[8];
#pragma unroll
    for (int e = 0; e < 8; ++e) s[e] = 0.f;
#pragma unroll
    for (int k = 0; k < 2 * H; ++k) POOL_ACC(+=, v[k]);
#pragma unroll
    for (int i = 0; i < 8; ++i) {
        if (i > 0) { POOL_ACC(+=, v[i + 2 * H - 1]); POOL_ACC(-=, v[i - 1]); }
        const int t = t0 + i, lo = (t - H > 0) ? t - H : 0, hi = (t + H < n) ? t + H : n;
        const float inv = 1.0f / (float)(hi - lo);
        const u32x4 c = v[H + i];
        u32x4 o; o.x = pk2(s[0] * inv - bflo(c.x), s[1] * inv - bfhi(c.x)); o.y = pk2(s[2] * inv - bflo(c.y), s[3] * inv - bfhi(c.y));
        o.z = pk2(s[4] * inv - bflo(c.z), s[5] * inv - bfhi(c.z)); o.w = pk2(s[6] * inv - bflo(c.w), s[7] * inv - bfhi(c.w));
        st16_wt(PA + (size_t)(m0 + i) * DM + ch0, o);
    }
}
__device__ __forceinline__ void pool_rows(const bf16* u, bf16* PA, int row0, int nbatch, int pw  , int lane) {
    if (lane >= 48) return;
    for (int it = pw; it < nbatch * 4; it += 4) {
        const int batch = it >> 2, grp = (it + batch) & 3, m0 = row0 + 8 * batch, ch0 = grp * PGRP + 8 * lane;
        if (grp == 0) pool_batch<1>(u, PA, m0, ch0); else if (grp == 1) pool_batch<2>(u, PA, m0, ch0); else if (grp == 2) pool_batch<4>(u, PA, m0, ch0); else pool_batch<8>(u, PA, m0, ch0);
    }
}
__device__ __forceinline__ int chain_row(int q, int dir, int b) {
    if (q < CTXL) { const int tt = dir ? (CTXL - 1 - q) : q; return MLAT + b * CTXL + tt; }
    const int qq = q - CTXL; const int tt = dir ? (SEQ - 1 - qq) : qq; return b * SEQ + tt;
}
constexpr int STASH_KCB = 528, STASH_BUFB = 16 * STASH_KCB;
__device__ __forceinline__ void ssm_chain(LAS unsigned char* stash, const bf16* u, bf16* Y, const float* LAM, const bf16* BB, const bf16* CM, int l, int b, int g, int dir, int lane) {
    const int ldg = (l * 2 + dir) * NGRP + g;
    const float lr = LAM[(ldg * 64 + lane) * 2], li = LAM[(ldg * 64 + lane) * 2 + 1];
    bf16x8 Bf[4], Cf[4];
#pragma unroll
    for (int cb = 0; cb < 4; ++cb) Bf[cb] = *(const bf16x8*)(BB + ((size_t)ldg * 128 + cb * 32 + (lane & 31)) * 16 + 8 * (lane >> 5));
#pragma unroll
    for (int ks = 0; ks < 4; ++ks) Cf[ks] = *(const bf16x8*)(CM + ((size_t)ldg * 16 + (lane & 15)) * 128 + 32 * ks + 8 * (lane >> 4));
    float hr = 0.f, hi = 0.f;
    const int ucol = POOLW + SGRP * g + 8 * (lane >> 5);
    const int sgn = dir ? -1 : 1;
    const int uoff = sgn * (lane & 31) * DM + ucol;
    const int yo0 = sgn * (lane & 15) * SSMW + SGRP * g + 4 * (lane >> 4), yo1 = yo0 + sgn * 16 * SSMW;
    const unsigned wad = (unsigned)(size_t)(stash + (lane >> 2) * STASH_KCB + (lane & 3) * 4);
    bf16x8 cur[8], nxt[8];
#pragma unroll
    for (int c = 0; c < 8; ++c) cur[c] = *(const bf16x8*)(u + (ptrdiff_t)chain_row(32 * c, dir, b) * DM + uoff);
    for (int sc = 0; sc < 17; ++sc) {
        if (sc + 1 < 17) {
#pragma unroll
            for (int c = 0; c < 8; ++c) nxt[c] = *(const bf16x8*)(u + (ptrdiff_t)chain_row(256 * (sc + 1) + 32 * c, dir, b) * DM + uoff);
        }
#pragma unroll
        for (int c = 0; c < 8; ++c) {
            const int q0 = 256 * sc + 32 * c;
            const LAS unsigned char* stp = stash + ((c & 1) ^ 1) * STASH_BUFB;
            bf16x8 a0[4], a1[4];
#pragma unroll
            for (int ks = 0; ks < 4; ++ks) {
                a0[ks] = *(const LAS bf16x8*)(stp + (4 * ks + (lane >> 4)) * STASH_KCB + (lane & 15) * 16);
                a1[ks] = *(const LAS bf16x8*)(stp + (4 * ks + (lane >> 4)) * STASH_KCB + (16 + (lane & 15)) * 16);
            }
            f32x16 z16;
#pragma unroll
            for (int r = 0; r < 16; ++r) z16[r] = 0.f;
            f32x16 D0 = __builtin_amdgcn_mfma_f32_32x32x16_bf16(cur[c], Bf[0], z16, 0, 0, 0);
            f32x16 D1 = __builtin_amdgcn_mfma_f32_32x32x16_bf16(cur[c], Bf[1], z16, 0, 0, 0);
            f32x16 D2 = __builtin_amdgcn_mfma_f32_32x32x16_bf16(cur[c], Bf[2], z16, 0, 0, 0);
            f32x16 D3 = __builtin_amdgcn_mfma_f32_32x32x16_bf16(cur[c], Bf[3], z16, 0, 0, 0);
            f32x4 acc0 = (f32x4){0.f, 0.f, 0.f, 0.f}, acc1 = acc0;
            asm volatile("" : "+v"(D0), "+v"(D1), "+v"(D2), "+v"(D3), "+v"(acc0), "+v"(acc1) :: "memory");
#pragma unroll
            for (int ks = 0; ks < 4; ++ks) {
                acc0 = __builtin_amdgcn_mfma_f32_16x16x32_bf16(Cf[ks], a0[ks], acc0, 0, 0, 0);
                acc1 = __builtin_amdgcn_mfma_f32_16x16x32_bf16(Cf[ks], a1[ks], acc1, 0, 0, 0);
            }
            asm volatile("s_waitcnt lgkmcnt(0)\n\ts_nop 15\n\ts_nop 15" : "+v"(acc0), "+v"(acc1) :: "memory");
            if (q0 > 0) {
                bf16* yb = Y + (ptrdiff_t)chain_row(q0 - 32, dir, b) * SSMW;
                u32x2 w0, w1; w0.x = pk2(acc0[0], acc0[1]); w0.y = pk2(acc0[2], acc0[3]); w1.x = pk2(acc1[0], acc1[1]); w1.y = pk2(acc1[2], acc1[3]);
                *(u32x2*)(yb + yo0) = w0;
                *(u32x2*)(yb + yo1) = w1;
            }
            asm volatile("s_nop 3" : "+v"(D0), "+v"(D1), "+v"(D2), "+v"(D3));
            float bre[32], bim[32];
#pragma unroll
            for (int r = 0; r < 16; ++r) { const int p0 = (r & 3) + 8 * (r >> 2);
                auto rr = __builtin_amdgcn_permlane32_swap(__float_as_uint(D0[r]), __float_as_uint(D1[r]), false, false);
                bre[p0] = __uint_as_float(rr[0]); bre[p0 + 4] = __uint_as_float(rr[1]);
                auto ri = __builtin_amdgcn_permlane32_swap(__float_as_uint(D2[r]), __float_as_uint(D3[r]), false, false);
                bim[p0] = __uint_as_float(ri[0]); bim[p0 + 4] = __uint_as_float(ri[1]); }
#pragma unroll
            for (int pos = 0; pos < 32; pos += 2) {
                const float nr = fmaf(-li, hi, fmaf(lr, hr, bre[pos]));
                const float ni = fmaf(li, hr, fmaf(lr, hi, bim[pos]));
                const unsigned p0 = pk2(nr, ni);
                hr = fmaf(-li, ni, fmaf(lr, nr, bre[pos + 1]));
                hi = fmaf(li, nr, fmaf(lr, ni, bim[pos + 1]));
                const unsigned p1 = pk2(hr, hi);
                asm volatile("ds_write2_b32 %0, %1, %2 offset0:%3 offset1:%4" :: "v"(wad + (unsigned)((c & 1) * STASH_BUFB)), "v"(p0), "v"(p1), "n"(4 * pos), "n"(4 * pos + 4) : "memory");
            }
        }
#pragma unroll
        for (int c = 0; c < 8; ++c) cur[c] = nxt[c];
    }
    {
        const LAS unsigned char* stp = stash + 1 * STASH_BUFB;
        asm volatile("s_waitcnt lgkmcnt(0)" ::: "memory");
        f32x4 acc0 = (f32x4){0.f, 0.f, 0.f, 0.f}, acc1 = acc0;
#pragma unroll
        for (int ks = 0; ks < 4; ++ks) {
            const bf16x8 a0 = *(const LAS bf16x8*)(stp + (4 * ks + (lane >> 4)) * STASH_KCB + (lane & 15) * 16);
            const bf16x8 a1 = *(const LAS bf16x8*)(stp + (4 * ks + (lane >> 4)) * STASH_KCB + (16 + (lane & 15)) * 16);
            acc0 = __builtin_amdgcn_mfma_f32_16x16x32_bf16(Cf[ks], a0, acc0, 0, 0, 0);
            acc1 = __builtin_amdgcn_mfma_f32_16x16x32_bf16(Cf[ks], a1, acc1, 0, 0, 0);
        }
        asm volatile("s_waitcnt lgkmcnt(0)\n\ts_nop 15\n\ts_nop 15" : "+v"(acc0), "+v"(acc1) :: "memory");
        bf16* yb = Y + (ptrdiff_t)chain_row(256 * 16 + 32 * 7, dir, b) * SSMW;
        u32x2 w0, w1; w0.x = pk2(acc0[0], acc0[1]); w0.y = pk2(acc0[2], acc0[3]); w1.x = pk2(acc1[0], acc1[1]); w1.y = pk2(acc1[2], acc1[3]);
        *(u32x2*)(yb + yo0) = w0;
        *(u32x2*)(yb + yo1) = w1;
    }
}
__device__ __forceinline__ void phase_mix_a(ArgsP a, LAS unsigned char* lds, int l, int mrows, int wave, int lane, int tid) {
    const bf16* u = (const bf16*)(a->ws + WS_BUFB);
    if (wave < 2) {
        const int bx = blockIdx.x, xcd = bx & 7, jj = bx >> 3;
        for (int it = jj; it < 32; it += (int)(gridDim.x >> 3)) {
            const int g = 4 * xcd + (it & 3), b = it >> 2;
            bf16* Y = (bf16*)(a->ws + WS_BUFA) + (size_t)wave * MALL * SSMW;
            ssm_chain(lds + wave * 32768, u, Y, (const float*)(a->ws + WS_LAM), (const bf16*)(a->ws + WS_BB), (const bf16*)(a->ws + WS_CM), l, b, g, wave, lane);
        }
    } else if (wave != 4 && wave != 5) {
        const int per = mrows / 256;
        for (int wgi = blockIdx.x; wgi < 256; wgi += gridDim.x) pool_rows(u, (bf16*)(a->ws + WS_BUFC), wgi * per, per / 8, (wave < 4) ? wave - 2 : wave - 4, lane);
    }
}

__device__ __forceinline__ float gelu_tanh(float x) { const float z = 0.7978845608028654f * (x + 0.044715f * x * x * x); return x * sigmoidf_(2.0f * z); }
__device__ __forceinline__ int glu_lds_off(int row, int chunk) { return row * 1024 + ((chunk ^ (row & 15)) << 4); }
__device__ __forceinline__ void phase_mix_b(ArgsP a, LAS unsigned char* lds, int l, int mrows, int tid, int wave, int lane) {
    const bf16* Y0 = (const bf16*)(a->ws + WS_BUFA); const bf16* Y1 = Y0 + (size_t)MALL * SSMW;
    const bf16* u = (const bf16*)(a->ws + WS_BUFB);
    const float* Dv = a->in[IN_SSMD] + l * SSMW;
    const bf16* Wg = (const bf16*)(a->ws + WS_WT) + (size_t)l * WT_LAYER + WT_GLU;
    bf16* PA = (bf16*)(a->ws + WS_BUFC);
    const int RPW = mrows / 256;
    for (int wgi = blockIdx.x; wgi < 256; wgi += gridDim.x) {
        const int row0 = wgi * RPW;
        {
            const int c = lane, k0 = 8 * c;
            const f32x4 d0 = *(const f32x4*)(Dv + k0), d1 = *(const f32x4*)(Dv + k0 + 4);
            const int NI = RPW / 8;
#pragma unroll 1
            for (int ib = 0; ib < NI; ib += 9) {
                u32x4 y0w[9], y1w[9], uw[9];
#pragma unroll
                for (int i = 0; i < 9; ++i) { int ii = ib + i; ii = ii < NI ? ii : NI - 1; const size_t mr = (size_t)(row0 + wave + 8 * ii);
                    y0w[i] = __builtin_nontemporal_load((const u32x4*)(Y0 + mr * SSMW + k0)); y1w[i] = __builtin_nontemporal_load((const u32x4*)(Y1 + mr * SSMW + k0)); uw[i] = *(const u32x4*)(u + mr * DM + POOLW + k0); }
#pragma unroll
                for (int i = 0; i < 9; ++i) {
                    if (ib + i < NI) {
                        const int r = wave + 8 * (ib + i);
                        const f32x4 y00 = (f32x4){bflo(y0w[i].x), bfhi(y0w[i].x), bflo(y0w[i].y), bfhi(y0w[i].y)}, y01 = (f32x4){bflo(y0w[i].z), bfhi(y0w[i].z), bflo(y0w[i].w), bfhi(y0w[i].w)};
                        const f32x4 y10 = (f32x4){bflo(y1w[i].x), bfhi(y1w[i].x), bflo(y1w[i].y), bfhi(y1w[i].y)}, y11 = (f32x4){bflo(y1w[i].z), bfhi(y1w[i].z), bflo(y1w[i].w), bfhi(y1w[i].w)};
                        const f32x4 u0 = (f32x4){bflo(uw[i].x), bfhi(uw[i].x), bflo(uw[i].y), bfhi(uw[i].y)}, u1 = (f32x4){bflo(uw[i].z), bfhi(uw[i].z), bflo(uw[i].w), bfhi(uw[i].w)};
                        const f32x4 v0 = y00 + y10 + d0 * u0, v1 = y01 + y11 + d1 * u1;
                        u32x4 w; w.x = pk2(gelu_tanh(v0.x), gelu_tanh(v0.y)); w.y = pk2(gelu_tanh(v0.z), gelu_tanh(v0.w)); w.z = pk2(gelu_tanh(v1.x), gelu_tanh(v1.y)); w.w = pk2(gelu_tanh(v1.z), gelu_tanh(v1.w));
                        *(LAS u32x4*)(lds + glu_lds_off(r, c)) = w;
                    }
                }
            }
        }
        __syncthreads();
#pragma unroll 1
        for (int mh = 0; mh < 2; ++mh) {
            const int fr = lane & 15, kq = lane >> 4, nbase = 64 * wave, mb0 = 5 * mh;
            f32x4 acc[5][4];
#pragma unroll
            for (int mb = 0; mb < 5; ++mb)
#pragma unroll
                for (int nb = 0; nb < 4; ++nb) acc[mb][nb] = (f32x4){0.f, 0.f, 0.f, 0.f};
            const bf16* wrow = Wg + (size_t)(nbase + 16 * (fr >> 2) + (fr & 3)) * SSMW + 8 * kq;
            bf16x8 W[4][4];
#pragma unroll
            for (int j = 0; j < 4; ++j)
#pragma unroll
                for (int nb = 0; nb < 4; ++nb) W[j][nb] = *(const bf16x8*)(wrow + (size_t)(4 * nb) * SSMW + 32 * j);
#pragma unroll 1
            for (int kg = 0; kg < 4; ++kg) {
#pragma unroll
                for (int j = 0; j < 4; ++j) {
                    const int ks = 4 * kg + j;
#pragma unroll
                    for (int mb = 0; mb < 5; ++mb) {
                        if (mb < 4 || mh == 0) {
                            int rr = 16 * (mb0 + mb) + fr; rr = rr < RPW ? rr : RPW - 1;
                            const bf16x8 af = *(const LAS bf16x8*)(lds + glu_lds_off(rr, 4 * ks + kq));
#pragma unroll
                            for (int nb = 0; nb < 4; ++nb) acc[mb][nb] = __builtin_amdgcn_mfma_f32_16x16x32_bf16(W[j][nb], af, acc[mb][nb], 0, 0, 0);
                        }
                    }
                    if (kg < 3) {
#pragma unroll
                        for (int nb = 0; nb < 4; ++nb) W[j][nb] = *(const bf16x8*)(wrow + (size_t)(4 * nb) * SSMW + 32 * (ks + 4));
                    }
                }
            }
#pragma unroll
            for (int mb = 0; mb < 5; ++mb) {
                const int tok = 16 * (mb0 + mb) + fr;
                if (tok < RPW) {
                    const int n = nbase + 16 * kq;
#pragma unroll
                    for (int hh = 0; hh < 2; ++hh) {
                        const u32x4 yw = *(const LAS u32x4*)(lds + glu_lds_off(tok, (n >> 3) + hh));
                        const f32x4 g0 = acc[mb][2 * hh], g1 = acc[mb][2 * hh + 1];
                        u32x4 o; o.x = pk2(bflo(yw.x) * sigmoidf_(g0.x), bfhi(yw.x) * sigmoidf_(g0.y)); o.y = pk2(bflo(yw.y) * sigmoidf_(g0.z), bfhi(yw.y) * sigmoidf_(g0.w));
                        o.z = pk2(bflo(yw.z) * sigmoidf_(g1.x), bfhi(yw.z) * sigmoidf_(g1.y)); o.w = pk2(bflo(yw.w) * sigmoidf_(g1.z), bfhi(yw.w) * sigmoidf_(g1.w));
                        *(u32x4*)(PA + (size_t)(row0 + tok) * DM + POOLW + n + 8 * hh) = o;
                    }
                }
            }
        }
        __syncthreads();
    }
}

struct ConvF { f32x4 v[3], g[3]; };
constexpr int CV_ROWB = 1024, CV_COLB = 10 * CV_ROWB, CV_PAIRB = 2 * CV_COLB, CV_DEPTH = 6;
__device__ __forceinline__ void conv_wg_item(LAS unsigned char* lds, const bf16* z  , bf16* aout  , const float* wc, int mloc0, int mglob0, int cg, int wave, int lane) {
    const bool ctx = mglob0 >= MLAT;
    const int gr0 = (mglob0 >> 6) & 63;
    const int f0c = cg * 256, f0 = f0c + 4 * lane;
    f32x4 wv[3][3], wg[3][3];
#pragma unroll
    for (int i = 0; i < 3; ++i)
#pragma unroll
        for (int j = 0; j < 3; ++j) { wv[i][j] = *(const f32x4*)(wc + (size_t)(i * 3 + j) * DFF2 + f0); wg[i][j] = *(const f32x4*)(wc + (size_t)(i * 3 + j) * DFF2 + DFF + f0); }
    asm volatile("s_waitcnt vmcnt(0)" : "+v"(wv[0][0]), "+v"(wv[0][1]), "+v"(wv[0][2]), "+v"(wv[1][0]), "+v"(wv[1][1]), "+v"(wv[1][2]), "+v"(wv[2][0]), "+v"(wv[2][1]), "+v"(wv[2][2]),
                 "+v"(wg[0][0]), "+v"(wg[0][1]), "+v"(wg[0][2]), "+v"(wg[1][0]), "+v"(wg[1][1]), "+v"(wg[1][2]), "+v"(wg[2][0]), "+v"(wg[2][1]), "+v"(wg[2][2]) :: "memory");
    const int mrun = mglob0 + 64 * wave;
    bool up, down, left, right;
    if (!ctx) { const int gr = (mrun >> 6) & 63; up = gr > 0; down = gr < 63; left = false; right = false; }
    else { const int seg = ((mrun - MLAT) >> 6) & 3; up = false; down = false; left = seg > 0; right = seg < 3; }
    bf16* ao = aout + (size_t)(mloc0 + 64 * wave) * DFF + f0;
    const int lane_off = (lane < 32) ? (f0c + 8 * lane) : (DFF + f0c + 8 * (lane - 32));
#define CV_DMA(hr, k, p, kc) do { int jj_ = (hr) - 1; bool rv_; \
        if (!ctx) { rv_ = (jj_ >= 0 && jj_ < 8) || (jj_ < 0 && gr0 > 0) || (jj_ == 8 && gr0 + 8 < 64); } else { rv_ = (jj_ >= 0 && jj_ < 8); } \
        if (!rv_) jj_ = jj_ < 0 ? 0 : 7; \
        int kk_ = (k); bool cv_ = (kk_ >= 0 && kk_ < GRIDW); \
        if (!cv_ && ctx && rv_) { const int sg_ = ((mglob0 + 64 * jj_ - MLAT) >> 6) & 3; cv_ = (kk_ < 0) ? (sg_ > 0) : (sg_ < 3); } \
        if (!cv_) kk_ = kk_ < 0 ? 0 : GRIDW - 1; \
        const bf16* src_ = z + (size_t)(mloc0 + 64 * jj_ + kk_) * DFF2 + lane_off; \
        __builtin_amdgcn_global_load_lds((const unsigned*)src_, (LAS unsigned*)(lds + ((p) % CV_DEPTH) * CV_PAIRB + (kc) * CV_COLB + (hr) * CV_ROWB), 16, 0, 2); } while (0)
#define CV_DMA_PAIR(p) do { const int pp_ = (p) > 32 ? 32 : (p);   \
        CV_DMA(wave, 2 * pp_ - 1, p, 0); CV_DMA(wave, 2 * pp_, p, 1); \
        if (wave < 2) { CV_DMA(8 + wave, 2 * pp_ - 1, p, 0); CV_DMA(8 + wave, 2 * pp_, p, 1); } } while (0)
#define CV_F4(w2) ((f32x4){bflo((w2).x), bfhi((w2).x), bflo((w2).y), bfhi((w2).y)})
    const f32x4 zero4 = (f32x4){0.f, 0.f, 0.f, 0.f};
#define CV_CVT(slot, p, kc, k) do { const bool cok_ = ((k) >= 0 && (k) < GRIDW) || ((k) < 0 && left) || ((k) >= GRIDW && right); \
        LAS const unsigned char* b_ = lds + ((p) % CV_DEPTH) * CV_PAIRB + (kc) * CV_COLB + wave * CV_ROWB + 8 * lane; \
        _Pragma("unroll") for (int i_ = 0; i_ < 3; ++i_) { const bool ok_ = cok_ && (i_ == 1 || (i_ == 0 && up) || (i_ == 2 && down)); \
            if (ok_) { const u32x2 a_ = *(LAS const u32x2*)(b_ + i_ * CV_ROWB), g_ = *(LAS const u32x2*)(b_ + i_ * CV_ROWB + 512); F[slot].v[i_] = CV_F4(a_); F[slot].g[i_] = CV_F4(g_); } \
            else { F[slot].v[i_] = zero4; F[slot].g[i_] = zero4; } } } while (0)
#define CV_OUT(c, sm, s0, sp) do { f32x4 ov = wv[0][0] * F[sm].v[0], og = wg[0][0] * F[sm].g[0]; \
        ov += wv[1][0] * F[sm].v[1]; og += wg[1][0] * F[sm].g[1]; ov += wv[2][0] * F[sm].v[2]; og += wg[2][0] * F[sm].g[2]; \
        _Pragma("unroll") for (int i_ = 0; i_ < 3; ++i_) { ov += wv[i_][1] * F[s0].v[i_]; og += wg[i_][1] * F[s0].g[i_]; ov += wv[i_][2] * F[sp].v[i_]; og += wg[i_][2] * F[sp].g[i_]; } \
        const f32x4 o_ = ov * og * (f32x4){sigmoidf_(og.x), sigmoidf_(og.y), sigmoidf_(og.z), sigmoidf_(og.w)}; \
        u32x2 w_; w_.x = pk2(o_.x, o_.y); w_.y = pk2(o_.z, o_.w); st8_wt(ao + (size_t)(c) * DFF, w_); } while (0)
#define CV_ARRIVE(p, EXACT) do { if (EXACT) { if (wave < 2) asm volatile("s_waitcnt vmcnt(26)" ::: "memory"); else asm volatile("s_waitcnt vmcnt(18)" ::: "memory"); } \
        else { if (wave < 2) asm volatile("s_waitcnt vmcnt(16)" ::: "memory"); else asm volatile("s_waitcnt vmcnt(8)" ::: "memory"); } \
        asm volatile("s_waitcnt lgkmcnt(0)" ::: "memory"); __builtin_amdgcn_s_barrier(); asm volatile("" ::: "memory"); CV_DMA_PAIR((p) + 5); } while (0)
    ConvF F[4];
    CV_DMA_PAIR(0); CV_DMA_PAIR(1); CV_DMA_PAIR(2); CV_DMA_PAIR(3); CV_DMA_PAIR(4);
    CV_ARRIVE(0, false); CV_CVT(0, 0, 0, -1); CV_CVT(1, 0, 1, 0);
#pragma unroll 1
    for (int q = 0; q < 16; ++q) {
        const int po = 2 * q + 1, pe = 2 * q + 2;
        const bool ex = q >= 3;
        CV_ARRIVE(po, ex); CV_CVT(2, po, 0, 2 * po - 1); CV_CVT(3, po, 1, 2 * po);
        CV_OUT(2 * po - 2, 0, 1, 2); CV_OUT(2 * po - 1, 1, 2, 3);
        CV_ARRIVE(pe, ex); CV_CVT(0, pe, 0, 2 * pe - 1); CV_CVT(1, pe, 1, 2 * pe);
        CV_OUT(2 * pe - 2, 2, 3, 0); CV_OUT(2 * pe - 1, 3, 0, 1);
    }
    asm volatile("s_waitcnt vmcnt(0) lgkmcnt(0)" ::: "memory"); __builtin_amdgcn_s_barrier(); asm volatile("" ::: "memory");
#undef CV_DMA
#undef CV_DMA_PAIR
#undef CV_F4
#undef CV_CVT
#undef CV_OUT
#undef CV_ARRIVE
}
__device__ __forceinline__ void phase_conv(ArgsP a, LAS unsigned char* lds, int l, int r0, int r1, const bf16* z, bf16* aout, int wave, int lane) {
    const float* wc = a->in[IN_WCONV] + (size_t)l * 9 * DFF2;
    const int nitems = ((r1 - r0) / (GRIDW * 8)) * 22;
    for (int it = blockIdx.x; it < nitems; it += gridDim.x) {
        const int rb = it / 22, cg = it % 22;
        conv_wg_item(lds, z, aout, wc, rb * 8 * GRIDW, r0 + rb * 8 * GRIDW, cg, wave, lane);
    }
}

constexpr int PH_PER_LAYER = 13;
constexpr int PH_TOTAL = 2 + DEPTH * PH_PER_LAYER;
constexpr int NORM_WGS = 64;

__global__ void __launch_bounds__(NTHREADS, 2) mk_fwd(Args args) {
    extern __shared__ __attribute__((aligned(16))) unsigned char lds_raw[];
    LAS unsigned char* lds = (LAS unsigned char*)lds_raw;
    const ArgsP kp = (ArgsP)__builtin_amdgcn_kernarg_segment_ptr();
    (void)args;
    volatile LAS unsigned* MISC = (volatile LAS unsigned*)(lds + MISC_OFF);
    if (threadIdx.x < 64) MISC[threadIdx.x] = 0u;
    __syncthreads();
    const int lo = kp->seg_lo, hi = kp->seg_hi;
    XcdBarrier bar; bar.bar = (unsigned*)(kp->ws + WS_CTL) + CW_BAR; bar.x = 0; bar.st = MISC + 8;
    if (hi - lo > 1) bar = xcd_barrier_post((unsigned*)(kp->ws + WS_CTL) + CW_BAR, MISC + 8);
#ifndef PHEN
#define PHEN 0xffff
#endif
#define IN(k) (lo <= (k) && (k) < hi)
#define SEAM(k) do { if ((k) + 1 < hi) xcd_barrier(bar); } while (0)
#define SEAM_WT(k) do { if ((k) + 1 < hi) xcd_barrier(bar, false); } while (0)
#define REP(bit) for (int rep_ = 0, nrep_ = ((kp->dup & (bit)) ? 2 : 1); rep_ < nrep_; ++rep_)
#define TIDV int tid_ = threadIdx.x; asm volatile("" : "+v"(tid_)); const int tid = tid_, lane = tid & 63, wave = __builtin_amdgcn_readfirstlane(tid >> 6); const int G = gridDim.x, gw = blockIdx.x * NWAVES + wave, ngw = G * NWAVES; (void)lane; (void)gw; (void)ngw; (void)G

    if ((PHEN & 1) && IN(0)) { TIDV; phase_prologue(launder(kp), lds, tid, wave, lane); SEAM(0); }
    if ((PHEN & 2) && IN(1)) {
        TIDV; const ArgsP a = launder(kp); float* MOD = (float*)(a->ws + WS_MOD);
        NormP P; P.y = nullptr; P.y_row0 = 0; P.xin_lat = a->in[IN_X]; P.xin_ctx = a->in[IN_CTX]; P.xb = (bf16*)(a->ws + WS_XB); P.out_f32 = nullptr; P.h = (bf16*)(a->ws + WS_BUFA);
        P.gate = nullptr; P.g_post = nullptr; P.g_pre = a->in[IN_GPREMIX]; P.shift = MOD + 0 * DM; P.scale = MOD + 1 * DM;
        phase_norm(P, 0, MALL, gw, ngw, lane);
        SEAM_WT(1);
    }
    for (int l = 0; l < DEPTH; ++l) {
        const int pb = 2 + l * PH_PER_LAYER;
        if (pb + PH_PER_LAYER <= lo || pb >= hi) continue;
        const int mrows = (l == DEPTH - 1) ? MLAT : MALL;
        if ((PHEN & 4) && IN(pb + 0)) {
            const ArgsP a = launder(kp); const pg8::bf16_t* WTL = (const pg8::bf16_t*)(a->ws + WS_WT) + (size_t)l * WT_LAYER;
            pg8::Gemm g{(const bf16*)(a->ws + WS_BUFA), WTL + WT_IN, MALL, DM, DM}; pg8::StaticOrder S; S.init(MALL, DM, (int)gridDim.x, (int)blockIdx.x);
            pg8::EpiBf16 E{(bf16*)(a->ws + WS_BUFB), DM};
            REP(4) pg8::gemm_phase<pg8::EpiBf16, pg8::StaticOrder, true, true>(lds, g, S, E);
            SEAM(pb + 0);
        }
        if ((PHEN & 8) && IN(pb + 1)) { TIDV; REP(8) phase_mix_a(launder(kp), lds, l, mrows, wave, lane, tid); SEAM(pb + 1); }
        if ((PHEN & 16) && IN(pb + 2)) { TIDV; REP(16) phase_mix_b(launder(kp), lds, l, mrows, tid, wave, lane); SEAM(pb + 2); }
        if ((PHEN & 32) && IN(pb + 3)) {
            const ArgsP a = launder(kp); const pg8::bf16_t* WTL = (const pg8::bf16_t*)(a->ws + WS_WT) + (size_t)l * WT_LAYER;
            pg8::Gemm g{(const bf16*)(a->ws + WS_BUFC), WTL + WT_COMB, mrows, DM, DM}; pg8::StaticOrder S; S.init(mrows, DM, (int)gridDim.x, (int)blockIdx.x);
            pg8::EpiBf16 E{(bf16*)(a->ws + WS_BUFB), DM};
            REP(4) pg8::gemm_phase<pg8::EpiBf16, pg8::StaticOrder, true, true>(lds, g, S, E);
            SEAM(pb + 3);
        }
        if ((PHEN & 64) && IN(pb + 4)) {
            TIDV; const ArgsP a = launder(kp); const float* MODL = (const float*)(a->ws + WS_MOD) + (size_t)l * 9 * 6 * DM;
            NormP P; P.y = (const bf16*)(a->ws + WS_BUFB); P.y_row0 = 0; P.xin_lat = nullptr; P.xin_ctx = nullptr; P.xb = (bf16*)(a->ws + WS_XB); P.out_f32 = nullptr; P.h = (bf16*)(a->ws + WS_BUFA);
            P.gate = MODL + 2 * DM; P.g_post = a->in[IN_GPOSTMIX] + l * DM; P.g_pre = a->in[IN_GPREFFN] + l * DM; P.shift = MODL + 3 * DM; P.scale = MODL + 4 * DM;
            phase_norm(P, 0, mrows, gw, ngw, lane);
            SEAM_WT(pb + 4);
        }
        for (int hf = 0; hf < 2; ++hf) {
            const int nhalf = kp->nhalf;
            if (hf >= nhalf) break;
            const int r0 = (nhalf == 1) ? 0 : (hf == 0 ? 0 : HALF1_ROW0), r1 = (nhalf == 1) ? mrows : (hf == 0 ? HALF1_ROW0 : mrows);
            const int ph = pb + 5 + 4 * hf;
            const size_t a_off = (nhalf == 1) ? WS_BUFA : WS_BUFB, f_off = (nhalf == 1) ? WS_Z : (hf == 0 ? WS_BUFB + A_HALF : WS_Z);
            const bool pair_norm0 = (nhalf == 2 && l < DEPTH - 1);
            if ((PHEN & 128) && IN(ph + 0)) {
                const ArgsP a = launder(kp); const pg8::bf16_t* WTL = (const pg8::bf16_t*)(a->ws + WS_WT) + (size_t)l * WT_LAYER;
                pg8::Gemm g{(const bf16*)(a->ws + WS_BUFA) + (size_t)r0 * DM, WTL + WT_UP, r1 - r0, DFF2, DM}; pg8::StaticOrder S; S.init(r1 - r0, DFF2, (int)gridDim.x, (int)blockIdx.x);
                pg8::EpiBf16 E{(bf16*)(a->ws + WS_Z), DFF2};
                REP(4) pg8::gemm_phase<pg8::EpiBf16, pg8::StaticOrder, true, true>(lds, g, S, E);
                SEAM(ph + 0);
            }
            if ((PHEN & 256) && IN(ph + 1)) { TIDV; const ArgsP a = launder(kp); REP(256) phase_conv(a, lds, l, r0, r1, (const bf16*)(a->ws + WS_Z), (bf16*)(a->ws + a_off), wave, lane); SEAM_WT(ph + 1); }
            if ((PHEN & 512) && IN(ph + 2)) {
                const bool paired = pair_norm0 && hf == 1;
                const int gG = paired ? (int)gridDim.x - NORM_WGS : (int)gridDim.x;
                if ((int)blockIdx.x < gG) {
                    const ArgsP a = launder(kp); const pg8::bf16_t* WTL = (const pg8::bf16_t*)(a->ws + WS_WT) + (size_t)l * WT_LAYER;
                    pg8::Gemm g{(const bf16*)(a->ws + a_off), WTL + WT_DOWN, r1 - r0, DM, DFF}; pg8::StaticOrder S; S.init(r1 - r0, DM, gG, (int)blockIdx.x);
                    pg8::EpiBf16 E{(bf16*)(a->ws + f_off), DM};
                    REP(4) pg8::gemm_phase<pg8::EpiBf16, pg8::StaticOrder, true, true>(lds, g, S, E);
                } else {
                    TIDV; const ArgsP a = launder(kp);
                    const float* MODL = (const float*)(a->ws + WS_MOD) + (size_t)l * 9 * 6 * DM; const float* MODN = MODL + 9 * 6 * DM;
                    NormP P; P.y = (const bf16*)(a->ws + WS_BUFB + A_HALF); P.y_row0 = 0; P.xin_lat = nullptr; P.xin_ctx = nullptr; P.xb = (bf16*)(a->ws + WS_XB); P.out_f32 = nullptr;
                    P.h = (bf16*)(a->ws + WS_BUFA);
                    P.gate = MODL + 5 * DM; P.g_post = a->in[IN_GPOSTFFN] + l * DM;
                    P.g_pre = a->in[IN_GPREMIX] + (l + 1) * DM; P.shift = MODN + 0 * DM; P.scale = MODN + 1 * DM;
                    phase_norm(P, 0, HALF1_ROW0, ((int)blockIdx.x - gG) * NWAVES + wave, NORM_WGS * NWAVES, lane);
                }
                SEAM(ph + 2);
            }
            if ((PHEN & 1024) && IN(ph + 3) && !(pair_norm0 && hf == 0)) {
                TIDV; const ArgsP a = launder(kp); const bool lastl = (l == DEPTH - 1);
                const float* MODL = (const float*)(a->ws + WS_MOD) + (size_t)l * 9 * 6 * DM; const float* MODN = MODL + (lastl ? 0 : 9 * 6 * DM);
                NormP P; P.y = (const bf16*)(a->ws + f_off); P.y_row0 = r0; P.xin_lat = nullptr; P.xin_ctx = nullptr; P.xb = (bf16*)(a->ws + WS_XB); P.out_f32 = lastl ? a->out : nullptr;
                P.h = lastl ? nullptr : (bf16*)(a->ws + WS_BUFA);
                P.gate = MODL + 5 * DM; P.g_post = a->in[IN_GPOSTFFN] + l * DM;
                P.g_pre = a->in[IN_GPREMIX] + (lastl ? l : l + 1) * DM; P.shift = MODN + 0 * DM; P.scale = MODN + 1 * DM;
                phase_norm(P, r0, r1, gw, ngw, lane);
                SEAM_WT(ph + 3);
            }
        }
    }
#undef IN
#undef SEAM
#undef TIDV
}

extern "C" void kernel_launch(void* const* d_in, const int* in_sizes, int n_in, void* d_out, int out_size, void* d_ws, size_t ws_size, hipStream_t stream) {
    static int grid = 0;
    if (grid == 0) {
        if (n_in != 26 || out_size != MLAT * DM || ws_size < WS_NEED_HALF) { fprintf(stderr, "kernel_launch: unexpected problem shape / workspace (n_in %d, out %d, ws %zu, need %zu)\n", n_in, out_size, ws_size, (size_t)WS_NEED_HALF); grid = -1; return; }
        int dev = 0, cus = 0, per_cu = 0;
        if (hipGetDevice(&dev) != hipSuccess || hipDeviceGetAttribute(&cus, hipDeviceAttributeMultiprocessorCount, dev) != hipSuccess) { grid = -1; return; }
        if (hipFuncSetAttribute((const void*)mk_fwd, hipFuncAttributeMaxDynamicSharedMemorySize, LDS_BYTES) != hipSuccess) { fprintf(stderr, "kernel_launch: hipFuncSetAttribute failed\n"); grid = -1; return; }
        if (hipOccupancyMaxActiveBlocksPerMultiprocessor(&per_cu, (const void*)mk_fwd, NTHREADS, LDS_BYTES) != hipSuccess || per_cu < 1)
            fprintf(stderr, "kernel_launch: note: occupancy query reports %d workgroups per CU\n", per_cu);
        (void)hipGetLastError();
        grid = cus;
        if (grid != 256) fprintf(stderr, "kernel_launch: note: %d CUs (built for 256)\n", grid);
    }
    if (grid < 0) return;
    if (hipMemsetAsync((char*)d_ws + WS_CTL, 0, CTL_BYTES, stream) != hipSuccess) { fprintf(stderr, "kernel_launch: memset failed\n"); return; }
    Args a{};
    for (int i = 0; i < 26; ++i) a.in[i] = (const float*)d_in[i];
    a.out = (float*)d_out; a.ws = (unsigned char*)d_ws;
    a.nhalf = 2;
    a.dup = MK_DUP;
#if MK_MULTI_LAUNCH
    for (int ph = 0; ph < PH_TOTAL; ++ph) {
        if (ph >= 2) { const int k = (ph - 2) % PH_PER_LAYER, ll = (ph - 2) / PH_PER_LAYER; if (a.nhalf == 1 && k >= 9) continue; if (a.nhalf == 2 && k == 8 && ll < DEPTH - 1) continue; }
        a.seg_lo = ph; a.seg_hi = ph + 1;
        hipLaunchKernelGGL(mk_fwd, dim3(grid), dim3(NTHREADS), LDS_BYTES, stream, a);
    }
#else
    a.seg_lo = 0; a.seg_hi = PH_TOTAL;
    hipLaunchKernelGGL(mk_fwd, dim3(grid), dim3(NTHREADS), LDS_BYTES, stream, a);
#endif
    const hipError_t le = hipPeekAtLastError();
    if (le != hipSuccess) fprintf(stderr, "kernel_launch: launch failed: %s\n", hipGetErrorName(le));
}
```
